# Optimizing an MI355X kernel written in HIP

```python
import jax, jax.numpy as jnp
from jax import lax
import numpy as np

D_MODEL = 1024
BATCH = 1
SEQ = 16384
DEPTH = 1
DEC_BATCH = 32
DEC_SEQ = 2048
PAST_LEN = 128

GRID_W = 64
M_HEADS = 4
M_HEAD_DIM = 256
M_WIDTH = M_HEADS * M_HEAD_DIM
M_CHUNK = 64
CONV_W = 5
N_GATES = 4 * M_HEADS
NA_HEADS = 16
NA_HEAD_DIM = 64
NA_WIDTH = NA_HEADS * NA_HEAD_DIM
NA_MAX_KH = 8
NA_KW = 16
NA_QCB = 16
NA_KCB = 32
SPLITS = (M_WIDTH, M_WIDTH, M_WIDTH, M_WIDTH, M_WIDTH, N_GATES, NA_WIDTH, NA_WIDTH, NA_WIDTH, NA_WIDTH, D_MODEL, D_MODEL)
D_IN = 5 * M_WIDTH + N_GATES + 4 * NA_WIDTH + 2 * D_MODEL
EPS = 1e-6
NEG = -1e30

kernel_name = 'hybrid_mlstm_natten_encoder'


def _rmsnorm(x, w):
    x32 = x.astype(jnp.float32)
    y = x32 * lax.rsqrt(jnp.mean(x32 * x32, axis=-1, keepdims=True) + EPS)
    return (y * w.astype(jnp.float32)).astype(x.dtype)


def _centred_conv(u, w, b):
    T = u.shape[1]
    pad = CONV_W // 2
    up = jnp.pad(u, ((0, 0), (pad, pad), (0, 0)))
    out = b
    for i in range(CONV_W):
        out = out + up[:, i:i + T] * w[i]
    return out


def _mlstm_scan(q, k, v, li, lf):
    B, H, T, dk = q.shape
    dv = v.shape[-1]
    nc = T // M_CHUNK

    def chunks(a):
        return jnp.moveaxis(a.reshape((B, H, nc, M_CHUNK) + a.shape[3:]), 2, 0)

    qc, kc, vc, lic = chunks(q), chunks(k), chunks(v), chunks(li)
    bc = jnp.cumsum(chunks(lf), axis=-1)
    tril = jnp.tril(jnp.ones((M_CHUNK, M_CHUNK), dtype=bool))

    def step(carry, xs):
        S, n, m = carry
        q_, k_, v_, li_, b_ = xs
        dmat = jnp.where(tril, b_[..., :, None] - b_[..., None, :] + li_[..., None, :], -jnp.inf)
        inter = b_ + m[..., None]
        mj = jnp.maximum(inter, jnp.max(dmat, axis=-1))
        w_int = jnp.exp(inter - mj)
        p = jnp.einsum('bhld,bhsd->bhls', q_, k_) * jnp.exp(dmat - mj[..., None])
        num = w_int[..., None] * jnp.einsum('bhld,bhde->bhle', q_, S) + jnp.einsum('bhls,bhse->bhle', p, v_)
        den = w_int * jnp.einsum('bhld,bhd->bhl', q_, n) + jnp.sum(p, axis=-1)
        h = num / jnp.maximum(jnp.abs(den), jnp.exp(-mj))[..., None]
        b_last = b_[..., -1]
        g = b_last[..., None] - b_ + li_
        m_new = jnp.maximum(b_last + m, jnp.max(g, axis=-1))
        a = jnp.exp(b_last + m - m_new)
        kw = k_ * jnp.exp(g - m_new[..., None])[..., None]
        S_new = a[..., None, None] * S + jnp.einsum('bhld,bhle->bhde', kw, v_)
        n_new = a[..., None] * n + jnp.sum(kw, axis=2)
        return (S_new, n_new, m_new), h

    init = (jnp.zeros((B, H, dk, dv), jnp.float32), jnp.zeros((B, H, dk), jnp.float32),
            jnp.zeros((B, H), jnp.float32))
    _, h = lax.scan(step, init, (qc, kc, vc, lic, bc))
    return jnp.moveaxis(h, 0, 2).reshape(B, H, T, dv)


def _mlstm_branch(q_pre, k_pre, v_in, o_pre, gate_pre, b_gate, conv_w, conv_b, mh_w):
    B, T, _ = q_pre.shape
    qk = jax.nn.silu(_centred_conv(jnp.concatenate([q_pre, k_pre], axis=-1), conv_w, conv_b))
    q, k = jnp.split(qk, 2, axis=-1)

    def heads(a):
        return a.astype(jnp.float32).reshape(B, T, M_HEADS, M_HEAD_DIM).transpose(0, 2, 1, 3)

    q, k, v = heads(q), heads(k) * (M_HEAD_DIM ** -0.5), heads(v_in)
    g = (gate_pre.astype(jnp.float32) + b_gate.astype(jnp.float32)).transpose(0, 2, 1)
    ig_f, fg_f, ig_b, fg_b = jnp.split(g, 4, axis=1)
    h_f = _mlstm_scan(q, k, v, ig_f, jax.nn.log_sigmoid(fg_f))

    def flip(a):
        return jnp.flip(a, axis=2)

    h_b = flip(_mlstm_scan(flip(q), flip(k), flip(v), flip(ig_b), flip(jax.nn.log_sigmoid(fg_b))))
    h = (h_f + h_b).transpose(0, 2, 1, 3)
    h = jax.nn.sigmoid(o_pre.astype(jnp.float32)).reshape(B, T, M_HEADS, M_HEAD_DIM) * h
    h = h * lax.rsqrt(jnp.mean(h * h, axis=-1, keepdims=True) + EPS) \
        * mh_w.astype(jnp.float32).reshape(M_HEADS, M_HEAD_DIM)
    return h.reshape(B, T, M_WIDTH).astype(q_pre.dtype)


def _na_col_tables():
    c = np.arange(GRID_W)
    cs = np.clip(c - NA_KW // 2, 0, GRID_W - NA_KW)
    ncb = GRID_W // NA_QCB
    c0 = np.arange(ncb) * NA_QCB
    kb = np.clip(c0 - NA_KW // 2, 0, GRID_W - NA_KCB)
    kcol = kb[:, None] + np.arange(NA_KCB)[None, :]
    qcol = c.reshape(ncb, NA_QCB)
    dc = kcol[:, None, :] - qcol[:, :, None]
    qs = cs.reshape(ncb, NA_QCB)[:, :, None]
    valid = (kcol[:, None, :] >= qs) & (kcol[:, None, :] < qs + NA_KW)
    return kcol, dc, valid


def _neighbourhood_attention(q, k, v, rpb):
    B, T, _ = q.shape
    rows = T // GRID_W
    kh = min(NA_MAX_KH, rows)
    ncb = GRID_W // NA_QCB
    kcol, dc, valid = _na_col_tables()
    qg = q.reshape(B, rows, ncb, NA_QCB, NA_HEADS, NA_HEAD_DIM)
    kg = k.reshape(B, rows, GRID_W, NA_HEADS, NA_HEAD_DIM)
    vg = v.reshape(B, rows, GRID_W, NA_HEADS, NA_HEAD_DIM)
    rpb_c = rpb[:, :, np.clip(dc + NA_KW - 1, 0, 2 * NA_KW - 2)]
    valid_b = jnp.asarray(valid)[None, None, :, :, None, :]
    scale = NA_HEAD_DIM ** -0.5

    def row(r):
        rs = jnp.clip(r - kh // 2, 0, rows - kh)
        k_blk = lax.dynamic_slice_in_dim(kg, rs, kh, axis=1)[:, :, kcol]
        v_blk = lax.dynamic_slice_in_dim(vg, rs, kh, axis=1)[:, :, kcol]
        q_r = lax.dynamic_index_in_dim(qg, r, axis=1, keepdims=False)
        s = jnp.einsum('bnqhd,bknjhd->bhnqkj', q_r, k_blk).astype(jnp.float32) * scale
        dr = rs + jnp.arange(kh) - r + (NA_MAX_KH - 1)
        bias = jnp.take(rpb_c, dr, axis=1).transpose(0, 2, 3, 1, 4)
        s = jnp.where(valid_b, s + bias.astype(jnp.float32)[None], NEG)
        shp = s.shape
        p = jax.nn.softmax(s.reshape(shp[:4] + (kh * NA_KCB,)), axis=-1).reshape(shp).astype(v.dtype)
        o = jnp.einsum('bhnqkj,bknjhd->bnqhd', p, v_blk)
        return o.reshape(B, GRID_W, NA_WIDTH)

    out = lax.map(row, jnp.arange(rows))
    return out.transpose(1, 0, 2, 3).reshape(B, T, NA_WIDTH)


def _layer(x, norm_w, w_in, b_gate, conv_w, conv_b, mh_norm_w, rpb, w_down_a, w_down_b, w_out):
    xn = _rmsnorm(x, norm_w)
    idx = np.cumsum(SPLITS)[:-1]
    m_q, m_k, m_v, m_o, m_z, m_g, n_q, n_k, n_v, n_z, g_a, g_b = [xn @ w for w in jnp.split(w_in, idx, axis=1)]
    y_a = _mlstm_branch(m_q, m_k, m_v, m_o, m_g, b_gate, conv_w, conv_b, mh_norm_w) * jax.nn.silu(m_z)
    y_b = _neighbourhood_attention(n_q, n_k, n_v, rpb) * jax.nn.silu(n_z)
    merged = jax.nn.sigmoid(g_a) * (y_a @ w_down_a) + jax.nn.sigmoid(g_b) * (y_b @ w_down_b)
    return x + merged @ w_out


def _trunk(x, norm_w, w_in, b_gate, conv_w, conv_b, mh_norm_w, rpb, w_down_a, w_down_b, w_out, final_norm_w):
    for l in range(DEPTH):
        x = _layer(x, norm_w[l], w_in[l], b_gate[l], conv_w[l], conv_b[l], mh_norm_w[l], rpb[l],
                   w_down_a[l], w_down_b[l], w_out[l])
    return _rmsnorm(x, final_norm_w)


def setup_inputs(seed: int = 0) -> dict:
    key = jax.random.key(seed)
    ks = jax.random.split(key, 13)
    nrm = jax.random.normal
    fb = jnp.linspace(3.0, 6.0, M_HEADS)
    zb = jnp.zeros((M_HEADS,), jnp.float32)
    gate_base = jnp.concatenate([zb, fb, zb, fb])
    return {
        'x_prompt': nrm(ks[0], (BATCH, SEQ, D_MODEL), jnp.float32),
        'x_sample': nrm(ks[1], (DEC_BATCH, DEC_SEQ, D_MODEL), jnp.float32),
        'norm_w': 1.0 + 0.02 * nrm(ks[2], (DEPTH, D_MODEL), jnp.float32),
        'w_in': nrm(ks[3], (DEPTH, D_MODEL, D_IN), jnp.float32) * D_MODEL ** -0.5,
        'b_gate': gate_base[None, :] + 0.1 * nrm(ks[4], (DEPTH, N_GATES), jnp.float32),
        'conv_w': nrm(ks[5], (DEPTH, CONV_W, 2 * M_WIDTH), jnp.float32) * CONV_W ** -0.5,
        'conv_b': 0.01 * nrm(ks[6], (DEPTH, 2 * M_WIDTH), jnp.float32),
        'mh_norm_w': 1.0 + 0.02 * nrm(ks[7], (DEPTH, M_WIDTH), jnp.float32),
        'rpb': 0.1 * nrm(ks[8], (DEPTH, NA_HEADS, 2 * NA_MAX_KH - 1, 2 * NA_KW - 1), jnp.float32),
        'w_down_a': nrm(ks[9], (DEPTH, M_WIDTH, D_MODEL), jnp.float32) * M_WIDTH ** -0.5,
        'w_down_b': nrm(ks[10], (DEPTH, NA_WIDTH, D_MODEL), jnp.float32) * NA_WIDTH ** -0.5,
        'w_out': nrm(ks[11], (DEPTH, D_MODEL, D_MODEL), jnp.float32) * D_MODEL ** -0.5,
        'final_norm_w': 1.0 + 0.02 * nrm(ks[12], (D_MODEL,), jnp.float32),
    }


def reference(x_prompt, x_sample, norm_w, w_in, b_gate, conv_w, conv_b, mh_norm_w, rpb,
              w_down_a, w_down_b, w_out, final_norm_w):
    y_prompt = _trunk(x_prompt, norm_w, w_in, b_gate, conv_w, conv_b, mh_norm_w, rpb,
                      w_down_a, w_down_b, w_out, final_norm_w)
    y_sample = _trunk(x_sample, norm_w, w_in, b_gate, conv_w, conv_b, mh_norm_w, rpb,
                      w_down_a, w_down_b, w_out, final_norm_w)
    return (y_prompt, y_sample)
```

```cpp
#include <hip/hip_runtime.h>
#include <hip/hip_cooperative_groups.h>
#include <cstdio>
namespace cg = cooperative_groups;
namespace pg8 {
#define PG8_LAS __attribute__((address_space(3)))
typedef unsigned short bf16_t;
typedef short bf16x8 __attribute__((ext_vector_type(8)));
typedef float f32x4 __attribute__((ext_vector_type(4)));
typedef unsigned u32x4 __attribute__((ext_vector_type(4)));
constexpr int BM = 256, BK = 64, HALF = 128, HTB = HALF * BK * 2  , STAGE_BYTES = 8 * HTB, NXCD = 8, WGM = 8;

__host__ __device__ __forceinline__ int lds_byte(int r, int c) { const int st = (r >> 4) * 2 + (c >> 5), rr = r & 15, cc = c & 31, ob = rr * 64 + cc * 2; return st * 1024 + (ob ^ (((ob >> 9) & 1) << 5)); }
__host__ __device__ __forceinline__ void stage_rc(int b, int& R, int& C) { const int st = b / 1024, sb = b % 1024, swz = sb ^ (((sb >> 9) & 1) << 5); R = (st >> 1) * 16 + swz / 64; C = (st & 1) * 32 + (swz % 64) / 2; }
__host__ __device__ __forceinline__ int perm32(int rho) { const int n = rho >> 4, i = rho & 15; return 8 * (i >> 2) + 4 * n + (i & 3); }

struct Unit { int pm, pn; };
struct Gemm { const bf16_t* A; const bf16_t* Bt; int M, N, K; };

struct StaticOrder {
    int nM, nN, nwg, G, c;
    __host__ __device__ void init(int M, int N, int G_, int c_) { nM = M / BM; nN = N / BM; nwg = nM * nN; G = G_; c = c_; }
    __host__ __device__ bool next(int i, Unit& u) const {
        const long L = (long)i * G + c; if (L >= nwg) return false;
        int wgid = (int)L; { const int q = nwg / NXCD, r = nwg % NXCD, xcd = wgid % NXCD, off = wgid / NXCD; wgid = (xcd < r ? xcd * (q + 1) : r * (q + 1) + (xcd - r) * q) + off; }
        const int nig = WGM * nN, gid = wgid / nig, fm = gid * WGM, gsz = (nM - fm) < WGM ? (nM - fm) : WGM;
        u.pm = fm + ((wgid % nig) % gsz); u.pn = (wgid % nig) / gsz; return true;
    }
    __device__ __forceinline__ void a_ready(const Unit&) const {}
    __device__ __forceinline__ void done(const Unit&) const {}
};
__device__ __forceinline__ unsigned cvt_pk_bf16(float lo, float hi) { unsigned r; asm volatile("v_cvt_pk_bf16_f32 %0, %1, %2" : "=v"(r) : "v"(lo), "v"(hi)); return r; }
template <class Epi, class Sched, bool STAMP = false>
__device__ __forceinline__ void gemm_phase(PG8_LAS unsigned char* lds, const Gemm g, const Sched& S, const Epi& E, unsigned long long* stamps) {
    const int tid = threadIdx.x, wid = __builtin_amdgcn_readfirstlane(tid >> 6), lane = tid & 63, wr = wid >> 2, wc = wid & 3, fr = lane & 15, fq = lane >> 4;
    const int K = g.K, nt = K / BK;
    int ts_lo = 0, ts_hi = 0, nts = 0; const unsigned long long rt_entry = STAMP ? (unsigned long long)wall_clock64() : 0ull;
#define PG8_STAMP() do { if (STAMP && wid == 0 && nts < 64) { const unsigned long long _c = (unsigned long long)clock64(); \
        ts_lo = (lane == nts) ? (int)(unsigned)_c : ts_lo; ts_hi = (lane == nts) ? (int)(unsigned)(_c >> 32) : ts_hi; ++nts; } } while (0)
    PG8_STAMP();
    unsigned voffA[2], voffB[2];
#pragma unroll
    for (int i = 0; i < 2; ++i) { int R, C; stage_rc(tid * 16 + i * 8192, R, C); const int Rb = Epi::PERM ? ((R & ~31) + perm32(R & 31)) : R;
        voffA[i] = (unsigned)(R * K + C) * 2u; voffB[i] = (unsigned)(Rb * K + C) * 2u; }
    const size_t kstep = (size_t)(BK * 2);
    const size_t hstep = (size_t)HALF * K * 2;
    const size_t tstep = 2 * hstep;
    const unsigned ldsw = (unsigned)wid * 1024u;
    const int aoff = lds_byte(wr * 64 + fr, fq * 8), boff = lds_byte(wc * 32 + fr, fq * 8);
#define PG8_SA(b, h) (((b) * 2 + (h)) * HTB)
#define PG8_SB(b, h) ((4 + (b) * 2 + (h)) * HTB)
#define PG8_STAGE(bufoff, gbase, voff) do { _Pragma("unroll") for (int _i = 0; _i < 2; ++_i) \
        __builtin_amdgcn_global_load_lds((const unsigned*)((const char*)(gbase) + (voff)[_i]), (PG8_LAS unsigned*)(lds + (bufoff) + ldsw + _i * 8192), 16, 0, 0); } while (0)
#define PG8_LDA(dst, b, h) do { _Pragma("unroll") for (int m = 0; m < 4; ++m) _Pragma("unroll") for (int k = 0; k < 2; ++k) dst[m][k] = *(const PG8_LAS bf16x8*)(lds + PG8_SA(b, h) + aoff + m * 2048 + k * 1024); } while (0)
#define PG8_LDB(dst, b, h) do { _Pragma("unroll") for (int n = 0; n < 2; ++n) _Pragma("unroll") for (int k = 0; k < 2; ++k) dst[n][k] = *(const PG8_LAS bf16x8*)(lds + PG8_SB(b, h) + boff + n * 2048 + k * 1024); } while (0)
#define PG8_MMA(ai, bj, At, Bt) do { __builtin_amdgcn_s_setprio(1); _Pragma("unroll") for (int m = 0; m < 4; ++m) _Pragma("unroll") for (int n = 0; n < 2; ++n) _Pragma("unroll") for (int k = 0; k < 2; ++k) \
        acc[ai][bj][m][n] = __builtin_amdgcn_mfma_f32_16x16x32_bf16(Bt[n][k], At[m][k], acc[ai][bj][m][n], 0, 0, 0); __builtin_amdgcn_s_setprio(0); } while (0)
#define PG8_WAIT_V(n) asm volatile("s_waitcnt vmcnt(" #n ")" ::: "memory")
#define PG8_WAIT_L(n) asm volatile("s_waitcnt lgkmcnt(" #n ")" ::: "memory")
#define PG8_BAR __builtin_amdgcn_s_barrier()
#define PG8_SCHED __builtin_amdgcn_sched_barrier(0)
    Unit cur, nxt; int ui = 0;
    if (!S.next(0, cur)) return;
    f32x4 acc[2][2][4][2];
#pragma unroll
    for (int a = 0; a < 2; ++a)
#pragma unroll
        for (int b = 0; b < 2; ++b)
#pragma unroll
            for (int m = 0; m < 4; ++m)
#pragma unroll
                for (int n = 0; n < 2; ++n) acc[a][b][m][n] = (f32x4){0.f, 0.f, 0.f, 0.f};
    bf16x8 At[4][2], B0[2][2], B1[2][2];
    const char* cA = (const char*)g.A + (size_t)cur.pm * tstep; const char* cB = (const char*)g.Bt + (size_t)cur.pn * tstep;
    S.a_ready(cur);
    PG8_STAGE(PG8_SB(0, 0), cB, voffB); PG8_STAGE(PG8_SA(0, 0), cA, voffA); PG8_STAGE(PG8_SB(0, 1), cB + hstep, voffB); PG8_STAGE(PG8_SA(0, 1), cA + hstep, voffA);
    if (wr == 1) PG8_BAR;
    PG8_WAIT_V(4); PG8_BAR;
    PG8_STAGE(PG8_SB(1, 0), cB + kstep, voffB); PG8_STAGE(PG8_SA(1, 0), cA + kstep, voffA); PG8_STAGE(PG8_SB(1, 1), cB + hstep + kstep, voffB);
    PG8_WAIT_V(6); PG8_BAR;
    PG8_STAMP();
    for (;;) {
        const bool has_next = S.next(ui + 1, nxt);
        const char* nA = has_next ? (const char*)g.A + (size_t)nxt.pm * tstep : cA; const char* nB = has_next ? (const char*)g.Bt + (size_t)nxt.pn * tstep : cB;
        for (int t = 0; t < nt; t += 2) {
            const bool last = (t == nt - 2);
            const char* a1 = cA + (size_t)(t + 1) * kstep;
            const char* a2 = last ? nA : cA + (size_t)(t + 2) * kstep; const char* b2 = last ? nB : cB + (size_t)(t + 2) * kstep;
            const char* a3 = a2 + kstep; const char* b3 = b2 + kstep;
            if (last && has_next) S.a_ready(nxt);
            PG8_LDB(B0, 0, 0); PG8_SCHED; PG8_LDA(At, 0, 0); PG8_STAGE(PG8_SA(1, 1), a1 + hstep, voffA);
            PG8_WAIT_L(8); PG8_BAR; PG8_WAIT_L(0); PG8_MMA(0, 0, At, B0); PG8_BAR; PG8_SCHED;
            PG8_LDB(B1, 0, 1); PG8_STAGE(PG8_SB(0, 0), b2, voffB);
            PG8_BAR; PG8_WAIT_L(0); PG8_MMA(0, 1, At, B1); PG8_BAR;
            PG8_LDA(At, 0, 1); PG8_STAGE(PG8_SA(0, 0), a2, voffA);
            PG8_BAR; PG8_WAIT_L(0); PG8_MMA(1, 0, At, B0); PG8_BAR; PG8_SCHED;
            PG8_STAGE(PG8_SB(0, 1), b2 + hstep, voffB);
            PG8_WAIT_V(6); PG8_BAR; PG8_MMA(1, 1, At, B1); PG8_BAR;
            PG8_LDB(B0, 1, 0); PG8_SCHED; PG8_LDA(At, 1, 0); PG8_STAGE(PG8_SA(0, 1), a2 + hstep, voffA);
            PG8_WAIT_L(8); PG8_BAR; PG8_WAIT_L(0); PG8_MMA(0, 0, At, B0); PG8_BAR; PG8_SCHED;
            PG8_LDB(B1, 1, 1); PG8_STAGE(PG8_SB(1, 0), b3, voffB);
            PG8_BAR; PG8_WAIT_L(0); PG8_MMA(0, 1, At, B1); PG8_BAR;
            PG8_LDA(At, 1, 1); PG8_STAGE(PG8_SA(1, 0), a3, voffA);
            PG8_BAR; PG8_WAIT_L(0); PG8_MMA(1, 0, At, B0); PG8_BAR; PG8_SCHED;
            PG8_STAGE(PG8_SB(1, 1), b3 + hstep, voffB);
            PG8_WAIT_V(6); PG8_BAR; PG8_MMA(1, 1, At, B1); PG8_BAR;
        }
        PG8_STAMP();
        if constexpr (!Epi::AFTER_DRAIN) { E(acc, cur, wr, wc, fr, fq); S.done(cur); }
        PG8_STAMP();
        if (!has_next) break;
#pragma unroll
        for (int a = 0; a < 2; ++a)
#pragma unroll
            for (int b = 0; b < 2; ++b)
#pragma unroll
                for (int m = 0; m < 4; ++m)
#pragma unroll
                    for (int n = 0; n < 2; ++n) acc[a][b][m][n] = (f32x4){0.f, 0.f, 0.f, 0.f};
        cur = nxt; cA = nA; cB = nB; ++ui;
    }
    PG8_WAIT_V(0);
    if (wr == 0) PG8_BAR;
    PG8_BAR;
    if constexpr (Epi::AFTER_DRAIN) { E.fused(acc, cur, wr, wc, fr, fq, lds, wid, lane); S.done(cur); }
    PG8_STAMP();
    if (STAMP && wid == 0) { stamps[lane] = lane < nts ? (((unsigned long long)(unsigned)ts_hi << 32) | (unsigned)ts_lo) : 0ull;
        if (lane == 62) stamps[62] = rt_entry; if (lane == 63) stamps[63] = (unsigned long long)wall_clock64(); }
#undef PG8_STAMP
#undef PG8_SA
#undef PG8_SB
#undef PG8_STAGE
#undef PG8_LDA
#undef PG8_LDB
#undef PG8_MMA
#undef PG8_WAIT_V
#undef PG8_WAIT_L
#undef PG8_BAR
#undef PG8_SCHED
}
}

#define LAS __attribute__((address_space(3)))
typedef unsigned short us;
typedef short bf16x8 __attribute__((ext_vector_type(8)));
typedef short s16x4 __attribute__((ext_vector_type(4)));
typedef float f32x4 __attribute__((ext_vector_type(4)));
typedef unsigned u32x4 __attribute__((ext_vector_type(4)));
typedef unsigned u32x2 __attribute__((ext_vector_type(2)));

constexpr int TOK_P = 16384, TOK_ALL = 81920, UNIT = 2048;
constexpr int DIN = 11280, NPAD = 11520;
constexpr int LDS_BYTES = 155648;
constexpr int L_ITEM = LDS_BYTES - 16;
constexpr int QS = 528, VS = 144;
constexpr int L_Q = 0, L_K = 33792, L_ST = 67584, L_V = 101376, L_VW = 110592, L_P = 119808, L_SM = 129024;
constexpr int SM_U = 0, SM_M = 64, SM_WINT = 128, SM_EB = 192, SM_W = 256, SM_QN = 320, SM_RS = 384  , SM_N = 640  , SM_A = 896;
constexpr int NA_VH = 73728, L_RPB = 147456;

struct Params {
    const float *xp, *xs, *norm_w, *w_in, *b_gate, *conv_w, *conv_b, *mh_w, *rpb, *wda, *wdb, *wout, *fnw;
    float* out;
    unsigned char* ws;
    unsigned long long o_winT, o_wdaT, o_wdbT, o_woutT, o_ctr, o_gates, o_xn, o_act;
    int Mr, nrounds, ph_lo, ph_hi;
};

__device__ __forceinline__ us f2bf(float f) { unsigned u = __float_as_uint(f); u += 0x7FFFu + ((u >> 16) & 1u); return (us)(u >> 16); }
__device__ __forceinline__ float bf2f(unsigned b) { return __uint_as_float(b << 16); }
__device__ __forceinline__ unsigned pk2(float lo, float hi) { return (unsigned)f2bf(lo) | ((unsigned)f2bf(hi) << 16); }
__device__ __forceinline__ float bflo(unsigned w) { return __uint_as_float(w << 16); }
__device__ __forceinline__ float bfhi(unsigned w) { return __uint_as_float(w & 0xFFFF0000u); }
__device__ __forceinline__ float sigmoidf_(float x) { return 1.0f / (1.0f + __expf(-x)); }
__device__ __forceinline__ float siluf_(float x) { return x / (1.0f + __expf(-x)); }
__device__ __forceinline__ const float* xrow(const Params& p, int t) { return t < TOK_P ? p.xp + (size_t)t * 1024 : p.xs + (size_t)(t - TOK_P) * 1024; }
__device__ __forceinline__ void seq_of(int t, int& s0, int& len) { if (t < TOK_P) { s0 = 0; len = TOK_P; } else { s0 = TOK_P + ((t - TOK_P) / UNIT) * UNIT; len = UNIT; } }
__device__ __forceinline__ us* actp(const Params& p, int i) { return (us*)(p.ws + p.o_act) + (size_t)i * p.Mr * 1024; }
__device__ __forceinline__ f32x4 mfma16(bf16x8 a, bf16x8 b, f32x4 c) { return __builtin_amdgcn_mfma_f32_16x16x32_bf16(a, b, c, 0, 0, 0); }
__device__ __forceinline__ bf16x8 tr8(LAS unsigned char* base, int off0, int off1) {
    s16x4 lo = __builtin_amdgcn_ds_read_tr16_b64_v4i16((LAS s16x4*)(base + off0));
    s16x4 hi = __builtin_amdgcn_ds_read_tr16_b64_v4i16((LAS s16x4*)(base + off1));
    return __builtin_shufflevector(lo, hi, 0, 1, 2, 3, 4, 5, 6, 7);
}

struct EpiIn {
    static constexpr bool PERM = true, AFTER_DRAIN = false;
    us* act; size_t split_stride; float* gates; const float* b_gate;
    __device__ __forceinline__ void operator()(const pg8::f32x4 (&acc)[2][2][4][2], const pg8::Unit& u, int wr, int wc, int fr, int fq) const {
        const int row0 = u.pm * 256 + wr * 64 + fr;
        if (u.pn < 44) {
            us* base = act + (size_t)(u.pn >> 2) * split_stride;
            const int col0 = (u.pn & 3) * 256 + wc * 32 + 8 * fq;
#pragma unroll
            for (int ai = 0; ai < 2; ++ai)
#pragma unroll
                for (int m = 0; m < 4; ++m) { us* rowp = base + (size_t)(row0 + ai * 128 + m * 16) * 1024 + col0;
#pragma unroll
                    for (int bj = 0; bj < 2; ++bj) { const pg8::f32x4 v0 = acc[ai][bj][m][0], v1 = acc[ai][bj][m][1];
                        u32x4 w; w.x = pk2(v0[0], v0[1]); w.y = pk2(v0[2], v0[3]); w.z = pk2(v1[0], v1[1]); w.w = pk2(v1[2], v1[3]);
                        *(u32x4*)(rowp + bj * 128) = w; } }
        } else {
            if (wc == 0 && fq < 2) {
#pragma unroll
                for (int n = 0; n < 2; ++n) { const int c = 8 * fq + 4 * n; const f32x4 bv = *(const f32x4*)(b_gate + c);
#pragma unroll
                    for (int ai = 0; ai < 2; ++ai)
#pragma unroll
                        for (int m = 0; m < 4; ++m) { const int row = row0 + ai * 128 + m * 16; *(f32x4*)(gates + (size_t)row * 16 + c) = acc[ai][0][m][n] + bv; } }
            }
        }
    }
};
struct EpiDA {
    static constexpr bool PERM = false, AFTER_DRAIN = false;
    float* tmp; const us* ga;
    __device__ __forceinline__ void operator()(const pg8::f32x4 (&acc)[2][2][4][2], const pg8::Unit& u, int wr, int wc, int fr, int fq) const {
        const int row0 = u.pm * 256 + wr * 64 + fr, col0 = u.pn * 256 + wc * 32 + 4 * fq;
#pragma unroll
        for (int ai = 0; ai < 2; ++ai)
#pragma unroll
            for (int m = 0; m < 4; ++m) { const size_t ro = (size_t)(row0 + ai * 128 + m * 16) * 1024 + col0;
#pragma unroll
                for (int bj = 0; bj < 2; ++bj)
#pragma unroll
                    for (int n = 0; n < 2; ++n) { const size_t o = ro + bj * 128 + n * 16; const u32x2 g = *(const u32x2*)(ga + o); const f32x4 a = acc[ai][bj][m][n];
                        f32x4 r; r[0] = sigmoidf_(bflo(g.x)) * a[0]; r[1] = sigmoidf_(bfhi(g.x)) * a[1]; r[2] = sigmoidf_(bflo(g.y)) * a[2]; r[3] = sigmoidf_(bfhi(g.y)) * a[3];
                        *(f32x4*)(tmp + o) = r; } asm volatile("" ::: "memory"); }
    }
};
struct EpiDB {
    static constexpr bool PERM = false, AFTER_DRAIN = false;
    const float* tmp; const us* gb; us* merged;
    __device__ __forceinline__ void operator()(const pg8::f32x4 (&acc)[2][2][4][2], const pg8::Unit& u, int wr, int wc, int fr, int fq) const {
        const int row0 = u.pm * 256 + wr * 64 + fr, col0 = u.pn * 256 + wc * 32 + 4 * fq;
#pragma unroll
        for (int ai = 0; ai < 2; ++ai)
#pragma unroll
            for (int m = 0; m < 4; ++m) { const size_t ro = (size_t)(row0 + ai * 128 + m * 16) * 1024 + col0;
#pragma unroll
                for (int bj = 0; bj < 2; ++bj)
#pragma unroll
                    for (int n = 0; n < 2; ++n) { const size_t o = ro + bj * 128 + n * 16; const u32x2 g = *(const u32x2*)(gb + o); const f32x4 a = acc[ai][bj][m][n]; const f32x4 t = *(const f32x4*)(tmp + o);
                        u32x2 w; w.x = pk2(t[0] + sigmoidf_(bflo(g.x)) * a[0], t[1] + sigmoidf_(bfhi(g.x)) * a[1]); w.y = pk2(t[2] + sigmoidf_(bflo(g.y)) * a[2], t[3] + sigmoidf_(bfhi(g.y)) * a[3]);
                        *(u32x2*)(merged + o) = w; } asm volatile("" ::: "memory"); }
    }
};
struct EpiOut {
    static constexpr bool PERM = false, AFTER_DRAIN = false;
    float* out; const float* xp; const float* xs; int T0;
    __device__ __forceinline__ void operator()(const pg8::f32x4 (&acc)[2][2][4][2], const pg8::Unit& u, int wr, int wc, int fr, int fq) const {
        const int row0 = u.pm * 256 + wr * 64 + fr, col0 = u.pn * 256 + wc * 32 + 4 * fq;
#pragma unroll
        for (int ai = 0; ai < 2; ++ai)
#pragma unroll
            for (int m = 0; m < 4; ++m) { const int row = row0 + ai * 128 + m * 16; const int t = T0 + row;
                const float* xr = (t < TOK_P ? xp + (size_t)t * 1024 : xs + (size_t)(t - TOK_P) * 1024) + col0; float* orow = out + (size_t)row * 1024 + col0;
#pragma unroll
                for (int bj = 0; bj < 2; ++bj)
#pragma unroll
                    for (int n = 0; n < 2; ++n) { const int o = bj * 128 + n * 16; *(f32x4*)(orow + o) = *(const f32x4*)(xr + o) + acc[ai][bj][m][n]; } }
    }
};

template <class Epi> __device__ __forceinline__ void run_gemm(unsigned char* shm, const us* A, const us* Bt, int M, int N, int K, const Epi& E) {
    pg8::Gemm g; g.A = A; g.Bt = Bt; g.M = M; g.N = N; g.K = K;
    pg8::StaticOrder S; S.init(M, N, (int)gridDim.x, (int)blockIdx.x);
    pg8::gemm_phase<Epi, pg8::StaticOrder, false>((LAS unsigned char*)shm, g, S, E, nullptr);
}

__device__ __forceinline__ void phase_weights(const Params& p, unsigned char* shm) {
    float* tile = (float*)shm;
    const int tid = threadIdx.x;
    for (int job = blockIdx.x; job < 2880 + 768; job += gridDim.x) {
        const float* src; int ld, col0, nvalid, kt; us* dst;
        if (job < 2880) { const int nt = job >> 4; kt = job & 15; src = p.w_in; ld = DIN; const int n0 = nt * 64;
            if (n0 < 5120) { col0 = n0; nvalid = 64; } else if (n0 < 11264) { col0 = n0 + 16; nvalid = 64; } else if (n0 == 11264) { col0 = 5120; nvalid = 16; } else { col0 = 0; nvalid = 0; }
            dst = (us*)(p.ws + p.o_winT) + (size_t)n0 * 1024;
        } else { const int j2 = job - 2880, which = j2 >> 8, t = j2 & 255, nt = t >> 4; kt = t & 15; ld = 1024; col0 = nt * 64; nvalid = 64;
            src = which == 0 ? p.wda : (which == 1 ? p.wdb : p.wout);
            dst = (us*)(p.ws + (which == 0 ? p.o_wdaT : (which == 1 ? p.o_wdbT : p.o_woutT))) + (size_t)nt * 64 * 1024; }
        __syncthreads();
        { const int j = tid & 63, i0 = tid >> 6;
#pragma unroll
          for (int ii = 0; ii < 8; ++ii) { const int i = i0 + 8 * ii; tile[i * 65 + j] = (j < nvalid) ? src[(size_t)(kt * 64 + i) * ld + col0 + j] : 0.f; } }
        __syncthreads();
        { const int i = tid & 63, j0 = tid >> 6;
#pragma unroll
          for (int jj = 0; jj < 8; ++jj) { const int j = j0 + 8 * jj; dst[(size_t)j * 1024 + kt * 64 + i] = f2bf(tile[i * 65 + j]); } }
    }
    __syncthreads();
}

__device__ __forceinline__ void phase_xnorm(const Params& p, int T0) {
    const int wave = threadIdx.x >> 6, lane = threadIdx.x & 63;
    us* xn = (us*)(p.ws + p.o_xn);
    f32x4 nw[4];
#pragma unroll
    for (int j = 0; j < 4; ++j) nw[j] = *(const f32x4*)(p.norm_w + lane * 4 + 256 * j);
    for (int r = blockIdx.x * 8 + wave; r < p.Mr; r += gridDim.x * 8) {
        const float* xr = xrow(p, T0 + r);
        f32x4 v[4]; float ss = 0.f;
#pragma unroll
        for (int j = 0; j < 4; ++j) { v[j] = *(const f32x4*)(xr + lane * 4 + 256 * j); ss += v[j][0] * v[j][0] + v[j][1] * v[j][1] + v[j][2] * v[j][2] + v[j][3] * v[j][3]; }
#pragma unroll
        for (int o = 32; o >= 1; o >>= 1) ss += __shfl_xor(ss, o);
        const float rs = rsqrtf(ss * (1.0f / 1024.0f) + 1e-6f);
#pragma unroll
        for (int j = 0; j < 4; ++j) { u32x2 w; w.x = pk2(v[j][0] * rs * nw[j][0], v[j][1] * rs * nw[j][1]); w.y = pk2(v[j][2] * rs * nw[j][2], v[j][3] * rs * nw[j][3]);
            *(u32x2*)(xn + (size_t)r * 1024 + lane * 4 + 256 * j) = w; }
    }
}

__device__ __forceinline__ void phase_fnorm(const Params& p, int T0) {
    const int wave = threadIdx.x >> 6, lane = threadIdx.x & 63;
    f32x4 nw[4];
#pragma unroll
    for (int j = 0; j < 4; ++j) nw[j] = *(const f32x4*)(p.fnw + lane * 4 + 256 * j);
    for (int r = blockIdx.x * 8 + wave; r < p.Mr; r += gridDim.x * 8) {
        float* xr = p.out + (size_t)(T0 + r) * 1024;
        f32x4 v[4]; float ss = 0.f;
#pragma unroll
        for (int j = 0; j < 4; ++j) { v[j] = *(const f32x4*)(xr + lane * 4 + 256 * j); ss += v[j][0] * v[j][0] + v[j][1] * v[j][1] + v[j][2] * v[j][2] + v[j][3] * v[j][3]; }
#pragma unroll
        for (int o = 32; o >= 1; o >>= 1) ss += __shfl_xor(ss, o);
        const float rs = rsqrtf(ss * (1.0f / 1024.0f) + 1e-6f);
#pragma unroll
        for (int j = 0; j < 4; ++j) { f32x4 w; w[0] = v[j][0] * rs * nw[j][0]; w[1] = v[j][1] * rs * nw[j][1]; w[2] = v[j][2] * rs * nw[j][2]; w[3] = v[j][3] * rs * nw[j][3];
            *(f32x4*)(xr + lane * 4 + 256 * j) = w; }
    }
}

__device__ __forceinline__ void phase_conv(const Params& p, int T0) {
    const int tid = threadIdx.x, ct = tid & 255, tensor = ct >> 7, cgp = ct & 127, sub = tid >> 8;
    const us* src = actp(p, tensor);
    us* dst = (us*)(p.out + (size_t)T0 * 1024) + (size_t)tensor * p.Mr * 1024;
    const int ch0 = tensor * 1024 + cgp * 8;
    float w[5][8], b[8];
#pragma unroll
    for (int e = 0; e < 8; ++e) { b[e] = p.conv_b[ch0 + e];
#pragma unroll
        for (int i = 0; i < 5; ++i) w[i][e] = p.conv_w[i * 2048 + ch0 + e]; }
    const float oscale = tensor ? 0.0625f : 1.0f;
    for (int item = blockIdx.x; item < p.Mr / 32; item += gridDim.x) {
        const int r0 = (item * 2 + sub) * 16;
        int s0, len; seq_of(T0 + r0, s0, len);
        const int lo = s0 - T0, hi = lo + len;
        u32x4 rows[20];
#pragma unroll
        for (int i = 0; i < 20; ++i) { const int r = r0 - 2 + i; rows[i] = (r >= lo && r < hi) ? *(const u32x4*)(src + (size_t)r * 1024 + cgp * 8) : (u32x4){0u, 0u, 0u, 0u}; }
#pragma unroll
        for (int o = 0; o < 16; ++o) {
            float a[8];
#pragma unroll
            for (int e = 0; e < 8; ++e) a[e] = b[e];
#pragma unroll
            for (int i = 0; i < 5; ++i) { const u32x4 rw = rows[o + i];
                a[0] += w[i][0] * bflo(rw.x); a[1] += w[i][1] * bfhi(rw.x); a[2] += w[i][2] * bflo(rw.y); a[3] += w[i][3] * bfhi(rw.y);
                a[4] += w[i][4] * bflo(rw.z); a[5] += w[i][5] * bfhi(rw.z); a[6] += w[i][6] * bflo(rw.w); a[7] += w[i][7] * bfhi(rw.w); }
#pragma unroll
            for (int e = 0; e < 8; ++e) a[e] = siluf_(a[e]) * oscale;
            u32x4 wv; wv.x = pk2(a[0], a[1]); wv.y = pk2(a[2], a[3]); wv.z = pk2(a[4], a[5]); wv.w = pk2(a[6], a[7]);
            *(u32x4*)(dst + (size_t)(r0 + o) * 1024 + cgp * 8) = wv;
        }
    }
}

__device__ __forceinline__ void phase_ya(const Params& p) {
    const int wave = threadIdx.x >> 6, lane = threadIdx.x & 63;
    const us* hf = actp(p, 0); const us* hb = actp(p, 1); const us* mo = actp(p, 3); const us* mz = actp(p, 4);
    us* ya = (us*)(p.ws + p.o_xn);
    float mw[16];
#pragma unroll
    for (int i = 0; i < 16; ++i) mw[i] = p.mh_w[lane * 16 + i];
    for (int r = blockIdx.x * 8 + wave; r < p.Mr; r += gridDim.x * 8) {
        const size_t o = (size_t)r * 1024 + lane * 16;
        float h[16]; float ss = 0.f;
        unsigned zz[8];
#pragma unroll
        for (int c = 0; c < 2; ++c) {
            const u32x4 a = *(const u32x4*)(hf + o + c * 8), b = *(const u32x4*)(hb + o + c * 8), g = *(const u32x4*)(mo + o + c * 8), z = *(const u32x4*)(mz + o + c * 8);
#pragma unroll
            for (int q = 0; q < 4; ++q) { const unsigned aw = a[q], bw = b[q], gw = g[q];
                h[c * 8 + 2 * q] = (bflo(aw) + bflo(bw)) * sigmoidf_(bflo(gw)); h[c * 8 + 2 * q + 1] = (bfhi(aw) + bfhi(bw)) * sigmoidf_(bfhi(gw)); zz[c * 4 + q] = z[q]; }
        }
#pragma unroll
        for (int i = 0; i < 16; ++i) ss += h[i] * h[i];
        ss += __shfl_xor(ss, 1); ss += __shfl_xor(ss, 2); ss += __shfl_xor(ss, 4); ss += __shfl_xor(ss, 8);
        const float rn = rsqrtf(ss * (1.0f / 256.0f) + 1e-6f);
        unsigned w[8];
#pragma unroll
        for (int q = 0; q < 8; ++q) w[q] = pk2(h[2 * q] * rn * mw[2 * q] * siluf_(bflo(zz[q])), h[2 * q + 1] * rn * mw[2 * q + 1] * siluf_(bfhi(zz[q])));
        *(u32x4*)(ya + o) = (u32x4){w[0], w[1], w[2], w[3]}; *(u32x4*)(ya + o + 8) = (u32x4){w[4], w[5], w[6], w[7]};
    }
}

__device__ __forceinline__ void mlstm_chain(const Params& p, unsigned char* shm, int T0, int s0, int len, int head, int dir, int split) {
    LAS unsigned char* lds = (LAS unsigned char*)shm;
    LAS float* sm = (LAS float*)(lds + L_SM);
    const int tid = threadIdx.x, w = tid >> 6, lane = tid & 63, fr = lane & 15, fq = lane >> 4;
    const us* qc = (const us*)(p.out + (size_t)T0 * 1024); const us* kc = qc + (size_t)p.Mr * 1024;
    const us* mv = actp(p, 2); const float* gates = (const float*)(p.ws + p.o_gates);
    us* hout = actp(p, dir);
    const int nc = len / 64;
    const int base = dir ? (s0 + len - 1 - T0) : (s0 - T0); const int sgn = dir ? -1 : 1;
    const size_t hoff = (size_t)head * 256;
    u32x4 rq[4], rk[4], rv; float gi = 0.f, gf = 0.f, gi_cur, gf_cur;
    for (int i = tid; i < 33792 / 16; i += 512) *(LAS u32x4*)(lds + L_ST + i * 16) = (u32x4){0u, 0u, 0u, 0u};
    if (tid < 256) sm[SM_N + tid] = 0.f;
    f32x4 Sacc[2][4];
#pragma unroll
    for (int a = 0; a < 2; ++a)
#pragma unroll
        for (int b = 0; b < 4; ++b) Sacc[a][b] = (f32x4){0.f, 0.f, 0.f, 0.f};
    float mstate = 0.f;
#define CH_LOAD(c) do { \
        _Pragma("unroll") for (int i = 0; i < 4; ++i) { const int id = tid + 512 * i, row = id >> 5, ch = id & 31; const size_t lr = (size_t)(base + sgn * ((c) * 64 + row)); \
            rq[i] = *(const u32x4*)(qc + lr * 1024 + hoff + ch * 8); rk[i] = *(const u32x4*)(kc + lr * 1024 + hoff + ch * 8); } \
        { const int row = tid >> 3, ch = tid & 7; const size_t lr = (size_t)(base + sgn * ((c) * 64 + row)); rv = *(const u32x4*)(mv + lr * 1024 + hoff + split * 64 + ch * 8); } \
        if (tid < 64) { const size_t lr = (size_t)(base + sgn * ((c) * 64 + tid)); gi = gates[lr * 16 + dir * 8 + head]; gf = gates[lr * 16 + dir * 8 + 4 + head]; } } while (0)
#define CH_STORE() do { \
        _Pragma("unroll") for (int i = 0; i < 4; ++i) { const int id = tid + 512 * i, row = id >> 5, ch = id & 31; \
            *(LAS u32x4*)(lds + L_Q + row * QS + ch * 16) = rq[i]; *(LAS u32x4*)(lds + L_K + row * QS + ch * 16) = rk[i]; } \
        { const int row = tid >> 3, ch = tid & 7; *(LAS u32x4*)(lds + L_V + row * VS + ch * 16) = rv; } } while (0)
    CH_LOAD(0); CH_STORE(); gi_cur = gi; gf_cur = gf;
    const int tA = w & 3, jt0 = (w >> 2) * 2;
    for (int c = 0; c < nc; ++c) {
        if (c + 1 < nc) CH_LOAD(c + 1);
        if (w == 0) {
            const float li = gi_cur; const float lf = fminf(gf_cur, 0.f) - log1pf(__expf(-fabsf(gf_cur)));
            float b = lf;
#pragma unroll
            for (int o = 1; o < 64; o <<= 1) { const float t = __shfl_up(b, o); if (lane >= o) b += t; }
            const float u = li - b; float cm = u;
#pragma unroll
            for (int o = 1; o < 64; o <<= 1) { const float t = __shfl_up(cm, o); if (lane >= o) cm = fmaxf(cm, t); }
            const float Mj = fmaxf(mstate, cm);
            const float M63 = __shfl(Mj, 63), b63 = __shfl(b, 63);
            sm[SM_U + lane] = u; sm[SM_M + lane] = Mj; sm[SM_WINT + lane] = __expf(mstate - Mj); sm[SM_EB + lane] = __expf(-b - Mj); sm[SM_W + lane] = __expf(u - M63);
            if (lane == 0) sm[SM_A] = __expf(mstate - M63);
            mstate = b63 + M63;
        }
        __syncthreads();
        f32x4 h0 = (f32x4){0.f, 0.f, 0.f, 0.f}, h1 = h0;
        {
            f32x4 sc0 = (f32x4){0.f, 0.f, 0.f, 0.f}, sc1 = sc0;
#pragma unroll
            for (int kk = 0; kk < 8; ++kk) {
                const bf16x8 a = *(LAS bf16x8*)(lds + L_K + (tA * 16 + fr) * QS + kk * 64 + fq * 16);
                const bf16x8 b0 = *(LAS bf16x8*)(lds + L_Q + (jt0 * 16 + fr) * QS + kk * 64 + fq * 16);
                const bf16x8 b1 = *(LAS bf16x8*)(lds + L_Q + ((jt0 + 1) * 16 + fr) * QS + kk * 64 + fq * 16);
                sc0 = mfma16(a, b0, sc0); sc1 = mfma16(a, b1, sc1);
            }
            const int sb = tA * 16 + 4 * fq;
            const f32x4 uv = *(LAS f32x4*)(sm + SM_U + sb);
#pragma unroll
            for (int jt = 0; jt < 2; ++jt) { const int j = (jt0 + jt) * 16 + fr; const float Mj = sm[SM_M + j]; const f32x4 sc = jt ? sc1 : sc0;
                float v[4];
#pragma unroll
                for (int i = 0; i < 4; ++i) v[i] = (sb + i <= j) ? sc[i] * __expf(uv[i] - Mj) : 0.f;
                u32x2 wv; wv.x = pk2(v[0], v[1]); wv.y = pk2(v[2], v[3]);
                *(LAS u32x2*)(lds + L_P + j * VS + sb * 2) = wv;
                float rs = (v[0] + v[1]) + (v[2] + v[3]); rs += __shfl_xor(rs, 16); rs += __shfl_xor(rs, 32);
                if (fq == 0) sm[SM_RS + tA * 64 + j] = rs; }
        }
        {
            const int j = tid >> 3, part = tid & 7; float acc = 0.f;
#pragma unroll
            for (int cc = 0; cc < 4; ++cc) { const u32x4 qv = *(LAS u32x4*)(lds + L_Q + j * QS + part * 64 + cc * 16);
                const f32x4 n0 = *(LAS f32x4*)(sm + SM_N + part * 32 + cc * 8), n1 = *(LAS f32x4*)(sm + SM_N + part * 32 + cc * 8 + 4);
                acc += bflo(qv.x) * n0[0] + bfhi(qv.x) * n0[1] + bflo(qv.y) * n0[2] + bfhi(qv.y) * n0[3] + bflo(qv.z) * n1[0] + bfhi(qv.z) * n1[1] + bflo(qv.w) * n1[2] + bfhi(qv.w) * n1[3]; }
            acc += __shfl_xor(acc, 1); acc += __shfl_xor(acc, 2); acc += __shfl_xor(acc, 4);
            if (part == 0) sm[SM_QN + j] = acc;
        }
        {
            const int s = tid >> 3, ch = tid & 7; const float ws_ = sm[SM_W + s]; const u32x4 vv = *(LAS u32x4*)(lds + L_V + s * VS + ch * 16);
            u32x4 o; o.x = pk2(bflo(vv.x) * ws_, bfhi(vv.x) * ws_); o.y = pk2(bflo(vv.y) * ws_, bfhi(vv.y) * ws_); o.z = pk2(bflo(vv.z) * ws_, bfhi(vv.z) * ws_); o.w = pk2(bflo(vv.w) * ws_, bfhi(vv.w) * ws_);
            *(LAS u32x4*)(lds + L_VW + s * VS + ch * 16) = o;
        }
        {
#pragma unroll
            for (int kk = 0; kk < 8; ++kk) {
                const bf16x8 a = *(LAS bf16x8*)(lds + L_ST + (tA * 16 + fr) * QS + kk * 64 + fq * 16);
                const bf16x8 b0 = *(LAS bf16x8*)(lds + L_Q + (jt0 * 16 + fr) * QS + kk * 64 + fq * 16);
                const bf16x8 b1 = *(LAS bf16x8*)(lds + L_Q + ((jt0 + 1) * 16 + fr) * QS + kk * 64 + fq * 16);
                h0 = mfma16(a, b0, h0); h1 = mfma16(a, b1, h1);
            }
        }
        __syncthreads();
        {
            const int j0 = jt0 * 16 + fr, j1 = j0 + 16;
            const float wi0 = sm[SM_WINT + j0], wi1 = sm[SM_WINT + j1];
            h0 *= wi0; h1 *= wi1;
#pragma unroll
            for (int ks = 0; ks < 2; ++ks) {
                const int o0 = (ks * 32 + 8 * fq + (fr >> 2)) * VS + (tA * 16 + 4 * (fr & 3)) * 2;
                const bf16x8 a = tr8(lds + L_V, o0, o0 + 4 * VS);
                const bf16x8 b0 = *(LAS bf16x8*)(lds + L_P + j0 * VS + ks * 64 + fq * 16);
                const bf16x8 b1 = *(LAS bf16x8*)(lds + L_P + j1 * VS + ks * 64 + fq * 16);
                h0 = mfma16(a, b0, h0); h1 = mfma16(a, b1, h1);
            }
            const float den0 = wi0 * sm[SM_QN + j0] + ((sm[SM_RS + j0] + sm[SM_RS + 64 + j0]) + (sm[SM_RS + 128 + j0] + sm[SM_RS + 192 + j0]));
            const float den1 = wi1 * sm[SM_QN + j1] + ((sm[SM_RS + j1] + sm[SM_RS + 64 + j1]) + (sm[SM_RS + 128 + j1] + sm[SM_RS + 192 + j1]));
            const float sc0 = 1.0f / fmaxf(fabsf(den0), sm[SM_EB + j0]), sc1 = 1.0f / fmaxf(fabsf(den1), sm[SM_EB + j1]);
            h0 *= sc0; h1 *= sc1;
            const size_t lr0 = (size_t)(base + sgn * (c * 64 + j0)), lr1 = (size_t)(base + sgn * (c * 64 + j1));
            const int eo = split * 64 + tA * 16 + 4 * fq;
            u32x2 w0, w1; w0.x = pk2(h0[0], h0[1]); w0.y = pk2(h0[2], h0[3]); w1.x = pk2(h1[0], h1[1]); w1.y = pk2(h1[2], h1[3]);
            *(u32x2*)(hout + lr0 * 1024 + hoff + eo) = w0; *(u32x2*)(hout + lr1 * 1024 + hoff + eo) = w1;
        }
        {
            const float a_ = sm[SM_A];
#pragma unroll
            for (int dd = 0; dd < 2; ++dd)
#pragma unroll
                for (int e4 = 0; e4 < 4; ++e4) Sacc[dd][e4] *= a_;
#pragma unroll
            for (int ks = 0; ks < 2; ++ks) {
                const int rbase = ks * 32 + 8 * fq + (fr >> 2);
                bf16x8 A[2], B[4];
#pragma unroll
                for (int dd = 0; dd < 2; ++dd) { const int o0 = rbase * QS + ((w * 2 + dd) * 16 + 4 * (fr & 3)) * 2; A[dd] = tr8(lds + L_K, o0, o0 + 4 * QS); }
#pragma unroll
                for (int e4 = 0; e4 < 4; ++e4) { const int o0 = rbase * VS + (e4 * 16 + 4 * (fr & 3)) * 2; B[e4] = tr8(lds + L_VW, o0, o0 + 4 * VS); }
#pragma unroll
                for (int dd = 0; dd < 2; ++dd)
#pragma unroll
                    for (int e4 = 0; e4 < 4; ++e4) Sacc[dd][e4] = mfma16(A[dd], B[e4], Sacc[dd][e4]);
            }
#pragma unroll
            for (int dd = 0; dd < 2; ++dd)
#pragma unroll
                for (int e4 = 0; e4 < 4; ++e4) { const f32x4 s = Sacc[dd][e4]; u32x2 wv; wv.x = pk2(s[0], s[1]); wv.y = pk2(s[2], s[3]);
                    *(LAS u32x2*)(lds + L_ST + (e4 * 16 + fr) * QS + ((w * 2 + dd) * 16 + 4 * fq) * 2) = wv; }
            if (tid < 256) {
                float acc = 0.f;
#pragma unroll 8
                for (int s = 0; s < 64; ++s) acc += sm[SM_W + s] * bf2f(*(LAS us*)(lds + L_K + s * QS + tid * 2));
                sm[SM_N + tid] = a_ * sm[SM_N + tid] + acc;
            }
        }
        __syncthreads();
        if (c + 1 < nc) { CH_STORE(); gi_cur = gi; gf_cur = gf; }
    }
#undef CH_LOAD
#undef CH_STORE
}

__device__ __forceinline__ void na_item(const Params& p, unsigned char* shm, int T0, int grow, int hp) {
    LAS unsigned char* lds = (LAS unsigned char*)shm;
    LAS float* rpbs = (LAS float*)(lds + L_RPB);
    const int tid = threadIdx.x, w = tid >> 6, lane = tid & 63, fr = lane & 15, fq = lane >> 4;
    const int n = w & 3, hh = w >> 2, head = 2 * hp + hh;
    const us* nq = actp(p, 5); const us* nk = actp(p, 6); const us* nv = actp(p, 7); const us* nz = actp(p, 8);
    us* yb = actp(p, 5);
    const int tok0 = T0 + grow * 64; int s0, len; seq_of(tok0, s0, len);
    const int rows = len / 64, r = (tok0 - s0) / 64;
    const int rs = min(max(r - 4, 0), rows - 8);
    const int wl0 = s0 + rs * 64 - T0;
#pragma unroll
    for (int i = 0; i < 16; ++i) { const int id = tid + 512 * i, h2 = id >> 12, key = (id >> 3) & 511, ch = id & 7;
        const u32x4 v = *(const u32x4*)(nv + (size_t)(wl0 + key) * 1024 + (2 * hp + h2) * 64 + ch * 8);
        *(LAS u32x4*)(lds + h2 * NA_VH + key * VS + ch * 16) = v; }
    for (int i = tid; i < 930; i += 512) rpbs[i] = p.rpb[hp * 930 + i];
    const int kb = min(max(16 * n - 8, 0), 32);
    const size_t lrq = (size_t)(tok0 - T0 + 16 * n + fr);
    bf16x8 qf[2];
#pragma unroll
    for (int ks = 0; ks < 2; ++ks) qf[ks] = *(const bf16x8*)(nq + lrq * 1024 + head * 64 + ks * 32 + fq * 8);
    f32x4 s[16];
#pragma unroll
    for (int t = 0; t < 16; ++t) { s[t] = (f32x4){0.f, 0.f, 0.f, 0.f};
        const size_t kl = (size_t)(wl0 + (t >> 1) * 64 + kb + 16 * (t & 1) + fr);
#pragma unroll
        for (int ks = 0; ks < 2; ++ks) { const bf16x8 kf = *(const bf16x8*)(nk + kl * 1024 + head * 64 + ks * 32 + fq * 8); s[t] = mfma16(kf, qf[ks], s[t]); } }
    __syncthreads();
    const int c = 16 * n + fr, cs = min(max(c - 8, 0), 48);
    float mx = -1e30f;
#pragma unroll
    for (int t = 0; t < 16; ++t) { const int dr = rs + (t >> 1) - r + 7;
#pragma unroll
        for (int i = 0; i < 4; ++i) { const int kcol = kb + 16 * (t & 1) + 4 * fq + i; const bool valid = (kcol >= cs) && (kcol < cs + 16);
            const int dc = min(max(kcol - c + 15, 0), 30);
            const float v = valid ? s[t][i] * 0.125f + rpbs[hh * 465 + dr * 31 + dc] : -1e30f; s[t][i] = v; mx = fmaxf(mx, v); } }
    mx = fmaxf(mx, __shfl_xor(mx, 16)); mx = fmaxf(mx, __shfl_xor(mx, 32));
    float sum = 0.f;
#pragma unroll
    for (int t = 0; t < 16; ++t)
#pragma unroll
        for (int i = 0; i < 4; ++i) { const float e = (s[t][i] > -1e29f) ? __expf(s[t][i] - mx) : 0.f; s[t][i] = e; sum += e; }
    sum += __shfl_xor(sum, 16); sum += __shfl_xor(sum, 32);
    f32x4 o[4];
#pragma unroll
    for (int dt = 0; dt < 4; ++dt) o[dt] = (f32x4){0.f, 0.f, 0.f, 0.f};
#pragma unroll
    for (int kk = 0; kk < 8; ++kk) {
        u32x4 pw; pw.x = pk2(s[2 * kk][0], s[2 * kk][1]); pw.y = pk2(s[2 * kk][2], s[2 * kk][3]); pw.z = pk2(s[2 * kk + 1][0], s[2 * kk + 1][1]); pw.w = pk2(s[2 * kk + 1][2], s[2 * kk + 1][3]);
        const bf16x8 pf = __builtin_bit_cast(bf16x8, pw);
#pragma unroll
        for (int dt = 0; dt < 4; ++dt) { const int o0 = hh * NA_VH + (kk * 64 + kb + 4 * fq + (fr >> 2)) * VS + (dt * 16 + 4 * (fr & 3)) * 2;
            const bf16x8 a = tr8(lds, o0, o0 + 16 * VS); o[dt] = mfma16(a, pf, o[dt]); }
    }
    const float inv = 1.0f / sum;
#pragma unroll
    for (int dt = 0; dt < 4; ++dt) { const size_t off = lrq * 1024 + head * 64 + dt * 16 + 4 * fq; const u32x2 z = *(const u32x2*)(nz + off);
        u32x2 wv; wv.x = pk2(o[dt][0] * inv * siluf_(bflo(z.x)), o[dt][1] * inv * siluf_(bfhi(z.x))); wv.y = pk2(o[dt][2] * inv * siluf_(bflo(z.y)), o[dt][3] * inv * siluf_(bfhi(z.y)));
        *(u32x2*)(yb + off) = wv; }
}

__device__ __forceinline__ void phase_mix(const Params& p, unsigned char* shm, int T0, int round) {
    int* ctr = (int*)(p.ws + p.o_ctr) + round;
    LAS int* s_item = (LAS int*)((LAS unsigned char*)shm + L_ITEM);
    const int nseq = (T0 == 0) ? 1 + (p.Mr - TOK_P) / UNIT : p.Mr / UNIT;
    const int n_chain = nseq * 32, total = n_chain + (p.Mr / 64) * 8;
    for (;;) {
        __syncthreads();
        if (threadIdx.x == 0) *s_item = atomicAdd(ctr, 1);
        __syncthreads();
        const int item = *s_item;
        if (item >= total) break;
        if (item < n_chain) {
            const int si = item >> 5, combo = item & 31;
            int s0, len;
            if (T0 == 0) { if (si == 0) { s0 = 0; len = TOK_P; } else { s0 = TOK_P + (si - 1) * UNIT; len = UNIT; } } else { s0 = T0 + si * UNIT; len = UNIT; }
            mlstm_chain(p, shm, T0, s0, len, combo & 3, (combo >> 2) & 1, combo >> 3);
        } else {
            const int idx = item - n_chain;
            na_item(p, shm, T0, idx >> 3, idx & 7);
        }
    }
}

#ifndef PHM
#define PHM 0xFF
#endif
#define IN(k) (lo <= (k) && (k) < hi)
#define SEAM(k) do { if (IN(k) && IN((k) + 1)) grid.sync(); } while (0)
__device__ __forceinline__ void round_body(const Params& p, unsigned char* shm, cg::grid_group& grid, const int round, const int lo, const int hi) {
        const int T0 = round * p.Mr, pb = 1 + 7 * round;
        if ((PHM & 2) && IN(pb)) { EpiIn E; E.act = actp(p, 0); E.split_stride = (size_t)p.Mr * 1024; E.gates = (float*)(p.ws + p.o_gates); E.b_gate = p.b_gate;
            run_gemm(shm, (const us*)(p.ws + p.o_xn), (const us*)(p.ws + p.o_winT), p.Mr, NPAD, 1024, E); }
        SEAM(pb);
        if ((PHM & 4) && IN(pb + 1)) phase_conv(p, T0);
        SEAM(pb + 1);
        if ((PHM & 8) && IN(pb + 2)) phase_mix(p, shm, T0, round);
        SEAM(pb + 2);
        if ((PHM & 16) && IN(pb + 3)) phase_ya(p);
        SEAM(pb + 3);
        if ((PHM & 32) && IN(pb + 4)) {
            { EpiDA E; E.tmp = p.out + (size_t)T0 * 1024; E.ga = actp(p, 9); run_gemm(shm, (const us*)(p.ws + p.o_xn), (const us*)(p.ws + p.o_wdaT), p.Mr, 1024, 1024, E); }
            { EpiDB E; E.tmp = p.out + (size_t)T0 * 1024; E.gb = actp(p, 10); E.merged = actp(p, 1); run_gemm(shm, actp(p, 5), (const us*)(p.ws + p.o_wdbT), p.Mr, 1024, 1024, E); }
        }
        SEAM(pb + 4);
        if ((PHM & 64) && IN(pb + 5)) { EpiOut E; E.out = p.out + (size_t)T0 * 1024; E.xp = p.xp; E.xs = p.xs; E.T0 = T0; run_gemm(shm, actp(p, 1), (const us*)(p.ws + p.o_woutT), p.Mr, 1024, 1024, E); }
        SEAM(pb + 5);
        if ((PHM & 128) && IN(pb + 6)) { phase_fnorm(p, T0); if (round + 1 < p.nrounds) phase_xnorm(p, T0 + p.Mr); }
        if (round + 1 < p.nrounds) SEAM(pb + 6);
    }
__global__ __launch_bounds__(512, 2) void mega(Params p) {
    extern __shared__ __attribute__((aligned(16))) unsigned char shm[];
    cg::grid_group grid = cg::this_grid();
    const int lo = p.ph_lo, hi = p.ph_hi;
    if ((PHM & 1) && IN(0)) { phase_weights(p, shm); phase_xnorm(p, 0); }
    SEAM(0);
    round_body(p, shm, grid, 0, lo, hi);
    if (p.nrounds > 1) round_body(p, shm, grid, 1, lo, hi);
#undef IN
#undef SEAM
}

#ifndef N_LAUNCH_MODE
#define N_LAUNCH_MODE 1
#endif
extern "C" void kernel_launch(void* const* d_in, const int* in_sizes, int n_in, void* d_out, int out_size, void* d_ws, size_t ws_size, hipStream_t stream) {
    static int grid = 0;
    if (grid == 0) {
        int dev = 0, cus = 0, per_cu = 0;
        hipGetDevice(&dev); hipDeviceGetAttribute(&cus, hipDeviceAttributeMultiprocessorCount, dev);
        if (hipFuncSetAttribute((const void*)mega, hipFuncAttributeMaxDynamicSharedMemorySize, LDS_BYTES) != hipSuccess) fprintf(stderr, "kernel_launch: hipFuncSetAttribute failed\n");
        if (hipOccupancyMaxActiveBlocksPerMultiprocessor(&per_cu, (const void*)mega, 512, LDS_BYTES) != hipSuccess || per_cu < 1) { fprintf(stderr, "kernel_launch: occupancy query says %d\n", per_cu); per_cu = 1; }
        (void)hipGetLastError();
        grid = cus * 1;
        if (grid <= 0) grid = 256;
    }
    Params p{};
    p.xp = (const float*)d_in[0]; p.xs = (const float*)d_in[1]; p.norm_w = (const float*)d_in[2]; p.w_in = (const float*)d_in[3]; p.b_gate = (const float*)d_in[4];
    p.conv_w = (const float*)d_in[5]; p.conv_b = (const float*)d_in[6]; p.mh_w = (const float*)d_in[7]; p.rpb = (const float*)d_in[8];
    p.wda = (const float*)d_in[9]; p.wdb = (const float*)d_in[10]; p.wout = (const float*)d_in[11]; p.fnw = (const float*)d_in[12];
    p.out = (float*)d_out; p.ws = (unsigned char*)d_ws;
    size_t off = 0;
    p.o_winT = off; off += (size_t)NPAD * 1024 * 2;
    p.o_wdaT = off; off += (size_t)1024 * 1024 * 2; p.o_wdbT = off; off += (size_t)1024 * 1024 * 2; p.o_woutT = off; off += (size_t)1024 * 1024 * 2;
    p.o_ctr = off; off += 256;
    int Mr = TOK_ALL;
    while (Mr > 20480 && off + (size_t)Mr * (64 + 2048 + 11 * 2048) > ws_size) Mr >>= 1;
    p.Mr = Mr; p.nrounds = TOK_ALL / Mr;
    p.o_gates = off; off += (size_t)Mr * 64;
    p.o_xn = off; off += (size_t)Mr * 2048;
    p.o_act = off; off += (size_t)Mr * 11 * 2048;
    if (off > ws_size) { fprintf(stderr, "kernel_launch: workspace too small (%zu > %zu)\n", off, ws_size); return; }
    hipMemsetAsync((char*)d_ws + p.o_ctr, 0, 256, stream);
    const int nph = 1 + 7 * p.nrounds;
#if N_LAUNCH_MODE == 1
    p.ph_lo = 0; p.ph_hi = nph;
    void* args[] = {&p};
    hipError_t e = hipLaunchCooperativeKernel((const void*)mega, dim3(grid), dim3(512), args, LDS_BYTES, stream);
    if (e != hipSuccess) fprintf(stderr, "kernel_launch: cooperative launch failed: %s (grid %d)\n", hipGetErrorString(e), grid);
#else
    for (int ph = 0; ph < nph; ++ph) { p.ph_lo = ph; p.ph_hi = ph + 1; hipLaunchKernelGGL(mega, dim3(grid), dim3(512), LDS_BYTES, stream, p); }
#endif
}
```

```cpp
#include <hip/hip_runtime.h>
#include <hip/hip_cooperative_groups.h>
#include <cstdio>
namespace cg = cooperative_groups;
namespace pg8 {
#define PG8_LAS __attribute__((address_space(3)))
typedef unsigned short bf16_t;
typedef short bf16x8 __attribute__((ext_vector_type(8)));
typedef float f32x4 __attribute__((ext_vector_type(4)));
typedef unsigned u32x4 __attribute__((ext_vector_type(4)));
constexpr int BM = 256, BK = 64, HALF = 128, HTB = HALF * BK * 2  , STAGE_BYTES = 8 * HTB, NXCD = 8, WGM = 8;

__host__ __device__ __forceinline__ int lds_byte(int r, int c) { const int st = (r >> 4) * 2 + (c >> 5), rr = r & 15, cc = c & 31, ob = rr * 64 + cc * 2; return st * 1024 + (ob ^ (((ob >> 9) & 1) << 5)); }
__host__ __device__ __forceinline__ void stage_rc(int b, int& R, int& C) { const int st = b / 1024, sb = b % 1024, swz = sb ^ (((sb >> 9) & 1) << 5); R = (st >> 1) * 16 + swz / 64; C = (st & 1) * 32 + (swz % 64) / 2; }
__host__ __device__ __forceinline__ int perm32(int rho) { const int n = rho >> 4, i = rho & 15; return 8 * (i >> 2) + 4 * n + (i & 3); }

struct Unit { int pm, pn, w; };
struct Gemm { const bf16_t* A; const bf16_t* Bt; int M, N, K; const bf16_t* A2; const bf16_t* Bt2; };

struct StaticOrder {
    int nM, nN, nwg, G, c;
    __host__ __device__ void init(int M, int N, int G_, int c_) { nM = M / BM; nN = N / BM; nwg = nM * nN; G = G_; c = c_; }
    __host__ __device__ bool next(int i, Unit& u) const {
        const long L = (long)i * G + c; if (L >= nwg) return false;
        int wgid = (int)L; { const int q = nwg / NXCD, r = nwg % NXCD, xcd = wgid % NXCD, off = wgid / NXCD; wgid = (xcd < r ? xcd * (q + 1) : r * (q + 1) + (xcd - r) * q) + off; }
        const int nig = WGM * nN, gid = wgid / nig, fm = gid * WGM, gsz = (nM - fm) < WGM ? (nM - fm) : WGM;
        u.pm = fm + ((wgid % nig) % gsz); u.pn = (wgid % nig) / gsz; u.w = 0; return true;
    }
    __device__ __forceinline__ void a_ready(const Unit&) const {}
    __device__ __forceinline__ void done(const Unit&) const {}
};
__device__ __forceinline__ unsigned cvt_pk_bf16(float lo, float hi) { unsigned r; asm volatile("v_cvt_pk_bf16_f32 %0, %1, %2" : "=v"(r) : "v"(lo), "v"(hi)); return r; }
template <class Epi, class Sched, bool STAMP = false>
__device__ __forceinline__ void gemm_phase(PG8_LAS unsigned char* lds, const Gemm g, const Sched& S, const Epi& E, unsigned long long* stamps) {
    const int tid = threadIdx.x, wid = __builtin_amdgcn_readfirstlane(tid >> 6), lane = tid & 63, wr = wid >> 2, wc = wid & 3, fr = lane & 15, fq = lane >> 4;
    const int K = g.K, nt = K / BK;
    int ts_lo = 0, ts_hi = 0, nts = 0; const unsigned long long rt_entry = STAMP ? (unsigned long long)wall_clock64() : 0ull;
#define PG8_STAMP() do { if (STAMP && wid == 0 && nts < 64) { const unsigned long long _c = (unsigned long long)clock64(); \
        ts_lo = (lane == nts) ? (int)(unsigned)_c : ts_lo; ts_hi = (lane == nts) ? (int)(unsigned)(_c >> 32) : ts_hi; ++nts; } } while (0)
    PG8_STAMP();
    unsigned voffA[2], voffB[2];
#pragma unroll
    for (int i = 0; i < 2; ++i) { int R, C; stage_rc(tid * 16 + i * 8192, R, C); const int Rb = Epi::PERM ? ((R & ~31) + perm32(R & 31)) : R;
        voffA[i] = (unsigned)(R * K + C) * 2u; voffB[i] = (unsigned)(Rb * K + C) * 2u; }
    const size_t kstep = (size_t)(BK * 2);
    const size_t hstep = (size_t)HALF * K * 2;
    const size_t tstep = 2 * hstep;
    const unsigned ldsw = (unsigned)wid * 1024u;
    const int aoff = lds_byte(wr * 64 + fr, fq * 8), boff = lds_byte(wc * 32 + fr, fq * 8);
#define PG8_SA(b, h) (((b) * 2 + (h)) * HTB)
#define PG8_SB(b, h) ((4 + (b) * 2 + (h)) * HTB)
#define PG8_STAGE(bufoff, gbase, voff) do { _Pragma("unroll") for (int _i = 0; _i < 2; ++_i) \
        __builtin_amdgcn_global_load_lds((const unsigned*)((const char*)(gbase) + (voff)[_i]), (PG8_LAS unsigned*)(lds + (bufoff) + ldsw + _i * 8192), 16, 0, 0); } while (0)
#define PG8_LDA(dst, b, h) do { _Pragma("unroll") for (int m = 0; m < 4; ++m) _Pragma("unroll") for (int k = 0; k < 2; ++k) dst[m][k] = *(const PG8_LAS bf16x8*)(lds + PG8_SA(b, h) + aoff + m * 2048 + k * 1024); } while (0)
#define PG8_LDB(dst, b, h) do { _Pragma("unroll") for (int n = 0; n < 2; ++n) _Pragma("unroll") for (int k = 0; k < 2; ++k) dst[n][k] = *(const PG8_LAS bf16x8*)(lds + PG8_SB(b, h) + boff + n * 2048 + k * 1024); } while (0)
#define PG8_MMA(ai, bj, At, Bt) do { __builtin_amdgcn_s_setprio(1); _Pragma("unroll") for (int m = 0; m < 4; ++m) _Pragma("unroll") for (int n = 0; n < 2; ++n) _Pragma("unroll") for (int k = 0; k < 2; ++k) \
        acc[ai][bj][m][n] = __builtin_amdgcn_mfma_f32_16x16x32_bf16(Bt[n][k], At[m][k], acc[ai][bj][m][n], 0, 0, 0); __builtin_amdgcn_s_setprio(0); } while (0)
#define PG8_WAIT_V(n) asm volatile("s_waitcnt vmcnt(" #n ")" ::: "memory")
#define PG8_WAIT_L(n) asm volatile("s_waitcnt lgkmcnt(" #n ")" ::: "memory")
#define PG8_BAR __builtin_amdgcn_s_barrier()
#define PG8_SCHED __builtin_amdgcn_sched_barrier(0)
    Unit cur, nxt; int ui = 0;
    if (!S.next(0, cur)) return;
    f32x4 acc[2][2][4][2];
#pragma unroll
    for (int a = 0; a < 2; ++a)
#pragma unroll
        for (int b = 0; b < 2; ++b)
#pragma unroll
            for (int m = 0; m < 4; ++m)
#pragma unroll
                for (int n = 0; n < 2; ++n) acc[a][b][m][n] = (f32x4){0.f, 0.f, 0.f, 0.f};
    bf16x8 At[4][2], B0[2][2], B1[2][2];
    const char* cA = (const char*)(cur.w ? g.A2 : g.A) + (size_t)cur.pm * tstep; const char* cB = (const char*)(cur.w ? g.Bt2 : g.Bt) + (size_t)cur.pn * tstep;
    S.a_ready(cur);
    PG8_STAGE(PG8_SB(0, 0), cB, voffB); PG8_STAGE(PG8_SA(0, 0), cA, voffA); PG8_STAGE(PG8_SB(0, 1), cB + hstep, voffB); PG8_STAGE(PG8_SA(0, 1), cA + hstep, voffA);
    if (wr == 1) PG8_BAR;
    PG8_WAIT_V(4); PG8_BAR;
    PG8_STAGE(PG8_SB(1, 0), cB + kstep, voffB); PG8_STAGE(PG8_SA(1, 0), cA + kstep, voffA); PG8_STAGE(PG8_SB(1, 1), cB + hstep + kstep, voffB);
    PG8_WAIT_V(6); PG8_BAR;
    PG8_STAMP();
    for (;;) {
        const bool has_next = S.next(ui + 1, nxt);
        const char* nA = has_next ? (const char*)(nxt.w ? g.A2 : g.A) + (size_t)nxt.pm * tstep : cA; const char* nB = has_next ? (const char*)(nxt.w ? g.Bt2 : g.Bt) + (size_t)nxt.pn * tstep : cB;
        for (int t = 0; t < nt; t += 2) {
            const bool last = (t == nt - 2);
            const char* a1 = cA + (size_t)(t + 1) * kstep;
            const char* a2 = last ? nA : cA + (size_t)(t + 2) * kstep; const char* b2 = last ? nB : cB + (size_t)(t + 2) * kstep;
            const char* a3 = a2 + kstep; const char* b3 = b2 + kstep;
            if (last && has_next) S.a_ready(nxt);
            PG8_LDB(B0, 0, 0); PG8_SCHED; PG8_LDA(At, 0, 0); PG8_STAGE(PG8_SA(1, 1), a1 + hstep, voffA);
            PG8_WAIT_L(8); PG8_BAR; PG8_WAIT_L(0); PG8_MMA(0, 0, At, B0); PG8_BAR; PG8_SCHED;
            PG8_LDB(B1, 0, 1); PG8_STAGE(PG8_SB(0, 0), b2, voffB);
            PG8_BAR; PG8_WAIT_L(0); PG8_MMA(0, 1, At, B1); PG8_BAR;
            PG8_LDA(At, 0, 1); PG8_STAGE(PG8_SA(0, 0), a2, voffA);
            PG8_BAR; PG8_WAIT_L(0); PG8_MMA(1, 0, At, B0); PG8_BAR; PG8_SCHED;
            PG8_STAGE(PG8_SB(0, 1), b2 + hstep, voffB);
            PG8_WAIT_V(6); PG8_BAR; PG8_MMA(1, 1, At, B1); PG8_BAR;
            PG8_LDB(B0, 1, 0); PG8_SCHED; PG8_LDA(At, 1, 0); PG8_STAGE(PG8_SA(0, 1), a2 + hstep, voffA);
            PG8_WAIT_L(8); PG8_BAR; PG8_WAIT_L(0); PG8_MMA(0, 0, At, B0); PG8_BAR; PG8_SCHED;
            PG8_LDB(B1, 1, 1); PG8_STAGE(PG8_SB(1, 0), b3, voffB);
            PG8_BAR; PG8_WAIT_L(0); PG8_MMA(0, 1, At, B1); PG8_BAR;
            PG8_LDA(At, 1, 1); PG8_STAGE(PG8_SA(1, 0), a3, voffA);
            PG8_BAR; PG8_WAIT_L(0); PG8_MMA(1, 0, At, B0); PG8_BAR; PG8_SCHED;
            PG8_STAGE(PG8_SB(1, 1), b3 + hstep, voffB);
            PG8_WAIT_V(6); PG8_BAR; PG8_MMA(1, 1, At, B1); PG8_BAR;
        }
        PG8_STAMP();
        if constexpr (!Epi::AFTER_DRAIN) { E(acc, cur, wr, wc, fr, fq); S.done(cur); }
        PG8_STAMP();
        if (!has_next) break;
        if (!(Epi::PAIR && cur.w == 0)) {
#pragma unroll
        for (int a = 0; a < 2; ++a)
#pragma unroll
            for (int b = 0; b < 2; ++b)
#pragma unroll
                for (int m = 0; m < 4; ++m)
#pragma unroll
                    for (int n = 0; n < 2; ++n) acc[a][b][m][n] = (f32x4){0.f, 0.f, 0.f, 0.f};
        }
        cur = nxt; cA = nA; cB = nB; ++ui;
    }
    PG8_WAIT_V(0);
    if (wr == 0) PG8_BAR;
    PG8_BAR;
    if constexpr (Epi::AFTER_DRAIN) { E.fused(acc, cur, wr, wc, fr, fq, lds, wid, lane); S.done(cur); }
    PG8_STAMP();
    if (STAMP && wid == 0) { stamps[lane] = lane < nts ? (((unsigned long long)(unsigned)ts_hi << 32) | (unsigned)ts_lo) : 0ull;
        if (lane == 62) stamps[62] = rt_entry; if (lane == 63) stamps[63] = (unsigned long long)wall_clock64(); }
#undef PG8_STAMP
#undef PG8_SA
#undef PG8_SB
#undef PG8_STAGE
#undef PG8_LDA
#undef PG8_LDB
#undef PG8_MMA
#undef PG8_WAIT_V
#undef PG8_WAIT_L
#undef PG8_BAR
#undef PG8_SCHED
}
}

#define LAS __attribute__((address_space(3)))
typedef unsigned short us;
typedef short bf16x8 __attribute__((ext_vector_type(8)));
typedef short s16x4 __attribute__((ext_vector_type(4)));
typedef float f32x4 __attribute__((ext_vector_type(4)));
typedef unsigned u32x4 __attribute__((ext_vector_type(4)));
typedef unsigned u32x2 __attribute__((ext_vector_type(2)));

constexpr int TOK_P = 16384, TOK_ALL = 81920, UNIT = 2048;
constexpr int DIN = 11280, NPAD = 11520;
constexpr int LDS_BYTES = 163840;
constexpr int L_ITEM = LDS_BYTES - 16;
constexpr int QS = 528, VS = 144;
constexpr int VSW = 176;
constexpr int L_Q = 0, L_K = 33792, L_ST = 67584, L_V = 101376, L_VW = 110592, L_P = 121856, L_SM = 131072;
constexpr int SM_W = 256, SM_QN = 320, SM_RS = 384  , SM_N = 640  ;
constexpr int L_NP = 132864  , L_GU = 134912, L_GC = 143104, L_GB = 151296, L_GM = 159488;
constexpr int NA_VH = 73728, L_RPB = 147456;

struct Params {
    const float *xp, *xs, *norm_w, *w_in, *b_gate, *conv_w, *conv_b, *mh_w, *rpb, *wda, *wdb, *wout, *fnw;
    float* out;
    unsigned char* ws;
    unsigned long long o_winT, o_wdaT, o_wdbT, o_woutT, o_ctr, o_bar, o_state, o_gates, o_xn, o_act;
    int Mr, nrounds, ph_lo, ph_hi;
};

__device__ __forceinline__ us f2bf(float f) { unsigned u = __float_as_uint(f); u += 0x7FFFu + ((u >> 16) & 1u); return (us)(u >> 16); }
__device__ __forceinline__ float bf2f(unsigned b) { return __uint_as_float(b << 16); }
typedef float f32x2_ __attribute__((ext_vector_type(2)));
typedef __bf16 bf16x2_ __attribute__((ext_vector_type(2)));
__device__ __forceinline__ unsigned pk2(float lo, float hi) { f32x2_ v = {lo, hi}; bf16x2_ b = __builtin_convertvector(v, bf16x2_); return __builtin_bit_cast(unsigned, b); }
__device__ __forceinline__ float bflo(unsigned w) { return __uint_as_float(w << 16); }
__device__ __forceinline__ float bfhi(unsigned w) { return __uint_as_float(w & 0xFFFF0000u); }
__device__ __forceinline__ float sigmoidf_(float x) { return __builtin_amdgcn_rcpf(1.0f + __expf(-x)); }
__device__ __forceinline__ float siluf_(float x) { return x * __builtin_amdgcn_rcpf(1.0f + __expf(-x)); }
__device__ __forceinline__ const float* xrow(const Params& p, int t) { return t < TOK_P ? p.xp + (size_t)t * 1024 : p.xs + (size_t)(t - TOK_P) * 1024; }
__device__ __forceinline__ void seq_of(int t, int& s0, int& len) { if (t < TOK_P) { s0 = 0; len = TOK_P; } else { s0 = TOK_P + ((t - TOK_P) / UNIT) * UNIT; len = UNIT; } }
__device__ __forceinline__ us* actp(const Params& p, int i) { return (us*)(p.ws + p.o_act) + (size_t)i * p.Mr * 1024; }
__device__ __forceinline__ f32x4 mfma16(bf16x8 a, bf16x8 b, f32x4 c) { return __builtin_amdgcn_mfma_f32_16x16x32_bf16(a, b, c, 0, 0, 0); }
__device__ __forceinline__ bf16x8 tr8(LAS unsigned char* base, int off0, int off1) {
    s16x4 lo = __builtin_amdgcn_ds_read_tr16_b64_v4i16((LAS s16x4*)(base + off0));
    s16x4 hi = __builtin_amdgcn_ds_read_tr16_b64_v4i16((LAS s16x4*)(base + off1));
    return __builtin_shufflevector(lo, hi, 0, 1, 2, 3, 4, 5, 6, 7);
}

struct EpiIn {
    static constexpr bool PERM = true, AFTER_DRAIN = false, PAIR = false;
    us* act; size_t split_stride; float* gates; const float* b_gate;
    __device__ __forceinline__ void operator()(const pg8::f32x4 (&acc)[2][2][4][2], const pg8::Unit& u, int wr, int wc, int fr, int fq) const {
        const int row0 = u.pm * 256 + wr * 64 + fr;
        if (u.pn < 44) {
            const int t = u.pn >> 2;
            us* base = act + (size_t)t * split_stride;
            const int col0 = (u.pn & 3) * 256 + wc * 32 + 8 * fq;
            if (t >= 5 && t <= 7) {
                const size_t hstride = split_stride >> 4;
#pragma unroll
                for (int ai = 0; ai < 2; ++ai)
#pragma unroll
                    for (int m = 0; m < 4; ++m) { const size_t ro = (size_t)(row0 + ai * 128 + m * 16) * 64;
#pragma unroll
                        for (int bj = 0; bj < 2; ++bj) { const pg8::f32x4 v0 = acc[ai][bj][m][0], v1 = acc[ai][bj][m][1]; const int col = col0 + bj * 128;
                            u32x4 w; w.x = pk2(v0[0], v0[1]); w.y = pk2(v0[2], v0[3]); w.z = pk2(v1[0], v1[1]); w.w = pk2(v1[2], v1[3]);
                            *(u32x4*)(base + (size_t)(col >> 6) * hstride + ro + (col & 63)) = w; } }
            } else
#pragma unroll
            for (int ai = 0; ai < 2; ++ai)
#pragma unroll
                for (int m = 0; m < 4; ++m) { us* rowp = base + (size_t)(row0 + ai * 128 + m * 16) * 1024 + col0;
#pragma unroll
                    for (int bj = 0; bj < 2; ++bj) { const pg8::f32x4 v0 = acc[ai][bj][m][0], v1 = acc[ai][bj][m][1];
                        u32x4 w; w.x = pk2(v0[0], v0[1]); w.y = pk2(v0[2], v0[3]); w.z = pk2(v1[0], v1[1]); w.w = pk2(v1[2], v1[3]);
                        *(u32x4*)(rowp + bj * 128) = w; } }
        } else {
            if (wc == 0 && fq < 2) {
#pragma unroll
                for (int n = 0; n < 2; ++n) { const int c = 8 * fq + 4 * n; const f32x4 bv = *(const f32x4*)(b_gate + c);
#pragma unroll
                    for (int ai = 0; ai < 2; ++ai)
#pragma unroll
                        for (int m = 0; m < 4; ++m) { const int row = row0 + ai * 128 + m * 16; *(f32x4*)(gates + (size_t)row * 16 + c) = acc[ai][0][m][n] + bv; } }
            }
        }
    }
};
struct PairOrder : pg8::StaticOrder {
    __device__ bool next(int i, pg8::Unit& u) const { const bool ok = pg8::StaticOrder::next(i >> 1, u); u.w = i & 1; return ok; }
};
struct EpiPair {
    static constexpr bool PERM = true, AFTER_DRAIN = false, PAIR = true;
    const us* ga; const us* gb; us* merged;
    __device__ __forceinline__ void operator()(pg8::f32x4 (&acc)[2][2][4][2], const pg8::Unit& u, int wr, int wc, int fr, int fq) const {
        const int row0 = u.pm * 256 + wr * 64 + fr, col0 = u.pn * 256 + wc * 32 + 8 * fq;
        if (u.w == 0) {
#pragma unroll
            for (int ai = 0; ai < 2; ++ai) {
                u32x4 a[4][2], b[4][2];
#pragma unroll
                for (int m = 0; m < 4; ++m)
#pragma unroll
                    for (int bj = 0; bj < 2; ++bj) { const size_t o = (size_t)(row0 + ai * 128 + m * 16) * 1024 + col0 + bj * 128; a[m][bj] = *(const u32x4*)(ga + o); b[m][bj] = *(const u32x4*)(gb + o); }
#pragma unroll
                for (int m = 0; m < 4; ++m)
#pragma unroll
                    for (int bj = 0; bj < 2; ++bj)
#pragma unroll
                        for (int q = 0; q < 4; ++q) { const unsigned aw = a[m][bj][q], bw = b[m][bj][q];
                            const float r0 = (1.0f + __expf(-bflo(bw))) * __builtin_amdgcn_rcpf(1.0f + __expf(-bflo(aw))), r1 = (1.0f + __expf(-bfhi(bw))) * __builtin_amdgcn_rcpf(1.0f + __expf(-bfhi(aw)));
                            acc[ai][bj][m][q >> 1][(q & 1) * 2] *= r0; acc[ai][bj][m][q >> 1][(q & 1) * 2 + 1] *= r1; }
                asm volatile("" ::: "memory");
            }
        } else {
#pragma unroll
            for (int ai = 0; ai < 2; ++ai) {
                u32x4 b[4][2];
#pragma unroll
                for (int m = 0; m < 4; ++m)
#pragma unroll
                    for (int bj = 0; bj < 2; ++bj) { const size_t o = (size_t)(row0 + ai * 128 + m * 16) * 1024 + col0 + bj * 128; b[m][bj] = *(const u32x4*)(gb + o); }
#pragma unroll
                for (int m = 0; m < 4; ++m)
#pragma unroll
                    for (int bj = 0; bj < 2; ++bj) { const size_t o = (size_t)(row0 + ai * 128 + m * 16) * 1024 + col0 + bj * 128; u32x4 w;
#pragma unroll
                        for (int q = 0; q < 4; ++q) { const unsigned bw = b[m][bj][q];
                            w[q] = pk2(acc[ai][bj][m][q >> 1][(q & 1) * 2] * sigmoidf_(bflo(bw)), acc[ai][bj][m][q >> 1][(q & 1) * 2 + 1] * sigmoidf_(bfhi(bw))); }
                        *(u32x4*)(merged + o) = w; }
                asm volatile("" ::: "memory");
            }
        }
    }
};
struct EpiOut {
    static constexpr bool PERM = false, AFTER_DRAIN = false, PAIR = false;
    float* out; const float* xp; const float* xs; int T0;
    __device__ __forceinline__ void operator()(const pg8::f32x4 (&acc)[2][2][4][2], const pg8::Unit& u, int wr, int wc, int fr, int fq) const {
        const int row0 = u.pm * 256 + wr * 64 + fr, col0 = u.pn * 256 + wc * 32 + 4 * fq;
#pragma unroll
        for (int ai = 0; ai < 2; ++ai)
#pragma unroll
            for (int m = 0; m < 4; ++m) { const int row = row0 + ai * 128 + m * 16; const int t = T0 + row;
                const float* xr = (t < TOK_P ? xp + (size_t)t * 1024 : xs + (size_t)(t - TOK_P) * 1024) + col0; float* orow = out + (size_t)row * 1024 + col0;
#pragma unroll
                for (int bj = 0; bj < 2; ++bj)
#pragma unroll
                    for (int n = 0; n < 2; ++n) { const int o = bj * 128 + n * 16; *(f32x4*)(orow + o) = *(const f32x4*)(xr + o) + acc[ai][bj][m][n]; } }
    }
};

template <class Epi> __device__ __forceinline__ void run_gemm(unsigned char* shm, const us* A, const us* Bt, int M, int N, int K, const Epi& E) {
    pg8::Gemm g; g.A = A; g.Bt = Bt; g.M = M; g.N = N; g.K = K; g.A2 = A; g.Bt2 = Bt;
    pg8::StaticOrder S; S.init(M, N, (int)gridDim.x, (int)blockIdx.x);
    pg8::gemm_phase<Epi, pg8::StaticOrder, false>((LAS unsigned char*)shm, g, S, E, nullptr);
}

__device__ __forceinline__ void run_gemm_pair(unsigned char* shm, const us* A, const us* Bt, const us* A2, const us* Bt2, int M, int N, int K, const EpiPair& E) {
    pg8::Gemm g; g.A = A; g.Bt = Bt; g.M = M; g.N = N; g.K = K; g.A2 = A2; g.Bt2 = Bt2;
    PairOrder S; S.init(M, N, (int)gridDim.x, (int)blockIdx.x);
    pg8::gemm_phase<EpiPair, PairOrder, false>((LAS unsigned char*)shm, g, S, E, nullptr);
}

__device__ __forceinline__ void phase_weights(const Params& p, unsigned char* shm) {
    float* tile = (float*)shm;
    const int tid = threadIdx.x;
    for (int job = blockIdx.x; job < 2880 + 768; job += gridDim.x) {
        const float* src; int ld, col0, nvalid, kt; us* dst;
        if (job < 2880) { const int nt = job >> 4; kt = job & 15; src = p.w_in; ld = DIN; const int n0 = nt * 64;
            if (n0 < 5120) { col0 = n0; nvalid = 64; } else if (n0 < 11264) { col0 = n0 + 16; nvalid = 64; } else if (n0 == 11264) { col0 = 5120; nvalid = 16; } else { col0 = 0; nvalid = 0; }
            dst = (us*)(p.ws + p.o_winT) + (size_t)n0 * 1024;
        } else { const int j2 = job - 2880, which = j2 >> 8, t = j2 & 255, nt = t >> 4; kt = t & 15; ld = 1024; col0 = nt * 64; nvalid = 64;
            src = which == 0 ? p.wda : (which == 1 ? p.wdb : p.wout);
            dst = (us*)(p.ws + (which == 0 ? p.o_wdaT : (which == 1 ? p.o_wdbT : p.o_woutT))) + (size_t)nt * 64 * 1024; }
        __syncthreads();
        { const int j = tid & 63, i0 = tid >> 6;
#pragma unroll
          for (int ii = 0; ii < 8; ++ii) { const int i = i0 + 8 * ii; tile[i * 65 + j] = (j < nvalid) ? src[(size_t)(kt * 64 + i) * ld + col0 + j] : 0.f; } }
        __syncthreads();
        { const int j = tid & 63, kg = tid >> 6;
          u32x4 wv; wv.x = pk2(tile[(kg * 8 + 0) * 65 + j], tile[(kg * 8 + 1) * 65 + j]); wv.y = pk2(tile[(kg * 8 + 2) * 65 + j], tile[(kg * 8 + 3) * 65 + j]);
          wv.z = pk2(tile[(kg * 8 + 4) * 65 + j], tile[(kg * 8 + 5) * 65 + j]); wv.w = pk2(tile[(kg * 8 + 6) * 65 + j], tile[(kg * 8 + 7) * 65 + j]);
          *(u32x4*)(dst + (size_t)j * 1024 + kt * 64 + kg * 8) = wv; }
    }
    __syncthreads();
}

__device__ __forceinline__ void phase_xnorm(const Params& p, int T0, int Mc) {
    const int wave = threadIdx.x >> 6, lane = threadIdx.x & 63;
    us* xn = (us*)(p.ws + p.o_xn);
    f32x4 nw[4];
#pragma unroll
    for (int j = 0; j < 4; ++j) nw[j] = *(const f32x4*)(p.norm_w + lane * 4 + 256 * j);
    for (int r = blockIdx.x * 8 + wave; r < Mc; r += gridDim.x * 8) {
        const float* xr = xrow(p, T0 + r);
        f32x4 v[4]; float ss = 0.f;
#pragma unroll
        for (int j = 0; j < 4; ++j) { v[j] = *(const f32x4*)(xr + lane * 4 + 256 * j); ss += v[j][0] * v[j][0] + v[j][1] * v[j][1] + v[j][2] * v[j][2] + v[j][3] * v[j][3]; }
#pragma unroll
        for (int o = 32; o >= 1; o >>= 1) ss += __shfl_xor(ss, o);
        const float rs = rsqrtf(ss * (1.0f / 1024.0f) + 1e-6f);
#pragma unroll
        for (int j = 0; j < 4; ++j) { u32x2 w; w.x = pk2(v[j][0] * rs * nw[j][0], v[j][1] * rs * nw[j][1]); w.y = pk2(v[j][2] * rs * nw[j][2], v[j][3] * rs * nw[j][3]);
            *(u32x2*)(xn + (size_t)r * 1024 + lane * 4 + 256 * j) = w; }
    }
}

__device__ __forceinline__ void phase_fnorm(const Params& p, int T0, int Mc) {
    const int wave = threadIdx.x >> 6, lane = threadIdx.x & 63;
    f32x4 nw[4];
#pragma unroll
    for (int j = 0; j < 4; ++j) nw[j] = *(const f32x4*)(p.fnw + lane * 4 + 256 * j);
    for (int r = blockIdx.x * 8 + wave; r < Mc; r += gridDim.x * 8) {
        float* xr = p.out + (size_t)(T0 + r) * 1024;
        f32x4 v[4]; float ss = 0.f;
#pragma unroll
        for (int j = 0; j < 4; ++j) { v[j] = *(const f32x4*)(xr + lane * 4 + 256 * j); ss += v[j][0] * v[j][0] + v[j][1] * v[j][1] + v[j][2] * v[j][2] + v[j][3] * v[j][3]; }
#pragma unroll
        for (int o = 32; o >= 1; o >>= 1) ss += __shfl_xor(ss, o);
        const float rs = rsqrtf(ss * (1.0f / 1024.0f) + 1e-6f);
#pragma unroll
        for (int j = 0; j < 4; ++j) { f32x4 w; w[0] = v[j][0] * rs * nw[j][0]; w[1] = v[j][1] * rs * nw[j][1]; w[2] = v[j][2] * rs * nw[j][2]; w[3] = v[j][3] * rs * nw[j][3];
            *(f32x4*)(xr + lane * 4 + 256 * j) = w; }
    }
}

__device__ __forceinline__ void phase_gates(const Params& p, int Mc) {
    const int wave = threadIdx.x >> 6, lane = threadIdx.x & 63, fr = lane & 15, fq = lane >> 4;
    const us* xn = (const us*)(p.ws + p.o_xn);
    const us* wg = (const us*)(p.ws + p.o_winT) + (size_t)(11264 + fr) * 1024 + fq * 8;
    float* gates = (float*)(p.ws + p.o_gates);
    const float bias = p.b_gate[fr];
    for (int task = blockIdx.x * 8 + wave; task < Mc / 16; task += gridDim.x * 8) {
        const us* ar = xn + (size_t)(task * 16 + fr) * 1024 + fq * 8;
        f32x4 acc0 = (f32x4){0.f, 0.f, 0.f, 0.f}, acc1 = acc0;
#pragma unroll 8
        for (int kk = 0; kk < 32; kk += 2) {
            const bf16x8 a0 = *(const bf16x8*)(ar + kk * 32), a1 = *(const bf16x8*)(ar + kk * 32 + 32);
            const bf16x8 b0 = *(const bf16x8*)(wg + kk * 32), b1 = *(const bf16x8*)(wg + kk * 32 + 32);
            acc0 = mfma16(a0, b0, acc0); acc1 = mfma16(a1, b1, acc1);
        }
#pragma unroll
        for (int i = 0; i < 4; ++i) gates[(size_t)(task * 16 + 4 * fq + i) * 16 + fr] = acc0[i] + acc1[i] + bias;
    }
}

__device__ __forceinline__ void phase_conv(const Params& p, int T0, int Mc) {
    const int tid = threadIdx.x, ct = tid & 255, tensor = ct >> 7, cgp = ct & 127, sub = tid >> 8;
    const us* src = actp(p, tensor);
    us* dst = (us*)(p.out + (size_t)T0 * 1024) + (size_t)tensor * Mc * 1024;
    const int ch0 = tensor * 1024 + cgp * 8;
    float w[5][8], b[8];
#pragma unroll
    for (int e = 0; e < 8; ++e) { b[e] = p.conv_b[ch0 + e];
#pragma unroll
        for (int i = 0; i < 5; ++i) w[i][e] = p.conv_w[i * 2048 + ch0 + e]; }
    const float oscale = tensor ? 0.0625f : 1.0f;
    for (int item = blockIdx.x; item < Mc / 32; item += gridDim.x) {
        const int r0 = (item * 2 + sub) * 16;
        int s0, len; seq_of(T0 + r0, s0, len);
        const int lo = s0 - T0, hi = lo + len;
        u32x4 rows[20];
#pragma unroll
        for (int i = 0; i < 20; ++i) { const int r = r0 - 2 + i; rows[i] = (r >= lo && r < hi) ? *(const u32x4*)(src + (size_t)r * 1024 + cgp * 8) : (u32x4){0u, 0u, 0u, 0u}; }
#pragma unroll
        for (int o = 0; o < 16; ++o) {
            float a[8];
#pragma unroll
            for (int e = 0; e < 8; ++e) a[e] = b[e];
#pragma unroll
            for (int i = 0; i < 5; ++i) { const u32x4 rw = rows[o + i];
                a[0] += w[i][0] * bflo(rw.x); a[1] += w[i][1] * bfhi(rw.x); a[2] += w[i][2] * bflo(rw.y); a[3] += w[i][3] * bfhi(rw.y);
                a[4] += w[i][4] * bflo(rw.z); a[5] += w[i][5] * bfhi(rw.z); a[6] += w[i][6] * bflo(rw.w); a[7] += w[i][7] * bfhi(rw.w); }
#pragma unroll
            for (int e = 0; e < 8; ++e) a[e] = siluf_(a[e]) * oscale;
            u32x4 wv; wv.x = pk2(a[0], a[1]); wv.y = pk2(a[2], a[3]); wv.z = pk2(a[4], a[5]); wv.w = pk2(a[6], a[7]);
            *(u32x4*)(dst + (size_t)(r0 + o) * 1024 + cgp * 8) = wv;
        }
    }
}

__device__ __forceinline__ void phase_ya(const Params& p, int Mc) {
    const int wave = threadIdx.x >> 6, lane = threadIdx.x & 63;
    const us* hf = actp(p, 0); const us* hb = actp(p, 1); const us* mo = actp(p, 3); const us* mz = actp(p, 4);
    us* ya = actp(p, 0);
    float mw[16];
#pragma unroll
    for (int i = 0; i < 16; ++i) mw[i] = p.mh_w[lane * 16 + i];
    for (int r = blockIdx.x * 8 + wave; r < Mc; r += gridDim.x * 8) {
        const size_t o = (size_t)r * 1024 + lane * 16;
        float h[16]; float ss = 0.f;
        unsigned zz[8];
#pragma unroll
        for (int c = 0; c < 2; ++c) {
            const u32x4 a = *(const u32x4*)(hf + o + c * 8), b = *(const u32x4*)(hb + o + c * 8), g = *(const u32x4*)(mo + o + c * 8), z = *(const u32x4*)(mz + o + c * 8);
#pragma unroll
            for (int q = 0; q < 4; ++q) { const unsigned aw = a[q], bw = b[q], gw = g[q];
                h[c * 8 + 2 * q] = (bflo(aw) + bflo(bw)) * sigmoidf_(bflo(gw)); h[c * 8 + 2 * q + 1] = (bfhi(aw) + bfhi(bw)) * sigmoidf_(bfhi(gw)); zz[c * 4 + q] = z[q]; }
        }
#pragma unroll
        for (int i = 0; i < 16; ++i) ss += h[i] * h[i];
        ss += __shfl_xor(ss, 1); ss += __shfl_xor(ss, 2); ss += __shfl_xor(ss, 4); ss += __shfl_xor(ss, 8);
        const float rn = rsqrtf(ss * (1.0f / 256.0f) + 1e-6f);
        unsigned w[8];
#pragma unroll
        for (int q = 0; q < 8; ++q) w[q] = pk2(h[2 * q] * rn * mw[2 * q] * siluf_(bflo(zz[q])), h[2 * q + 1] * rn * mw[2 * q + 1] * siluf_(bfhi(zz[q])));
        *(u32x4*)(ya + o) = (u32x4){w[0], w[1], w[2], w[3]}; *(u32x4*)(ya + o + 8) = (u32x4){w[4], w[5], w[6], w[7]};
    }
}

constexpr int ST_REC = 16896;
template <bool STATE_ONLY>
__device__ __forceinline__ void mlstm_chain(const Params& p, unsigned char* shm, int T0, int Mc, int s0, int len, int head, int dir, int split, int c0, int c1,
                                            const float* st_in, int n_prev, float* st_out) {
    LAS unsigned char* lds = (LAS unsigned char*)shm;
    LAS float* sm = (LAS float*)(lds + L_SM);
    const int tid = threadIdx.x, w = tid >> 6, lane = tid & 63, fr = lane & 15, fq = lane >> 4;
    const us* qc = (const us*)(p.out + (size_t)T0 * 1024); const us* kc = qc + (size_t)Mc * 1024;
    const us* mv = actp(p, 2); const float* gates = (const float*)(p.ws + p.o_gates);
    us* hout = actp(p, dir);
    const int base = dir ? (s0 + len - 1 - T0) : (s0 - T0); const int sgn = dir ? -1 : 1;
    const size_t hoff = (size_t)head * 256;
    u32x4 rq[4], rk[4], rv;
    LAS float* GU = (LAS float*)(lds + L_GU); LAS float* GC = (LAS float*)(lds + L_GC); LAS float* GB = (LAS float*)(lds + L_GB); LAS float* GM = (LAS float*)(lds + L_GM); LAS unsigned char* NBF = lds + L_NP;
    f32x4 Sacc[2][5];
#pragma unroll
    for (int a = 0; a < 2; ++a)
#pragma unroll
        for (int b = 0; b < 5; ++b) Sacc[a][b] = (f32x4){0.f, 0.f, 0.f, 0.f};
    float mstate = 0.f;
    if constexpr (!STATE_ONLY) {
        float nval = 0.f;
        for (int g = 0; g < n_prev; ++g) { const float* rec = st_in + (size_t)g * ST_REC; const float m_loc = rec[16640], B = rec[16641];
            const float m_new = fmaxf(B + mstate, m_loc), a1 = __expf(B + mstate - m_new), a2 = __expf(m_loc - m_new);
#pragma unroll
            for (int dd = 0; dd < 2; ++dd)
#pragma unroll
                for (int e4 = 0; e4 < 4; ++e4) { const f32x4 sl = *(const f32x4*)(rec + (size_t)((((w * 2 + dd) * 4 + e4) * 64 + lane) * 4)); Sacc[dd][e4] = a1 * Sacc[dd][e4] + a2 * sl; }
            if (tid < 256) nval = a1 * nval + a2 * rec[16384 + tid];
            mstate = m_new; }
        if (tid < 256) sm[SM_N + tid] = nval;
        __syncthreads();
#pragma unroll
        for (int dd = 0; dd < 2; ++dd)
#pragma unroll
            for (int i = 0; i < 4; ++i) Sacc[dd][4][i] = (fr == 0) ? sm[SM_N + (w * 2 + dd) * 16 + 4 * fq + i] : 0.f;
        if (fr == 0) {
#pragma unroll
            for (int dd = 0; dd < 2; ++dd) { u32x2 nb; nb.x = pk2(Sacc[dd][4][0], Sacc[dd][4][1]); nb.y = pk2(Sacc[dd][4][2], Sacc[dd][4][3]); *(LAS u32x2*)(NBF + ((w * 2 + dd) * 16 + 4 * fq) * 2) = nb; }
        }
#pragma unroll
        for (int dd = 0; dd < 2; ++dd)
#pragma unroll
            for (int e4 = 0; e4 < 4; ++e4) { const f32x4 sv = Sacc[dd][e4]; u32x2 wv; wv.x = pk2(sv[0], sv[1]); wv.y = pk2(sv[2], sv[3]);
                *(LAS u32x2*)(lds + L_ST + (e4 * 16 + fr) * QS + ((w * 2 + dd) * 16 + 4 * fq) * 2) = wv; }
    } else {
        if (tid < 256) sm[SM_N + tid] = 0.f;
    }
#define CH_LOAD(c) do { \
        _Pragma("unroll") for (int i = 0; i < 4; ++i) { const int id = tid + 512 * i, row = id >> 5, ch = id & 31; const size_t lr = (size_t)(base + sgn * ((c) * 64 + row)); \
            if (!STATE_ONLY) rq[i] = *(const u32x4*)(qc + lr * 1024 + hoff + ch * 8); rk[i] = *(const u32x4*)(kc + lr * 1024 + hoff + ch * 8); } \
        { const int row = tid >> 3, ch = tid & 7; const size_t lr = (size_t)(base + sgn * ((c) * 64 + row)); rv = *(const u32x4*)(mv + lr * 1024 + hoff + split * 64 + ch * 8); } \
 } while (0)
#define CH_STORE() do { \
        _Pragma("unroll") for (int i = 0; i < 4; ++i) { const int id = tid + 512 * i, row = id >> 5, ch = id & 31; \
            if (!STATE_ONLY) *(LAS u32x4*)(lds + L_Q + row * QS + ch * 16) = rq[i]; *(LAS u32x4*)(lds + L_K + row * QS + ch * 16) = rk[i]; } \
        { const int row = tid >> 3, ch = tid & 7; *(LAS u32x4*)(lds + L_V + row * VS + ch * 16) = rv; } } while (0)
    CH_LOAD(c0);
    {
        float bq[4], uq[4], cq[4];
#pragma unroll
        for (int q = 0; q < 4; ++q) { const int cc = w + 8 * q;
            const size_t lr = (size_t)(base + sgn * ((c0 + cc) * 64 + lane));
            const float li = gates[lr * 16 + dir * 8 + head], gfv = gates[lr * 16 + dir * 8 + 4 + head];
            bq[q] = fminf(gfv, 0.f) - log1pf(__expf(-fabsf(gfv))); uq[q] = li; }
#pragma unroll
        for (int o = 1; o < 64; o <<= 1) {
            float t[4];
#pragma unroll
            for (int q = 0; q < 4; ++q) t[q] = __shfl_up(bq[q], o);
#pragma unroll
            for (int q = 0; q < 4; ++q) if (lane >= o) bq[q] += t[q]; }
#pragma unroll
        for (int q = 0; q < 4; ++q) { uq[q] -= bq[q]; cq[q] = uq[q]; }
#pragma unroll
        for (int o = 1; o < 64; o <<= 1) {
            float t[4];
#pragma unroll
            for (int q = 0; q < 4; ++q) t[q] = __shfl_up(cq[q], o);
#pragma unroll
            for (int q = 0; q < 4; ++q) if (lane >= o) cq[q] = fmaxf(cq[q], t[q]); }
#pragma unroll
        for (int q = 0; q < 4; ++q) { const int cc = w + 8 * q; GU[cc * 64 + lane] = uq[q]; GC[cc * 64 + lane] = cq[q]; GB[cc * 64 + lane] = bq[q]; }
    }
    CH_STORE();
    __syncthreads();
    if (w == 0) {
        const int cl = lane & 31;
        const float cmv = GC[cl * 64 + 63], bv = GB[cl * 64 + 63];
        float m = mstate, bt = 0.f, mine = 0.f;
#pragma unroll
        for (int cc = 0; cc < 32; ++cc) {
            const float cm63 = __uint_as_float(__builtin_amdgcn_readlane(__float_as_uint(cmv), cc)), b63 = __uint_as_float(__builtin_amdgcn_readlane(__float_as_uint(bv), cc));
            mine = (lane == cc) ? m : mine;
            m = b63 + fmaxf(m, cm63); bt += b63; }
        if (lane < 32) GM[lane] = mine;
        if (lane == 0) { GM[32] = m; GM[33] = bt; }
    }
    __syncthreads();
    const int tA = w & 3, jt0 = (w >> 2) * 2;
    for (int c = c0; c < c1; ++c) {
        if (c + 1 < c1) CH_LOAD(c + 1);
        const int cg_ = (c - c0) * 64; const float m_c = GM[c - c0]; const float M63 = fmaxf(m_c, GC[cg_ + 63]);
        f32x4 h0 = (f32x4){0.f, 0.f, 0.f, 0.f}, h1 = h0, qn0 = h0, qn1 = h0;
        if constexpr (!STATE_ONLY) {
            f32x4 sc0 = (f32x4){0.f, 0.f, 0.f, 0.f}, sc1 = sc0;
#pragma unroll 4
            for (int kk = 0; kk < 8; ++kk) {
                const bf16x8 a = *(LAS bf16x8*)(lds + L_K + (tA * 16 + fr) * QS + kk * 64 + fq * 16);
                const bf16x8 a2 = *(LAS bf16x8*)(lds + L_ST + (tA * 16 + fr) * QS + kk * 64 + fq * 16);
                const bf16x8 b0 = *(LAS bf16x8*)(lds + L_Q + (jt0 * 16 + fr) * QS + kk * 64 + fq * 16);
                const bf16x8 b1 = *(LAS bf16x8*)(lds + L_Q + ((jt0 + 1) * 16 + fr) * QS + kk * 64 + fq * 16);
                sc0 = mfma16(a, b0, sc0); sc1 = mfma16(a, b1, sc1);
                h0 = mfma16(a2, b0, h0); h1 = mfma16(a2, b1, h1);
                const bf16x8 nf = *(LAS bf16x8*)(NBF + kk * 64 + fq * 16);
                qn0 = mfma16(nf, b0, qn0); qn1 = mfma16(nf, b1, qn1);
            }
            const int sb = tA * 16 + 4 * fq;
            const f32x4 uv = *(LAS f32x4*)(GU + cg_ + sb);
#pragma unroll
            for (int jt = 0; jt < 2; ++jt) { const int j = (jt0 + jt) * 16 + fr; const float Mj = fmaxf(m_c, GC[cg_ + j]); const f32x4 sc = jt ? sc1 : sc0;
                float v[4];
#pragma unroll
                for (int i = 0; i < 4; ++i) v[i] = (sb + i <= j) ? sc[i] * __expf(uv[i] - Mj) : 0.f;
                u32x2 wv; wv.x = pk2(v[0], v[1]); wv.y = pk2(v[2], v[3]);
                *(LAS u32x2*)(lds + L_P + j * VS + sb * 2) = wv;
                }
        }
        {
            const int s = tid >> 3, ch = tid & 7; const float ws_ = __expf(GU[cg_ + s] - M63); const u32x4 vv = *(LAS u32x4*)(lds + L_V + s * VS + ch * 16);
            u32x4 o; o.x = pk2(bflo(vv.x) * ws_, bfhi(vv.x) * ws_); o.y = pk2(bflo(vv.y) * ws_, bfhi(vv.y) * ws_); o.z = pk2(bflo(vv.z) * ws_, bfhi(vv.z) * ws_); o.w = pk2(bflo(vv.w) * ws_, bfhi(vv.w) * ws_);
            *(LAS u32x4*)(lds + L_VW + s * VSW + ch * 16) = o;
            if (ch == 0) { *(LAS u32x4*)(lds + L_VW + s * VSW + 128) = (u32x4){pk2(ws_, 0.f), 0u, 0u, 0u}; *(LAS u32x4*)(lds + L_VW + s * VSW + 144) = (u32x4){0u, 0u, 0u, 0u}; }
        }
        bf16x8 pkf[2][2], pvf[2];
#pragma unroll
        for (int ks = 0; ks < 2; ++ks) { const int rbase = ks * 32 + 8 * fq + (fr >> 2);
#pragma unroll
            for (int dd = 0; dd < 2; ++dd) { const int o0 = rbase * QS + ((w * 2 + dd) * 16 + 4 * (fr & 3)) * 2; pkf[ks][dd] = tr8(lds + L_K, o0, o0 + 4 * QS); }
            if constexpr (!STATE_ONLY) { const int o0 = rbase * VS + (tA * 16 + 4 * (fr & 3)) * 2; pvf[ks] = tr8(lds + L_V, o0, o0 + 4 * VS); } }
        __syncthreads();
        if (c + 1 < c1) { CH_STORE(); }
        if constexpr (!STATE_ONLY) {
            const int j0 = jt0 * 16 + fr, j1 = j0 + 16;
            const float Mj0 = fmaxf(m_c, GC[cg_ + j0]), Mj1 = fmaxf(m_c, GC[cg_ + j1]);
            const float wi0 = __expf(m_c - Mj0), wi1 = __expf(m_c - Mj1);
            h0 *= wi0; h1 *= wi1;
            f32x4 rs0 = (f32x4){0.f, 0.f, 0.f, 0.f}, rs1 = rs0;
            const bf16x8 ones = (bf16x8){(short)0x3F80, (short)0x3F80, (short)0x3F80, (short)0x3F80, (short)0x3F80, (short)0x3F80, (short)0x3F80, (short)0x3F80};
#pragma unroll
            for (int ks = 0; ks < 2; ++ks) {
                const bf16x8 a = pvf[ks];
                const bf16x8 b0 = *(LAS bf16x8*)(lds + L_P + j0 * VS + ks * 64 + fq * 16);
                const bf16x8 b1 = *(LAS bf16x8*)(lds + L_P + j1 * VS + ks * 64 + fq * 16);
                h0 = mfma16(a, b0, h0); h1 = mfma16(a, b1, h1);
                rs0 = mfma16(ones, b0, rs0); rs1 = mfma16(ones, b1, rs1);
            }
            const float den0 = wi0 * qn0[0] + rs0[0], den1 = wi1 * qn1[0] + rs1[0];
            const float sc0 = __builtin_amdgcn_rcpf(fmaxf(fabsf(den0), __expf(-GB[cg_ + j0] - Mj0))), sc1 = __builtin_amdgcn_rcpf(fmaxf(fabsf(den1), __expf(-GB[cg_ + j1] - Mj1)));
            h0 *= sc0; h1 *= sc1;
            const size_t lr0 = (size_t)(base + sgn * (c * 64 + j0)), lr1 = (size_t)(base + sgn * (c * 64 + j1));
            const int eo = split * 64 + tA * 16 + 4 * fq;
            u32x2 w0, w1; w0.x = pk2(h0[0], h0[1]); w0.y = pk2(h0[2], h0[3]); w1.x = pk2(h1[0], h1[1]); w1.y = pk2(h1[2], h1[3]);
            *(u32x2*)(hout + lr0 * 1024 + hoff + eo) = w0; *(u32x2*)(hout + lr1 * 1024 + hoff + eo) = w1;
        }
        {
            const float a_ = __expf(m_c - M63);
#pragma unroll
            for (int dd = 0; dd < 2; ++dd)
#pragma unroll
                for (int e4 = 0; e4 < 5; ++e4) Sacc[dd][e4] *= a_;
#pragma unroll
            for (int ks = 0; ks < 2; ++ks) {
                const int rbase = ks * 32 + 8 * fq + (fr >> 2);
                bf16x8 A[2], B[5];
#pragma unroll
                for (int dd = 0; dd < 2; ++dd) A[dd] = pkf[ks][dd];
#pragma unroll
                for (int e4 = 0; e4 < 5; ++e4) { const int o0 = rbase * VSW + (e4 * 16 + 4 * (fr & 3)) * 2; B[e4] = tr8(lds + L_VW, o0, o0 + 4 * VSW); }
#pragma unroll
                for (int dd = 0; dd < 2; ++dd)
#pragma unroll
                    for (int e4 = 0; e4 < 5; ++e4) Sacc[dd][e4] = mfma16(A[dd], B[e4], Sacc[dd][e4]);
            }
            if constexpr (!STATE_ONLY) {
#pragma unroll
                for (int dd = 0; dd < 2; ++dd)
#pragma unroll
                    for (int e4 = 0; e4 < 4; ++e4) { const f32x4 sv = Sacc[dd][e4]; u32x2 wv; wv.x = pk2(sv[0], sv[1]); wv.y = pk2(sv[2], sv[3]);
                        *(LAS u32x2*)(lds + L_ST + (e4 * 16 + fr) * QS + ((w * 2 + dd) * 16 + 4 * fq) * 2) = wv; }
            }
            if (fr == 0) {
#pragma unroll
                for (int dd = 0; dd < 2; ++dd) { *(LAS f32x4*)(sm + SM_N + (w * 2 + dd) * 16 + 4 * fq) = Sacc[dd][4];
                    if (!STATE_ONLY) { u32x2 nb; nb.x = pk2(Sacc[dd][4][0], Sacc[dd][4][1]); nb.y = pk2(Sacc[dd][4][2], Sacc[dd][4][3]); *(LAS u32x2*)(NBF + ((w * 2 + dd) * 16 + 4 * fq) * 2) = nb; } }
            }
        }
        __syncthreads();
    }
#undef CH_LOAD
#undef CH_STORE
    if constexpr (STATE_ONLY) {
#pragma unroll
        for (int dd = 0; dd < 2; ++dd)
#pragma unroll
            for (int e4 = 0; e4 < 4; ++e4) *(f32x4*)(st_out + (size_t)((((w * 2 + dd) * 4 + e4) * 64 + lane) * 4)) = Sacc[dd][e4];
        if (tid < 256) st_out[16384 + tid] = sm[SM_N + tid];
        if (tid == 0) { st_out[16640] = GM[32]; st_out[16641] = GM[33]; }
    }
}

__device__ __forceinline__ void na_item(const Params& p, unsigned char* shm, int T0, int gpair, int head) {
    LAS unsigned char* lds = (LAS unsigned char*)shm;
    LAS float* rpbs = (LAS float*)(lds + L_RPB);
    constexpr int VOFF = 73728;
    const int tid = threadIdx.x, w = tid >> 6, lane = tid & 63, fr = lane & 15, fq = lane >> 4;
    const int n = w & 3, rr = w >> 2;
    const us* nq = actp(p, 5); const us* nk = actp(p, 6); const us* nv = actp(p, 7); const us* nz = actp(p, 8);
    us* yb = (us*)(p.ws + p.o_xn);
    const size_t hstr = (size_t)p.Mr * 64;
    const int tokA = T0 + gpair * 128; int s0, len; seq_of(tokA, s0, len);
    const int rows = len / 64, r0 = (tokA - s0) / 64, r = r0 + rr;
    const int rsb = min(max(r0 - 4, 0), rows - 8), rs1 = min(max(r0 - 3, 0), rows - 8);
    const int rs = rr ? rs1 : rsb;
    const int nkeys = (rs1 + 8 - rsb) * 64;
    const int wl0 = s0 + rsb * 64 - T0;
    const int kb = min(max(16 * n - 8, 0), 32);
    const size_t lrq = (size_t)(tokA - T0 + rr * 64 + 16 * n + fr);
    u32x4 kreg[9], vreg[9];
#pragma unroll
    for (int i = 0; i < 9; ++i) { const int id = tid + 512 * i, key = id >> 3, ch = id & 7;
        if (key < nkeys) { kreg[i] = *(const u32x4*)(nk + (size_t)head * hstr + (size_t)(wl0 + key) * 64 + ch * 8); vreg[i] = *(const u32x4*)(nv + (size_t)head * hstr + (size_t)(wl0 + key) * 64 + ch * 8); } }
    bf16x8 qf[2];
#pragma unroll
    for (int ks = 0; ks < 2; ++ks) qf[ks] = *(const bf16x8*)(nq + head * hstr + lrq * 64 + ks * 32 + fq * 8);
    float rp0 = 0.f;
    if (tid < 465) rp0 = p.rpb[head * 465 + tid] * 1.44269504f;
#pragma unroll
    for (int i = 0; i < 9; ++i) { const int id = tid + 512 * i, key = id >> 3, ch = id & 7;
        if (key < nkeys) { const int o = key * 128 + ((ch ^ (key & 7)) * 16); *(LAS u32x4*)(lds + o) = kreg[i]; *(LAS u32x4*)(lds + VOFF + o) = vreg[i]; } }
    if (tid < 465) rpbs[tid] = rp0;
    __syncthreads();
    u32x2 zreg[4];
#pragma unroll
    for (int dt = 0; dt < 4; ++dt) zreg[dt] = *(const u32x2*)(nz + lrq * 1024 + head * 64 + dt * 16 + 4 * fq);
    f32x4 s[16];
    const int krow0 = (rs - rsb) * 64 + kb + fr;
#pragma unroll
    for (int t = 0; t < 16; ++t) { s[t] = (f32x4){0.f, 0.f, 0.f, 0.f};
        const int key = krow0 + (t >> 1) * 64 + 16 * (t & 1);
#pragma unroll
        for (int ks = 0; ks < 2; ++ks) { const bf16x8 kf = *(LAS bf16x8*)(lds + key * 128 + (((ks * 4 + fq) ^ (key & 7)) * 16)); s[t] = mfma16(kf, qf[ks], s[t]); } }
    const int c = 16 * n + fr, cs = min(max(c - 8, 0), 48);
    bool vf[2][4];
#pragma unroll
    for (int hf2 = 0; hf2 < 2; ++hf2)
#pragma unroll
        for (int i = 0; i < 4; ++i) vf[hf2][i] = (unsigned)(kb + 16 * hf2 + 4 * fq + i - cs) < 16u;
    LAS float* bp = rpbs + ((rs - r + 7) * 31 + (kb - 16 * n + 4 * fq - fr + 15));
    float mx = -1e30f;
#pragma unroll
    for (int t = 0; t < 16; ++t)
#pragma unroll
        for (int i = 0; i < 4; ++i) { const float v = vf[t & 1][i] ? s[t][i] * 0.18033688f + bp[(t >> 1) * 31 + 16 * (t & 1) + i] : -1e30f; s[t][i] = v; mx = fmaxf(mx, v); }
    mx = fmaxf(mx, __shfl_xor(mx, 16)); mx = fmaxf(mx, __shfl_xor(mx, 32));
    float sum = 0.f;
#pragma unroll
    for (int t = 0; t < 16; ++t)
#pragma unroll
        for (int i = 0; i < 4; ++i) { const float e = __builtin_amdgcn_exp2f(s[t][i] - mx); s[t][i] = e; sum += e; }
    sum += __shfl_xor(sum, 16); sum += __shfl_xor(sum, 32);
    f32x4 o[4];
#pragma unroll
    for (int dt = 0; dt < 4; ++dt) o[dt] = (f32x4){0.f, 0.f, 0.f, 0.f};
    const int vrow0 = (rs - rsb) * 64 + kb + 4 * fq + (fr >> 2), pch = (fr & 3) >> 1, phalf = (fr & 3) & 1;
#pragma unroll
    for (int kk = 0; kk < 8; ++kk) {
        u32x4 pw; pw.x = pk2(s[2 * kk][0], s[2 * kk][1]); pw.y = pk2(s[2 * kk][2], s[2 * kk][3]); pw.z = pk2(s[2 * kk + 1][0], s[2 * kk + 1][1]); pw.w = pk2(s[2 * kk + 1][2], s[2 * kk + 1][3]);
        const bf16x8 pf = __builtin_bit_cast(bf16x8, pw);
        const int k0 = vrow0 + kk * 64, k1 = k0 + 16;
#pragma unroll
        for (int dt = 0; dt < 4; ++dt) { const int chunk = 2 * dt + pch;
            const bf16x8 a = tr8(lds + VOFF, k0 * 128 + ((chunk ^ (k0 & 7)) * 16) + phalf * 8, k1 * 128 + ((chunk ^ (k1 & 7)) * 16) + phalf * 8); o[dt] = mfma16(a, pf, o[dt]); }
    }
    const float inv = __builtin_amdgcn_rcpf(sum);
#pragma unroll
    for (int dt = 0; dt < 4; ++dt) { const size_t off = lrq * 1024 + head * 64 + dt * 16 + 4 * fq; const u32x2 z = zreg[dt];
        u32x2 wv; wv.x = pk2(o[dt][0] * inv * siluf_(bflo(z.x)), o[dt][1] * inv * siluf_(bfhi(z.x))); wv.y = pk2(o[dt][2] * inv * siluf_(bflo(z.y)), o[dt][3] * inv * siluf_(bfhi(z.y)));
        *(u32x2*)(yb + off) = wv; }
}

struct NaGeom { int s0, rows, r0, rsb, rs1; };
__device__ __forceinline__ NaGeom na_geom(int T0, int gpair) {
    NaGeom g; const int tokA = T0 + gpair * 128; int len; seq_of(tokA, g.s0, len);
    g.rows = len / 64; g.r0 = (tokA - g.s0) / 64;
    g.rsb = min(max(g.r0 - 4, 0), g.rows - 8); g.rs1 = min(max(g.r0 - 3, 0), g.rows - 8); return g;
}
__device__ __forceinline__ void na_band(const Params& p, unsigned char* shm, int T0, int Mc) {
    LAS unsigned char* lds = (LAS unsigned char*)shm;
    LAS float* rpbs = (LAS float*)(lds + L_RPB);
    constexpr int VOFF = 73728;
    const int tid = threadIdx.x, w = tid >> 6, lane = tid & 63, fr = lane & 15, fq = lane >> 4;
    const int n = w & 3, rr = w >> 2;
    const int head = blockIdx.x & 15, band = blockIdx.x >> 4, ppb = (Mc / 128) / 16;
    const us* nq = actp(p, 5) + (size_t)head * p.Mr * 64; const us* nk = actp(p, 6) + (size_t)head * p.Mr * 64; const us* nv = actp(p, 7) + (size_t)head * p.Mr * 64;
    const us* nz = actp(p, 8); us* yb = (us*)(p.ws + p.o_xn);
    const int kb = min(max(16 * n - 8, 0), 32);
    const int c = 16 * n + fr, cs = min(max(c - 8, 0), 48);
    const int ccol = tid >> 3, cch = tid & 7;
    const int cswz = (ccol * 128) + ((cch ^ ((ccol >> 1) & 7)) * 16);
    if (tid < 465) rpbs[tid] = p.rpb[head * 465 + tid] * 1.44269504f;
    bool vf[2][4];
#pragma unroll
    for (int hf2 = 0; hf2 < 2; ++hf2)
#pragma unroll
        for (int i = 0; i < 4; ++i) vf[hf2][i] = (unsigned)(kb + 16 * hf2 + 4 * fq + i - cs) < 16u;
    u32x4 kpf[2], vpf[2]; bf16x8 qfn[2];
    int prev_hi = 0, prev_s0 = -1;
    {
        const int gp0 = band * ppb; const size_t lq = (size_t)(gp0 * 128 + rr * 64 + 16 * n + fr);
#pragma unroll
        for (int ks = 0; ks < 2; ++ks) qfn[ks] = *(const bf16x8*)(nq + lq * 64 + ks * 32 + fq * 8);
    }
    for (int k = 0; k < ppb; ++k) {
        const int gpair = band * ppb + k; const NaGeom g = na_geom(T0, gpair);
        const int hi = g.rs1 + 8; const bool fresh = (g.s0 != prev_s0);
        const int r = g.r0 + rr, rs = rr ? g.rs1 : g.rsb;
        const size_t lrq = (size_t)(gpair * 128 + rr * 64 + 16 * n + fr);
        const size_t rowbase = (size_t)(g.s0 - T0) * 64 + (size_t)ccol * 64 + cch * 8;
        __syncthreads();
        if (fresh) {
            u32x4 kreg[9], vreg[9];
#pragma unroll
            for (int i = 0; i < 9; ++i) { const int R = g.rsb + i; if (R < hi) { kreg[i] = *(const u32x4*)(nk + rowbase + (size_t)R * 4096); vreg[i] = *(const u32x4*)(nv + rowbase + (size_t)R * 4096); } }
#pragma unroll
            for (int i = 0; i < 9; ++i) { const int R = g.rsb + i; if (R < hi) { const int o = (R % 9) * 8192 + cswz; *(LAS u32x4*)(lds + o) = kreg[i]; *(LAS u32x4*)(lds + VOFF + o) = vreg[i]; } }
        } else {
#pragma unroll
            for (int i = 0; i < 2; ++i) { const int R = prev_hi + i; if (R < hi) { const int o = (R % 9) * 8192 + cswz; *(LAS u32x4*)(lds + o) = kpf[i]; *(LAS u32x4*)(lds + VOFF + o) = vpf[i]; } }
        }
        const bf16x8 qf0 = qfn[0], qf1 = qfn[1];
        __syncthreads();
        u32x2 zreg[4];
#pragma unroll
        for (int dt = 0; dt < 4; ++dt) zreg[dt] = *(const u32x2*)(nz + lrq * 1024 + head * 64 + dt * 16 + 4 * fq);
        if (k + 1 < ppb) {
            const NaGeom g2 = na_geom(T0, gpair + 1); const int hi2 = g2.rs1 + 8;
            if (g2.s0 == g.s0) {
#pragma unroll
                for (int i = 0; i < 2; ++i) { const int R = hi + i; if (R < hi2) { kpf[i] = *(const u32x4*)(nk + rowbase + (size_t)R * 4096); vpf[i] = *(const u32x4*)(nv + rowbase + (size_t)R * 4096); } }
            }
            const size_t lq = (size_t)((gpair + 1) * 128 + rr * 64 + 16 * n + fr);
#pragma unroll
            for (int ks = 0; ks < 2; ++ks) qfn[ks] = *(const bf16x8*)(nq + lq * 64 + ks * 32 + fq * 8);
        }
        prev_hi = hi; prev_s0 = g.s0;
        int slot[8];
#pragma unroll
        for (int i = 0; i < 8; ++i) slot[i] = (rs + i) % 9;
        f32x4 s[16];
#pragma unroll
        for (int t = 0; t < 16; ++t) { s[t] = (f32x4){0.f, 0.f, 0.f, 0.f};
            const int key = slot[t >> 1] * 64 + kb + 16 * (t & 1) + fr;
            const bf16x8 kf0 = *(LAS bf16x8*)(lds + key * 128 + (((0 + fq) ^ ((key >> 1) & 7)) * 16)), kf1 = *(LAS bf16x8*)(lds + key * 128 + (((4 + fq) ^ ((key >> 1) & 7)) * 16));
            s[t] = mfma16(kf0, qf0, s[t]); s[t] = mfma16(kf1, qf1, s[t]); }
        LAS float* bp = rpbs + ((rs - r + 7) * 31 + (kb - 16 * n + 4 * fq - fr + 15));
        float mx = -1e30f;
#pragma unroll
        for (int t = 0; t < 16; ++t)
#pragma unroll
            for (int i = 0; i < 4; ++i) { const float v = vf[t & 1][i] ? s[t][i] * 0.18033688f + bp[(t >> 1) * 31 + 16 * (t & 1) + i] : -1e30f; s[t][i] = v; }
#pragma unroll
        for (int t = 0; t < 16; ++t) { mx = fmaxf(fmaxf(mx, s[t][0]), s[t][1]); mx = fmaxf(fmaxf(mx, s[t][2]), s[t][3]); }
        mx = fmaxf(mx, __shfl_xor(mx, 16)); mx = fmaxf(mx, __shfl_xor(mx, 32));
        float sum = 0.f;
#pragma unroll
        for (int t = 0; t < 16; ++t)
#pragma unroll
            for (int i = 0; i < 4; ++i) { const float e = __builtin_amdgcn_exp2f(s[t][i] - mx); s[t][i] = e; sum += e; }
        sum += __shfl_xor(sum, 16); sum += __shfl_xor(sum, 32);
        f32x4 o[4];
#pragma unroll
        for (int dt = 0; dt < 4; ++dt) o[dt] = (f32x4){0.f, 0.f, 0.f, 0.f};
        const int vcol0 = kb + 4 * fq + (fr >> 2), pch = (fr & 3) >> 1, phalf = (fr & 3) & 1;
#pragma unroll
        for (int kk = 0; kk < 8; ++kk) {
            u32x4 pw; pw.x = pk2(s[2 * kk][0], s[2 * kk][1]); pw.y = pk2(s[2 * kk][2], s[2 * kk][3]); pw.z = pk2(s[2 * kk + 1][0], s[2 * kk + 1][1]); pw.w = pk2(s[2 * kk + 1][2], s[2 * kk + 1][3]);
            const bf16x8 pf = __builtin_bit_cast(bf16x8, pw);
            const int k0 = slot[kk] * 64 + vcol0, k1 = k0 + 16;
#pragma unroll
            for (int dt = 0; dt < 4; ++dt) { const int chunk = 2 * dt + pch;
                const bf16x8 a = tr8(lds + VOFF, k0 * 128 + ((chunk ^ ((k0 >> 1) & 7)) * 16) + phalf * 8, k1 * 128 + ((chunk ^ ((k1 >> 1) & 7)) * 16) + phalf * 8); o[dt] = mfma16(a, pf, o[dt]); }
        }
        const float inv = __builtin_amdgcn_rcpf(sum);
#pragma unroll
        for (int dt = 0; dt < 4; ++dt) { const size_t off = lrq * 1024 + head * 64 + dt * 16 + 4 * fq; const u32x2 z = zreg[dt];
            u32x2 wv; wv.x = pk2(o[dt][0] * inv * siluf_(bflo(z.x)), o[dt][1] * inv * siluf_(bfhi(z.x))); wv.y = pk2(o[dt][2] * inv * siluf_(bflo(z.y)), o[dt][3] * inv * siluf_(bfhi(z.y)));
            *(u32x2*)(yb + off) = wv; }
    }
}

__device__ __forceinline__ void phase_mix(const Params& p, unsigned char* shm, int T0, int Mc, int cidx, int flags) {
    float* state = (float*)(p.ws + p.o_state);
    const int n_pre = (flags & 1) ? 7 * 32 : 0;
    const int n_chain = (flags & 2) ? (Mc / UNIT) * 32 : 0;
    const int n_na = (flags & 4) ? (Mc / 128) * 16 : 0;
    for (int item = blockIdx.x; item < n_pre; item += gridDim.x) { __syncthreads();
        const int g = item >> 5, combo = item & 31;
        mlstm_chain<true>(p, shm, T0, Mc, 0, TOK_P, combo & 3, (combo >> 2) & 1, combo >> 3, 32 * g, 32 * g + 32, nullptr, 0, state + (size_t)(combo * 8 + g) * ST_REC); }
    for (int item = blockIdx.x; item < n_chain; item += gridDim.x) { __syncthreads();
        const int si = item >> 5, combo = item & 31;
        if (T0 == 0 && si < 8) mlstm_chain<false>(p, shm, T0, Mc, 0, TOK_P, combo & 3, (combo >> 2) & 1, combo >> 3, 32 * si, 32 * si + 32, state + (size_t)(combo * 8) * ST_REC, si, nullptr);
        else mlstm_chain<false>(p, shm, T0, Mc, T0 + si * UNIT, UNIT, combo & 3, (combo >> 2) & 1, combo >> 3, 0, 32, nullptr, 0, nullptr); }
    if (n_na) { __syncthreads();
        if (gridDim.x == 256) na_band(p, shm, T0, Mc);
        else for (int idx = blockIdx.x; idx < n_na; idx += gridDim.x) { __syncthreads(); na_item(p, shm, T0, idx >> 4, idx & 15); } }
    __syncthreads();
}

#define XB_TMO      128
#define XB_XCNT(j)  (256  + 64 * (j))
#define XB_XSUB(j)  (1280 + 64 * (j))
#define XB_XGEN(j)  (2304 + 64 * (j))
#define XB_TOP      3328
#define XB_TOPGEN   3392
#define XCD_BAR_WORDS 3456
#define XB_SPIN_CAP (1u << 18)
#define XB_TOP      3328
#define XB_TOPGEN   3392
#define XCD_BAR_WORDS 3456
#define XB_SPIN_CAP (1u << 18)

__device__ __forceinline__ unsigned xb_ld(unsigned* p)              { return __hip_atomic_load(p, __ATOMIC_RELAXED, __HIP_MEMORY_SCOPE_AGENT); }
__device__ __forceinline__ unsigned xb_add(unsigned* p, unsigned v) { return __hip_atomic_fetch_add(p, v, __ATOMIC_RELAXED, __HIP_MEMORY_SCOPE_AGENT); }
__device__ __forceinline__ unsigned xb_xcc_id() { return (unsigned)__builtin_amdgcn_s_getreg((3 << 11) | 20) & 0xFu; }
#define XB_SPIN(cond, bar) do { unsigned _sp = 0; while (cond) { __builtin_amdgcn_s_sleep(1); \
    if ((++_sp & 255u) == 0u) { if (xb_ld(&(bar)[XB_TMO])) break; if (_sp > XB_SPIN_CAP) { atomicAdd(&(bar)[XB_TMO], 1u); break; } } } } while (0)

struct XcdBarrier {
    unsigned* bar; unsigned x;
    volatile LAS unsigned* st;
};

__device__ __forceinline__ XcdBarrier xcd_barrier_post(unsigned* bar, volatile LAS unsigned* st) {
    XcdBarrier b; b.bar = bar; b.x = xb_xcc_id(); b.st = st;
    if (threadIdx.x == 0) (void)xb_add(&bar[XB_XCNT(b.x)], 1u);
    return b;
}
__device__ __forceinline__ void xcd_barrier_complete(unsigned* bar, unsigned x, unsigned& nloc, unsigned& nx) {
    const unsigned G = gridDim.x * gridDim.y * gridDim.z;
    unsigned sum, cnt, mine, sp = 0u;
    for (;;) {
        sum = 0u; cnt = 0u; mine = 0u;
#pragma unroll
        for (unsigned j = 0; j < 16; ++j) { const unsigned c = xb_ld(&bar[XB_XCNT(j)]); sum += c; cnt += (c > 0u) ? 1u : 0u; mine = (j == x) ? c : mine; }
        if (sum == G) break;
        __builtin_amdgcn_s_sleep(1);
        if ((++sp & 255u) == 0u) { if (xb_ld(&bar[XB_TMO])) break; if (sp > XB_SPIN_CAP) { atomicAdd(&bar[XB_TMO], 1u); break; } }
    }
    nloc = mine > 0u ? mine : 1u; nx = cnt > 0u ? cnt : 1u;
}

__device__ __forceinline__ void xcd_barrier(const XcdBarrier& b) {
    asm volatile("s_waitcnt vmcnt(0)" ::: "memory");
    __syncthreads();
    if (threadIdx.x == 0) {
        unsigned* bar = b.bar;
        __builtin_amdgcn_s_waitcnt(0);
        unsigned nloc = b.st[0], nx = b.st[1];
        if (nloc == 0u) { xcd_barrier_complete(bar, b.x, nloc, nx); b.st[0] = nloc; b.st[1] = nx; }
        const unsigned old = xb_add(&bar[XB_XSUB(b.x)], 1u);
        const unsigned gen = old / nloc;
        if (old + 1u == (gen + 1u) * nloc) {
            __builtin_amdgcn_fence(__ATOMIC_RELEASE, "agent");
            asm volatile("s_waitcnt vmcnt(0)" ::: "memory");
            const unsigned og = xb_add(&bar[XB_TOP], 1u);
            const unsigned tg = og / nx;
            if (og + 1u == (tg + 1u) * nx) xb_add(&bar[XB_TOPGEN], 1u);
            else XB_SPIN(xb_ld(&bar[XB_TOPGEN]) == tg, bar);
            __builtin_amdgcn_fence(__ATOMIC_ACQUIRE, "agent");
            xb_add(&bar[XB_XGEN(b.x)], 1u);
            asm volatile("s_waitcnt vmcnt(0)" ::: "memory");
        } else {
            XB_SPIN(xb_ld(&bar[XB_XGEN(b.x)]) == gen, bar);
            __builtin_amdgcn_fence(__ATOMIC_ACQUIRE, "agent");
            asm volatile("s_waitcnt vmcnt(0)" ::: "memory");
        }
    }
    __syncthreads();
}

#ifndef PHM
#define PHM 0xFFF
#endif
#define IN(k) (lo <= (k) && (k) < hi)
#define INB(b, k) (((PHM >> (b)) & 1) && IN(k))
#define SEAM(k) do { if (IN(k) && IN((k) + 1)) xcd_barrier(bar); } while (0)
__device__ __forceinline__ void round_body(const Params& p, unsigned char* shm, const XcdBarrier& bar, const int round, const int lo, const int hi) {
    const int T0 = round * p.Mr, pb = 1 + 8 * round;
    const int Mc = (TOK_ALL - T0) < p.Mr ? (TOK_ALL - T0) : p.Mr;
    if (INB(1, pb)) { EpiIn E; E.act = actp(p, 0); E.split_stride = (size_t)p.Mr * 1024; E.gates = (float*)(p.ws + p.o_gates); E.b_gate = p.b_gate;
        run_gemm(shm, (const us*)(p.ws + p.o_xn), (const us*)(p.ws + p.o_winT), Mc, 11264, 1024, E); }
    SEAM(pb);
    if (INB(2, pb + 1)) { phase_gates(p, Mc); phase_conv(p, T0, Mc); }
    SEAM(pb + 1);
    if (round == 0) {
        if (INB(3, pb + 2)) phase_mix(p, shm, T0, Mc, 0, 1 | 4);
        SEAM(pb + 2);
        if (INB(4, pb + 3)) phase_mix(p, shm, T0, Mc, 1, 2);
    } else {
        if (INB(4, pb + 3)) phase_mix(p, shm, T0, Mc, 1 + round, 2 | 4);
    }
    SEAM(pb + 3);
    if (INB(5, pb + 4)) phase_ya(p, Mc);
    SEAM(pb + 4);
    if (INB(6, pb + 5)) {
        EpiPair E; E.ga = actp(p, 9); E.gb = actp(p, 10); E.merged = actp(p, 1);
        run_gemm_pair(shm, actp(p, 0), (const us*)(p.ws + p.o_wdaT), (const us*)(p.ws + p.o_xn), (const us*)(p.ws + p.o_wdbT), Mc, 1024, 1024, E);
    }
    SEAM(pb + 5);
    if (INB(7, pb + 6)) { EpiOut E; E.out = p.out + (size_t)T0 * 1024; E.xp = p.xp; E.xs = p.xs; E.T0 = T0; run_gemm(shm, actp(p, 1), (const us*)(p.ws + p.o_woutT), Mc, 1024, 1024, E); }
    SEAM(pb + 6);
    if (INB(8, pb + 7)) { phase_fnorm(p, T0, Mc); if (T0 + Mc < TOK_ALL) phase_xnorm(p, T0 + Mc, (TOK_ALL - T0 - Mc) < p.Mr ? (TOK_ALL - T0 - Mc) : p.Mr); }
    if (T0 + Mc < TOK_ALL) SEAM(pb + 7);
}
__global__ __launch_bounds__(512, 2) void mega(Params p) {
    extern __shared__ __attribute__((aligned(16))) unsigned char shm[];
    cg::grid_group grid = cg::this_grid();
    const int lo = p.ph_lo, hi = p.ph_hi;
    volatile LAS unsigned* bst = (volatile LAS unsigned*)((LAS unsigned char*)shm + (LDS_BYTES - 32));
    if (threadIdx.x == 0) { bst[0] = 0u; bst[1] = 0u; }
    __syncthreads();
    const XcdBarrier bar = xcd_barrier_post((unsigned*)(p.ws + p.o_bar), bst);
    if (INB(0, 0)) { phase_weights(p, shm); phase_xnorm(p, 0, p.Mr); }
    if (p.ph_lo < 0) grid.sync();
    SEAM(0);
    round_body(p, shm, bar, 0, lo, hi);
    round_body(p, shm, bar, 1, lo, hi);
    round_body(p, shm, bar, 2, lo, hi);
#undef IN
#undef SEAM
}

#ifndef N_LAUNCH_MODE
#define N_LAUNCH_MODE 1
#endif
extern "C" void kernel_launch(void* const* d_in, const int* in_sizes, int n_in, void* d_out, int out_size, void* d_ws, size_t ws_size, hipStream_t stream) {
    static int grid = 0;
    if (grid == 0) {
        int dev = 0, cus = 0, per_cu = 0;
        hipGetDevice(&dev); hipDeviceGetAttribute(&cus, hipDeviceAttributeMultiprocessorCount, dev);
        if (hipFuncSetAttribute((const void*)mega, hipFuncAttributeMaxDynamicSharedMemorySize, LDS_BYTES) != hipSuccess) fprintf(stderr, "kernel_launch: hipFuncSetAttribute failed\n");
        if (hipOccupancyMaxActiveBlocksPerMultiprocessor(&per_cu, (const void*)mega, 512, LDS_BYTES) != hipSuccess || per_cu < 1) { fprintf(stderr, "kernel_launch: occupancy query says %d\n", per_cu); per_cu = 1; }
        (void)hipGetLastError();
        grid = cus * 1;
        if (grid <= 0) grid = 256;
    }
    Params p{};
    p.xp = (const float*)d_in[0]; p.xs = (const float*)d_in[1]; p.norm_w = (const float*)d_in[2]; p.w_in = (const float*)d_in[3]; p.b_gate = (const float*)d_in[4];
    p.conv_w = (const float*)d_in[5]; p.conv_b = (const float*)d_in[6]; p.mh_w = (const float*)d_in[7]; p.rpb = (const float*)d_in[8];
    p.wda = (const float*)d_in[9]; p.wdb = (const float*)d_in[10]; p.wout = (const float*)d_in[11]; p.fnw = (const float*)d_in[12];
    p.out = (float*)d_out; p.ws = (unsigned char*)d_ws;
    size_t off = 0;
    p.o_winT = off; off += (size_t)NPAD * 1024 * 2;
    p.o_wdaT = off; off += (size_t)1024 * 1024 * 2; p.o_wdbT = off; off += (size_t)1024 * 1024 * 2; p.o_woutT = off; off += (size_t)1024 * 1024 * 2;
    p.o_ctr = off; off += 256;
    p.o_bar = off; off += (size_t)XCD_BAR_WORDS * 4;
    p.o_state = off; off += (size_t)256 * ST_REC * 4;
    const int Mr = 32768;
    p.Mr = Mr; p.nrounds = 3;
    p.o_gates = off; off += (size_t)Mr * 64;
    p.o_xn = off; off += (size_t)Mr * 2048;
    p.o_act = off; off += (size_t)Mr * 11 * 2048;
    if (off > ws_size) { fprintf(stderr, "kernel_launch: workspace too small (%zu > %zu)\n", off, ws_size); return; }
    hipMemsetAsync((char*)d_ws + p.o_ctr, 0, 256 + (size_t)XCD_BAR_WORDS * 4, stream);
    const int nph = 1 + 8 * p.nrounds;
#if N_LAUNCH_MODE == 1
    p.ph_lo = 0; p.ph_hi = nph;
    void* args[] = {&p};
    hipError_t e = hipLaunchCooperativeKernel((const void*)mega, dim3(grid), dim3(512), args, LDS_BYTES, stream);
    if (e != hipSuccess) fprintf(stderr, "kernel_launch: cooperative launch failed: %s (grid %d)\n", hipGetErrorString(e), grid);
#else
    for (int ph = 0; ph < nph; ++ph) { p.ph_lo = ph; p.ph_hi = ph + 1; hipLaunchKernelGGL(mega, dim3(grid), dim3(512), LDS_BYTES, stream, p); }
#endif
}
```

```cpp
#include <hip/hip_runtime.h>
#include <hip/hip_cooperative_groups.h>
#include <cstdio>
namespace cg = cooperative_groups;
namespace pg8 {
#define PG8_LAS __attribute__((address_space(3)))
typedef unsigned short bf16_t;
typedef short bf16x8 __attribute__((ext_vector_type(8)));
typedef float f32x4 __attribute__((ext_vector_type(4)));
typedef unsigned u32x4 __attribute__((ext_vector_type(4)));
constexpr int BM = 256, BK = 64, HALF = 128, HTB = HALF * BK * 2  , STAGE_BYTES = 8 * HTB, NXCD = 8, WGM = 8;

__host__ __device__ __forceinline__ int lds_byte(int r, int c) { const int st = (r >> 4) * 2 + (c >> 5), rr = r & 15, cc = c & 31, ob = rr * 64 + cc * 2; return st * 1024 + (ob ^ (((ob >> 9) & 1) << 5)); }
__host__ __device__ __forceinline__ void stage_rc(int b, int& R, int& C) { const int st = b / 1024, sb = b % 1024, swz = sb ^ (((sb >> 9) & 1) << 5); R = (st >> 1) * 16 + swz / 64; C = (st & 1) * 32 + (swz % 64) / 2; }
__host__ __device__ __forceinline__ int perm32(int rho) { const int n = rho >> 4, i = rho & 15; return 8 * (i >> 2) + 4 * n + (i & 3); }

struct Unit { int pm, pn, w; };
struct Gemm { const bf16_t* A; const bf16_t* Bt; int M, N, K; const bf16_t* A2; const bf16_t* Bt2; };

struct StaticOrder {
    int nM, nN, nwg, G, c;
    __host__ __device__ void init(int M, int N, int G_, int c_) { nM = M / BM; nN = N / BM; nwg = nM * nN; G = G_; c = c_; }
    __host__ __device__ bool next(int i, Unit& u) const {
        const long L = (long)i * G + c; if (L >= nwg) return false;
        int wgid = (int)L; { const int q = nwg / NXCD, r = nwg % NXCD, xcd = wgid % NXCD, off = wgid / NXCD; wgid = (xcd < r ? xcd * (q + 1) : r * (q + 1) + (xcd - r) * q) + off; }
        const int nig = WGM * nN, gid = wgid / nig, fm = gid * WGM, gsz = (nM - fm) < WGM ? (nM - fm) : WGM;
        u.pm = fm + ((wgid % nig) % gsz); u.pn = (wgid % nig) / gsz; u.w = 0; return true;
    }
    __device__ __forceinline__ void a_ready(const Unit&) const {}
    __device__ __forceinline__ void done(const Unit&) const {}
};
__device__ __forceinline__ unsigned cvt_pk_bf16(float lo, float hi) { unsigned r; asm volatile("v_cvt_pk_bf16_f32 %0, %1, %2" : "=v"(r) : "v"(lo), "v"(hi)); return r; }
template <class Epi, class Sched, bool STAMP = false>
__device__ __forceinline__ void gemm_phase(PG8_LAS unsigned char* lds, const Gemm g, const Sched& S, const Epi& E, unsigned long long* stamps) {
    const int tid = threadIdx.x, wid = __builtin_amdgcn_readfirstlane(tid >> 6), lane = tid & 63, wr = wid >> 2, wc = wid & 3, fr = lane & 15, fq = lane >> 4;
    const int K = g.K, nt = K / BK;
    int ts_lo = 0, ts_hi = 0, nts = 0; const unsigned long long rt_entry = STAMP ? (unsigned long long)wall_clock64() : 0ull;
#define PG8_STAMP() do { if (STAMP && wid == 0 && nts < 64) { const unsigned long long _c = (unsigned long long)clock64(); \
        ts_lo = (lane == nts) ? (int)(unsigned)_c : ts_lo; ts_hi = (lane == nts) ? (int)(unsigned)(_c >> 32) : ts_hi; ++nts; } } while (0)
    PG8_STAMP();
    unsigned voffA[2], voffB[2];
#pragma unroll
    for (int i = 0; i < 2; ++i) { int R, C; stage_rc(tid * 16 + i * 8192, R, C); const int Rb = Epi::PERM ? ((R & ~31) + perm32(R & 31)) : R;
        voffA[i] = (unsigned)(R * K + C) * 2u; voffB[i] = (unsigned)(Rb * K + C) * 2u; }
    const size_t kstep = (size_t)(BK * 2);
    const size_t hstep = (size_t)HALF * K * 2;
    const size_t tstep = 2 * hstep;
    const unsigned ldsw = (unsigned)wid * 1024u;
    const int aoff = lds_byte(wr * 64 + fr, fq * 8), boff = lds_byte(wc * 32 + fr, fq * 8);
#define PG8_SA(b, h) (((b) * 2 + (h)) * HTB)
#define PG8_SB(b, h) ((4 + (b) * 2 + (h)) * HTB)
#define PG8_STAGE(bufoff, gbase, voff) do { _Pragma("unroll") for (int _i = 0; _i < 2; ++_i) \
        __builtin_amdgcn_global_load_lds((const unsigned*)((const char*)(gbase) + (voff)[_i]), (PG8_LAS unsigned*)(lds + (bufoff) + ldsw + _i * 8192), 16, 0, 0); } while (0)
#define PG8_LDA(dst, b, h) do { _Pragma("unroll") for (int m = 0; m < 4; ++m) _Pragma("unroll") for (int k = 0; k < 2; ++k) dst[m][k] = *(const PG8_LAS bf16x8*)(lds + PG8_SA(b, h) + aoff + m * 2048 + k * 1024); } while (0)
#define PG8_LDB(dst, b, h) do { _Pragma("unroll") for (int n = 0; n < 2; ++n) _Pragma("unroll") for (int k = 0; k < 2; ++k) dst[n][k] = *(const PG8_LAS bf16x8*)(lds + PG8_SB(b, h) + boff + n * 2048 + k * 1024); } while (0)
#define PG8_MMA(ai, bj, At, Bt) do { __builtin_amdgcn_s_setprio(1); _Pragma("unroll") for (int m = 0; m < 4; ++m) _Pragma("unroll") for (int n = 0; n < 2; ++n) _Pragma("unroll") for (int k = 0; k < 2; ++k) \
        acc[ai][bj][m][n] = __builtin_amdgcn_mfma_f32_16x16x32_bf16(Bt[n][k], At[m][k], acc[ai][bj][m][n], 0, 0, 0); __builtin_amdgcn_s_setprio(0); } while (0)
#define PG8_WAIT_V(n) asm volatile("s_waitcnt vmcnt(" #n ")" ::: "memory")
#define PG8_WAIT_L(n) asm volatile("s_waitcnt lgkmcnt(" #n ")" ::: "memory")
#define PG8_BAR __builtin_amdgcn_s_barrier()
#define PG8_SCHED __builtin_amdgcn_sched_barrier(0)
    Unit cur, nxt; int ui = 0;
    if (!S.next(0, cur)) return;
    f32x4 acc[2][2][4][2];
#pragma unroll
    for (int a = 0; a < 2; ++a)
#pragma unroll
        for (int b = 0; b < 2; ++b)
#pragma unroll
            for (int m = 0; m < 4; ++m)
#pragma unroll
                for (int n = 0; n < 2; ++n) acc[a][b][m][n] = (f32x4){0.f, 0.f, 0.f, 0.f};
    bf16x8 At[4][2], B0[2][2], B1[2][2];
    const char* cA = (const char*)(cur.w ? g.A2 : g.A) + (size_t)cur.pm * tstep; const char* cB = (const char*)(cur.w ? g.Bt2 : g.Bt) + (size_t)cur.pn * tstep;
    S.a_ready(cur);
    PG8_STAGE(PG8_SB(0, 0), cB, voffB); PG8_STAGE(PG8_SA(0, 0), cA, voffA); PG8_STAGE(PG8_SB(0, 1), cB + hstep, voffB); PG8_STAGE(PG8_SA(0, 1), cA + hstep, voffA);
    if (wr == 1) PG8_BAR;
    PG8_WAIT_V(4); PG8_BAR;
    PG8_STAGE(PG8_SB(1, 0), cB + kstep, voffB); PG8_STAGE(PG8_SA(1, 0), cA + kstep, voffA); PG8_STAGE(PG8_SB(1, 1), cB + hstep + kstep, voffB);
    PG8_WAIT_V(6); PG8_BAR;
    PG8_STAMP();
    for (;;) {
        const bool has_next = S.next(ui + 1, nxt);
        const char* nA = has_next ? (const char*)(nxt.w ? g.A2 : g.A) + (size_t)nxt.pm * tstep : cA; const char* nB = has_next ? (const char*)(nxt.w ? g.Bt2 : g.Bt) + (size_t)nxt.pn * tstep : cB;
        for (int t = 0; t < nt; t += 2) {
            const bool last = (t == nt - 2);
            const char* a1 = cA + (size_t)(t + 1) * kstep;
            const char* a2 = last ? nA : cA + (size_t)(t + 2) * kstep; const char* b2 = last ? nB : cB + (size_t)(t + 2) * kstep;
            const char* a3 = a2 + kstep; const char* b3 = b2 + kstep;
            if (last && has_next) S.a_ready(nxt);
            PG8_LDB(B0, 0, 0); PG8_SCHED; PG8_LDA(At, 0, 0); PG8_STAGE(PG8_SA(1, 1), a1 + hstep, voffA);
            PG8_WAIT_L(8); PG8_BAR; PG8_WAIT_L(0); PG8_MMA(0, 0, At, B0); PG8_BAR; PG8_SCHED;
            PG8_LDB(B1, 0, 1); PG8_STAGE(PG8_SB(0, 0), b2, voffB);
            PG8_BAR; PG8_WAIT_L(0); PG8_MMA(0, 1, At, B1); PG8_BAR;
            PG8_LDA(At, 0, 1); PG8_STAGE(PG8_SA(0, 0), a2, voffA);
            PG8_BAR; PG8_WAIT_L(0); PG8_MMA(1, 0, At, B0); PG8_BAR; PG8_SCHED;
            PG8_STAGE(PG8_SB(0, 1), b2 + hstep, voffB);
            PG8_WAIT_V(6); PG8_BAR; PG8_MMA(1, 1, At, B1); PG8_BAR;
            PG8_LDB(B0, 1, 0); PG8_SCHED; PG8_LDA(At, 1, 0); PG8_STAGE(PG8_SA(0, 1), a2 + hstep, voffA);
            PG8_WAIT_L(8); PG8_BAR; PG8_WAIT_L(0); PG8_MMA(0, 0, At, B0); PG8_BAR; PG8_SCHED;
            PG8_LDB(B1, 1, 1); PG8_STAGE(PG8_SB(1, 0), b3, voffB);
            PG8_BAR; PG8_WAIT_L(0); PG8_MMA(0, 1, At, B1); PG8_BAR;
            PG8_LDA(At, 1, 1); PG8_STAGE(PG8_SA(1, 0), a3, voffA);
            PG8_BAR; PG8_WAIT_L(0); PG8_MMA(1, 0, At, B0); PG8_BAR; PG8_SCHED;
            PG8_STAGE(PG8_SB(1, 1), b3 + hstep, voffB);
            PG8_WAIT_V(6); PG8_BAR; PG8_MMA(1, 1, At, B1); PG8_BAR;
        }
        PG8_STAMP();
        if (wr == 0) PG8_BAR;
        if constexpr (!Epi::AFTER_DRAIN) { E(acc, cur, wr, wc, fr, fq); S.done(cur); }
        PG8_STAMP();
        if (!has_next) break;
        if (!(Epi::PAIR && cur.w == 0)) {
#pragma unroll
        for (int a = 0; a < 2; ++a)
#pragma unroll
            for (int b = 0; b < 2; ++b)
#pragma unroll
                for (int m = 0; m < 4; ++m)
#pragma unroll
                    for (int n = 0; n < 2; ++n) acc[a][b][m][n] = (f32x4){0.f, 0.f, 0.f, 0.f};
        }
        cur = nxt; cA = nA; cB = nB; ++ui;
        if (wr == 1) PG8_BAR;
    }
    PG8_WAIT_V(0);
    PG8_BAR;
    if constexpr (Epi::AFTER_DRAIN) { E.fused(acc, cur, wr, wc, fr, fq, lds, wid, lane); S.done(cur); }
    PG8_STAMP();
    if (STAMP && wid == 0) { stamps[lane] = lane < nts ? (((unsigned long long)(unsigned)ts_hi << 32) | (unsigned)ts_lo) : 0ull;
        if (lane == 62) stamps[62] = rt_entry; if (lane == 63) stamps[63] = (unsigned long long)wall_clock64(); }
#undef PG8_STAMP
#undef PG8_SA
#undef PG8_SB
#undef PG8_STAGE
#undef PG8_LDA
#undef PG8_LDB
#undef PG8_MMA
#undef PG8_WAIT_V
#undef PG8_WAIT_L
#undef PG8_BAR
#undef PG8_SCHED
}
}

#define LAS __attribute__((address_space(3)))
typedef unsigned short us;
typedef short bf16x8 __attribute__((ext_vector_type(8)));
typedef short s16x4 __attribute__((ext_vector_type(4)));
typedef float f32x4 __attribute__((ext_vector_type(4)));
typedef unsigned u32x4 __attribute__((ext_vector_type(4)));
typedef unsigned u32x2 __attribute__((ext_vector_type(2)));

constexpr int TOK_P = 16384, TOK_ALL = 81920, UNIT = 2048;
constexpr int DIN = 11280, NPAD = 11520;
constexpr int LDS_BYTES = 163840;
constexpr int L_ITEM = LDS_BYTES - 16;
constexpr int QS = 528, VS = 144;
constexpr int VSW = 176;
constexpr int L_Q = 0, L_K = 33792, L_ST = 67584, L_V = 101376, L_VW = 110592, L_P = 121856, L_SM = 131072;
constexpr int SM_W = 256, SM_QN = 320, SM_RS = 384  , SM_N = 640  ;
constexpr int L_NP = 132864  , L_GU = 134912, L_GC = 143104, L_GB = 151296, L_GM = 159488;
constexpr int NA_VH = 73728, L_RPB = 147456;

struct Params {
    const float *xp, *xs, *norm_w, *w_in, *b_gate, *conv_w, *conv_b, *mh_w, *rpb, *wda, *wdb, *wout, *fnw;
    float* out;
    unsigned char* ws;
    unsigned long long o_winT, o_wdaT, o_wdbT, o_woutT, o_ctr, o_bar, o_state, o_gates, o_xn, o_act;
    int Mr, nrounds, ph_lo, ph_hi;
};

__device__ __forceinline__ us f2bf(float f) { unsigned u = __float_as_uint(f); u += 0x7FFFu + ((u >> 16) & 1u); return (us)(u >> 16); }
__device__ __forceinline__ float bf2f(unsigned b) { return __uint_as_float(b << 16); }
typedef float f32x2_ __attribute__((ext_vector_type(2)));
typedef __bf16 bf16x2_ __attribute__((ext_vector_type(2)));
__device__ __forceinline__ unsigned pk2(float lo, float hi) { f32x2_ v = {lo, hi}; bf16x2_ b = __builtin_convertvector(v, bf16x2_); return __builtin_bit_cast(unsigned, b); }
__device__ __forceinline__ float bflo(unsigned w) { return __uint_as_float(w << 16); }
__device__ __forceinline__ float bfhi(unsigned w) { return __uint_as_float(w & 0xFFFF0000u); }
__device__ __forceinline__ float sigmoidf_(float x) { return __builtin_amdgcn_rcpf(1.0f + __expf(-x)); }
__device__ __forceinline__ float siluf_(float x) { return x * __builtin_amdgcn_rcpf(1.0f + __expf(-x)); }
__device__ __forceinline__ const float* xrow(const Params& p, int t) { return t < TOK_P ? p.xp + (size_t)t * 1024 : p.xs + (size_t)(t - TOK_P) * 1024; }
__device__ __forceinline__ void seq_of(int t, int& s0, int& len) { if (t < TOK_P) { s0 = 0; len = TOK_P; } else { s0 = TOK_P + ((t - TOK_P) / UNIT) * UNIT; len = UNIT; } }
__device__ __forceinline__ us* actp(const Params& p, int i) { return (us*)(p.ws + p.o_act) + (size_t)i * p.Mr * 1024; }
__device__ __forceinline__ f32x4 mfma16(bf16x8 a, bf16x8 b, f32x4 c) { return __builtin_amdgcn_mfma_f32_16x16x32_bf16(a, b, c, 0, 0, 0); }
__device__ __forceinline__ bf16x8 tr8(LAS unsigned char* base, int off0, int off1) {
    s16x4 lo = __builtin_amdgcn_ds_read_tr16_b64_v4i16((LAS s16x4*)(base + off0));
    s16x4 hi = __builtin_amdgcn_ds_read_tr16_b64_v4i16((LAS s16x4*)(base + off1));
    return __builtin_shufflevector(lo, hi, 0, 1, 2, 3, 4, 5, 6, 7);
}

struct EpiIn {
    static constexpr bool PERM = true, AFTER_DRAIN = false, PAIR = false;
    us* act; size_t split_stride; float* gates; const float* b_gate;
    __device__ __forceinline__ void operator()(const pg8::f32x4 (&acc)[2][2][4][2], const pg8::Unit& u, int wr, int wc, int fr, int fq) const {
        const int row0 = u.pm * 256 + wr * 64 + fr;
        if (u.pn < 44) {
            const int t = u.pn >> 2;
            us* base = act + (size_t)t * split_stride;
            const int col0 = (u.pn & 3) * 256 + wc * 32 + 8 * fq;
            if (t >= 5 && t <= 7) {
                const size_t hstride = split_stride >> 4;
#pragma unroll
                for (int ai = 0; ai < 2; ++ai)
#pragma unroll
                    for (int m = 0; m < 4; ++m) { const size_t ro = (size_t)(row0 + ai * 128 + m * 16) * 64;
#pragma unroll
                        for (int bj = 0; bj < 2; ++bj) { const pg8::f32x4 v0 = acc[ai][bj][m][0], v1 = acc[ai][bj][m][1]; const int col = col0 + bj * 128;
                            u32x4 w; w.x = pk2(v0[0], v0[1]); w.y = pk2(v0[2], v0[3]); w.z = pk2(v1[0], v1[1]); w.w = pk2(v1[2], v1[3]);
                            *(u32x4*)(base + (size_t)(col >> 6) * hstride + ro + (col & 63)) = w; } }
            } else
#pragma unroll
            for (int ai = 0; ai < 2; ++ai)
#pragma unroll
                for (int m = 0; m < 4; ++m) { us* rowp = base + (size_t)(row0 + ai * 128 + m * 16) * 1024 + col0;
#pragma unroll
                    for (int bj = 0; bj < 2; ++bj) { const pg8::f32x4 v0 = acc[ai][bj][m][0], v1 = acc[ai][bj][m][1];
                        u32x4 w; w.x = pk2(v0[0], v0[1]); w.y = pk2(v0[2], v0[3]); w.z = pk2(v1[0], v1[1]); w.w = pk2(v1[2], v1[3]);
                        *(u32x4*)(rowp + bj * 128) = w; } }
        } else {
            if (wc == 0 && fq < 2) {
#pragma unroll
                for (int n = 0; n < 2; ++n) { const int c = 8 * fq + 4 * n; const f32x4 bv = *(const f32x4*)(b_gate + c);
#pragma unroll
                    for (int ai = 0; ai < 2; ++ai)
#pragma unroll
                        for (int m = 0; m < 4; ++m) { const int row = row0 + ai * 128 + m * 16; *(f32x4*)(gates + (size_t)row * 16 + c) = acc[ai][0][m][n] + bv; } }
            }
        }
    }
};
struct PairOrder : pg8::StaticOrder {
    __device__ bool next(int i, pg8::Unit& u) const { const bool ok = pg8::StaticOrder::next(i >> 1, u); u.w = i & 1; return ok; }
};
struct EpiPair {
    static constexpr bool PERM = true, AFTER_DRAIN = false, PAIR = true;
    const us* ga; const us* gb; us* merged;
    __device__ __forceinline__ void operator()(pg8::f32x4 (&acc)[2][2][4][2], const pg8::Unit& u, int wr, int wc, int fr, int fq) const {
        const int row0 = u.pm * 256 + wr * 64 + fr, col0 = u.pn * 256 + wc * 32 + 8 * fq;
        if (u.w == 0) {
#pragma unroll
            for (int ai = 0; ai < 2; ++ai) {
                u32x4 a[4][2], b[4][2];
#pragma unroll
                for (int m = 0; m < 4; ++m)
#pragma unroll
                    for (int bj = 0; bj < 2; ++bj) { const size_t o = (size_t)(row0 + ai * 128 + m * 16) * 1024 + col0 + bj * 128; a[m][bj] = *(const u32x4*)(ga + o); b[m][bj] = *(const u32x4*)(gb + o); }
#pragma unroll
                for (int m = 0; m < 4; ++m)
#pragma unroll
                    for (int bj = 0; bj < 2; ++bj)
#pragma unroll
                        for (int q = 0; q < 4; ++q) { const unsigned aw = a[m][bj][q], bw = b[m][bj][q];
                            const float r0 = (1.0f + __expf(-bflo(bw))) * __builtin_amdgcn_rcpf(1.0f + __expf(-bflo(aw))), r1 = (1.0f + __expf(-bfhi(bw))) * __builtin_amdgcn_rcpf(1.0f + __expf(-bfhi(aw)));
                            acc[ai][bj][m][q >> 1][(q & 1) * 2] *= r0; acc[ai][bj][m][q >> 1][(q & 1) * 2 + 1] *= r1; }
                asm volatile("" ::: "memory");
            }
        } else {
#pragma unroll
            for (int ai = 0; ai < 2; ++ai) {
                u32x4 b[4][2];
#pragma unroll
                for (int m = 0; m < 4; ++m)
#pragma unroll
                    for (int bj = 0; bj < 2; ++bj) { const size_t o = (size_t)(row0 + ai * 128 + m * 16) * 1024 + col0 + bj * 128; b[m][bj] = *(const u32x4*)(gb + o); }
#pragma unroll
                for (int m = 0; m < 4; ++m)
#pragma unroll
                    for (int bj = 0; bj < 2; ++bj) { const size_t o = (size_t)(row0 + ai * 128 + m * 16) * 1024 + col0 + bj * 128; u32x4 w;
#pragma unroll
                        for (int q = 0; q < 4; ++q) { const unsigned bw = b[m][bj][q];
                            w[q] = pk2(acc[ai][bj][m][q >> 1][(q & 1) * 2] * sigmoidf_(bflo(bw)), acc[ai][bj][m][q >> 1][(q & 1) * 2 + 1] * sigmoidf_(bfhi(bw))); }
                        *(u32x4*)(merged + o) = w; }
                asm volatile("" ::: "memory");
            }
        }
    }
};
struct EpiOut {
    static constexpr bool PERM = false, AFTER_DRAIN = false, PAIR = false;
    float* out; const float* xp; const float* xs; int T0;
    __device__ __forceinline__ void operator()(const pg8::f32x4 (&acc)[2][2][4][2], const pg8::Unit& u, int wr, int wc, int fr, int fq) const {
        const int row0 = u.pm * 256 + wr * 64 + fr, col0 = u.pn * 256 + wc * 32 + 4 * fq;
#pragma unroll
        for (int ai = 0; ai < 2; ++ai)
#pragma unroll
            for (int m = 0; m < 4; ++m) { const int row = row0 + ai * 128 + m * 16; const int t = T0 + row;
                const float* xr = (t < TOK_P ? xp + (size_t)t * 1024 : xs + (size_t)(t - TOK_P) * 1024) + col0; float* orow = out + (size_t)row * 1024 + col0;
#pragma unroll
                for (int bj = 0; bj < 2; ++bj)
#pragma unroll
                    for (int n = 0; n < 2; ++n) { const int o = bj * 128 + n * 16; *(f32x4*)(orow + o) = *(const f32x4*)(xr + o) + acc[ai][bj][m][n]; } }
    }
};

template <class Epi> __device__ __forceinline__ void run_gemm(unsigned char* shm, const us* A, const us* Bt, int M, int N, int K, const Epi& E) {
    pg8::Gemm g; g.A = A; g.Bt = Bt; g.M = M; g.N = N; g.K = K; g.A2 = A; g.Bt2 = Bt;
    pg8::StaticOrder S; S.init(M, N, (int)gridDim.x, (int)blockIdx.x);
    pg8::gemm_phase<Epi, pg8::StaticOrder, false>((LAS unsigned char*)shm, g, S, E, nullptr);
}

__device__ __forceinline__ void run_gemm_pair(unsigned char* shm, const us* A, const us* Bt, const us* A2, const us* Bt2, int M, int N, int K, const EpiPair& E) {
    pg8::Gemm g; g.A = A; g.Bt = Bt; g.M = M; g.N = N; g.K = K; g.A2 = A2; g.Bt2 = Bt2;
    PairOrder S; S.init(M, N, (int)gridDim.x, (int)blockIdx.x);
    pg8::gemm_phase<EpiPair, PairOrder, false>((LAS unsigned char*)shm, g, S, E, nullptr);
}

__device__ __forceinline__ void phase_weights(const Params& p, unsigned char* shm) {
    float* tile = (float*)shm;
    const int tid = threadIdx.x;
    for (int job = blockIdx.x; job < 2880 + 768; job += gridDim.x) {
        const float* src; int ld, col0, nvalid, kt; us* dst;
        if (job < 2880) { const int nt = job >> 4; kt = job & 15; src = p.w_in; ld = DIN; const int n0 = nt * 64;
            if (n0 < 5120) { col0 = n0; nvalid = 64; } else if (n0 < 11264) { col0 = n0 + 16; nvalid = 64; } else if (n0 == 11264) { col0 = 5120; nvalid = 16; } else { col0 = 0; nvalid = 0; }
            dst = (us*)(p.ws + p.o_winT) + (size_t)n0 * 1024;
        } else { const int j2 = job - 2880, which = j2 >> 8, t = j2 & 255, nt = t >> 4; kt = t & 15; ld = 1024; col0 = nt * 64; nvalid = 64;
            src = which == 0 ? p.wda : (which == 1 ? p.wdb : p.wout);
            dst = (us*)(p.ws + (which == 0 ? p.o_wdaT : (which == 1 ? p.o_wdbT : p.o_woutT))) + (size_t)nt * 64 * 1024; }
        __syncthreads();
        { const int j = tid & 63, i0 = tid >> 6;
#pragma unroll
          for (int ii = 0; ii < 8; ++ii) { const int i = i0 + 8 * ii; tile[i * 65 + j] = (j < nvalid) ? src[(size_t)(kt * 64 + i) * ld + col0 + j] : 0.f; } }
        __syncthreads();
        { const int i = tid & 63, j0 = tid >> 6;
#pragma unroll
          for (int jj = 0; jj < 8; ++jj) { const int j = j0 + 8 * jj; dst[(size_t)j * 1024 + kt * 64 + i] = f2bf(tile[i * 65 + j]); } }
    }
    __syncthreads();
}

__device__ __forceinline__ void phase_xnorm(const Params& p, int T0, int Mc) {
    const int wave = threadIdx.x >> 6, lane = threadIdx.x & 63;
    us* xn = (us*)(p.ws + p.o_xn);
    f32x4 nw[4];
#pragma unroll
    for (int j = 0; j < 4; ++j) nw[j] = *(const f32x4*)(p.norm_w + lane * 4 + 256 * j);
    for (int r = blockIdx.x * 8 + wave; r < Mc; r += gridDim.x * 8) {
        const float* xr = xrow(p, T0 + r);
        f32x4 v[4]; float ss = 0.f;
#pragma unroll
        for (int j = 0; j < 4; ++j) { v[j] = *(const f32x4*)(xr + lane * 4 + 256 * j); ss += v[j][0] * v[j][0] + v[j][1] * v[j][1] + v[j][2] * v[j][2] + v[j][3] * v[j][3]; }
#pragma unroll
        for (int o = 32; o >= 1; o >>= 1) ss += __shfl_xor(ss, o);
        const float rs = rsqrtf(ss * (1.0f / 1024.0f) + 1e-6f);
#pragma unroll
        for (int j = 0; j < 4; ++j) { u32x2 w; w.x = pk2(v[j][0] * rs * nw[j][0], v[j][1] * rs * nw[j][1]); w.y = pk2(v[j][2] * rs * nw[j][2], v[j][3] * rs * nw[j][3]);
            *(u32x2*)(xn + (size_t)r * 1024 + lane * 4 + 256 * j) = w; }
    }
}

__device__ __forceinline__ void phase_fnorm(const Params& p, int T0, int Mc) {
    const int wave = threadIdx.x >> 6, lane = threadIdx.x & 63;
    f32x4 nw[4];
#pragma unroll
    for (int j = 0; j < 4; ++j) nw[j] = *(const f32x4*)(p.fnw + lane * 4 + 256 * j);
    for (int r = blockIdx.x * 8 + wave; r < Mc; r += gridDim.x * 8) {
        float* xr = p.out + (size_t)(T0 + r) * 1024;
        f32x4 v[4]; float ss = 0.f;
#pragma unroll
        for (int j = 0; j < 4; ++j) { v[j] = *(const f32x4*)(xr + lane * 4 + 256 * j); ss += v[j][0] * v[j][0] + v[j][1] * v[j][1] + v[j][2] * v[j][2] + v[j][3] * v[j][3]; }
#pragma unroll
        for (int o = 32; o >= 1; o >>= 1) ss += __shfl_xor(ss, o);
        const float rs = rsqrtf(ss * (1.0f / 1024.0f) + 1e-6f);
#pragma unroll
        for (int j = 0; j < 4; ++j) { f32x4 w; w[0] = v[j][0] * rs * nw[j][0]; w[1] = v[j][1] * rs * nw[j][1]; w[2] = v[j][2] * rs * nw[j][2]; w[3] = v[j][3] * rs * nw[j][3];
            *(f32x4*)(xr + lane * 4 + 256 * j) = w; }
    }
}

__device__ __forceinline__ void phase_gates(const Params& p, int Mc) {
    const int wave = threadIdx.x >> 6, lane = threadIdx.x & 63, fr = lane & 15, fq = lane >> 4;
    const us* xn = (const us*)(p.ws + p.o_xn);
    const us* wg = (const us*)(p.ws + p.o_winT) + (size_t)(11264 + fr) * 1024 + fq * 8;
    float* gates = (float*)(p.ws + p.o_gates);
    const float bias = p.b_gate[fr];
    for (int task = blockIdx.x * 8 + wave; task < Mc / 16; task += gridDim.x * 8) {
        const us* ar = xn + (size_t)(task * 16 + fr) * 1024 + fq * 8;
        f32x4 acc0 = (f32x4){0.f, 0.f, 0.f, 0.f}, acc1 = acc0;
#pragma unroll 8
        for (int kk = 0; kk < 32; kk += 2) {
            const bf16x8 a0 = *(const bf16x8*)(ar + kk * 32), a1 = *(const bf16x8*)(ar + kk * 32 + 32);
            const bf16x8 b0 = *(const bf16x8*)(wg + kk * 32), b1 = *(const bf16x8*)(wg + kk * 32 + 32);
            acc0 = mfma16(a0, b0, acc0); acc1 = mfma16(a1, b1, acc1);
        }
#pragma unroll
        for (int i = 0; i < 4; ++i) gates[(size_t)(task * 16 + 4 * fq + i) * 16 + fr] = acc0[i] + acc1[i] + bias;
    }
}

__device__ __forceinline__ void phase_conv(const Params& p, int T0, int Mc) {
    const int tid = threadIdx.x, ct = tid & 255, tensor = ct >> 7, cgp = ct & 127, sub = tid >> 8;
    const us* src = actp(p, tensor);
    us* dst = (us*)(p.out + (size_t)T0 * 1024) + (size_t)tensor * Mc * 1024;
    const int ch0 = tensor * 1024 + cgp * 8;
    float w[5][8], b[8];
#pragma unroll
    for (int e = 0; e < 8; ++e) { b[e] = p.conv_b[ch0 + e];
#pragma unroll
        for (int i = 0; i < 5; ++i) w[i][e] = p.conv_w[i * 2048 + ch0 + e]; }
    const float oscale = tensor ? 0.0625f : 1.0f;
    for (int item = blockIdx.x; item < Mc / 32; item += gridDim.x) {
        const int r0 = (item * 2 + sub) * 16;
        int s0, len; seq_of(T0 + r0, s0, len);
        const int lo = s0 - T0, hi = lo + len;
        u32x4 rows[20];
#pragma unroll
        for (int i = 0; i < 20; ++i) { const int r = r0 - 2 + i; rows[i] = (r >= lo && r < hi) ? *(const u32x4*)(src + (size_t)r * 1024 + cgp * 8) : (u32x4){0u, 0u, 0u, 0u}; }
#pragma unroll
        for (int o = 0; o < 16; ++o) {
            float a[8];
#pragma unroll
            for (int e = 0; e < 8; ++e) a[e] = b[e];
#pragma unroll
            for (int i = 0; i < 5; ++i) { const u32x4 rw = rows[o + i];
                a[0] += w[i][0] * bflo(rw.x); a[1] += w[i][1] * bfhi(rw.x); a[2] += w[i][2] * bflo(rw.y); a[3] += w[i][3] * bfhi(rw.y);
                a[4] += w[i][4] * bflo(rw.z); a[5] += w[i][5] * bfhi(rw.z); a[6] += w[i][6] * bflo(rw.w); a[7] += w[i][7] * bfhi(rw.w); }
#pragma unroll
            for (int e = 0; e < 8; ++e) a[e] = siluf_(a[e]) * oscale;
            u32x4 wv; wv.x = pk2(a[0], a[1]); wv.y = pk2(a[2], a[3]); wv.z = pk2(a[4], a[5]); wv.w = pk2(a[6], a[7]);
            *(u32x4*)(dst + (size_t)(r0 + o) * 1024 + cgp * 8) = wv;
        }
    }
}

__device__ __forceinline__ void phase_ya(const Params& p, int Mc) {
    const int wave = threadIdx.x >> 6, lane = threadIdx.x & 63;
    const us* hf = actp(p, 0); const us* hb = actp(p, 1); const us* mo = actp(p, 3); const us* mz = actp(p, 4);
    us* ya = actp(p, 0);
    float mw[16];
#pragma unroll
    for (int i = 0; i < 16; ++i) mw[i] = p.mh_w[lane * 16 + i];
    for (int r = blockIdx.x * 8 + wave; r < Mc; r += gridDim.x * 8) {
        const size_t o = (size_t)r * 1024 + lane * 16;
        float h[16]; float ss = 0.f;
        unsigned zz[8];
#pragma unroll
        for (int c = 0; c < 2; ++c) {
            const u32x4 a = *(const u32x4*)(hf + o + c * 8), b = *(const u32x4*)(hb + o + c * 8), g = *(const u32x4*)(mo + o + c * 8), z = *(const u32x4*)(mz + o + c * 8);
#pragma unroll
            for (int q = 0; q < 4; ++q) { const unsigned aw = a[q], bw = b[q], gw = g[q];
                h[c * 8 + 2 * q] = (bflo(aw) + bflo(bw)) * sigmoidf_(bflo(gw)); h[c * 8 + 2 * q + 1] = (bfhi(aw) + bfhi(bw)) * sigmoidf_(bfhi(gw)); zz[c * 4 + q] = z[q]; }
        }
#pragma unroll
        for (int i = 0; i < 16; ++i) ss += h[i] * h[i];
        ss += __shfl_xor(ss, 1); ss += __shfl_xor(ss, 2); ss += __shfl_xor(ss, 4); ss += __shfl_xor(ss, 8);
        const float rn = rsqrtf(ss * (1.0f / 256.0f) + 1e-6f);
        unsigned w[8];
#pragma unroll
        for (int q = 0; q < 8; ++q) w[q] = pk2(h[2 * q] * rn * mw[2 * q] * siluf_(bflo(zz[q])), h[2 * q + 1] * rn * mw[2 * q + 1] * siluf_(bfhi(zz[q])));
        *(u32x4*)(ya + o) = (u32x4){w[0], w[1], w[2], w[3]}; *(u32x4*)(ya + o + 8) = (u32x4){w[4], w[5], w[6], w[7]};
    }
}

constexpr int ST_REC = 16896;
template <bool STATE_ONLY>
__device__ __forceinline__ void mlstm_chain(const Params& p, unsigned char* shm, int T0, int Mc, int s0, int len, int head, int dir, int split, int c0, int c1,
                                            const float* st_in, int n_prev, float* st_out) {
    LAS unsigned char* lds = (LAS unsigned char*)shm;
    LAS float* sm = (LAS float*)(lds + L_SM);
    const int tid = threadIdx.x, w = tid >> 6, lane = tid & 63, fr = lane & 15, fq = lane >> 4;
    const us* qc = (const us*)(p.out + (size_t)T0 * 1024); const us* kc = qc + (size_t)Mc * 1024;
    const us* mv = actp(p, 2); const float* gates = (const float*)(p.ws + p.o_gates);
    us* hout = actp(p, dir);
    const int base = dir ? (s0 + len - 1 - T0) : (s0 - T0); const int sgn = dir ? -1 : 1;
    const size_t hoff = (size_t)head * 256;
    u32x4 rq[4], rk[4], rv;
    LAS float* GU = (LAS float*)(lds + L_GU); LAS float* GC = (LAS float*)(lds + L_GC); LAS float* GB = (LAS float*)(lds + L_GB); LAS float* GM = (LAS float*)(lds + L_GM); LAS unsigned char* NBF = lds + L_NP;
    f32x4 Sacc[2][5];
#pragma unroll
    for (int a = 0; a < 2; ++a)
#pragma unroll
        for (int b = 0; b < 5; ++b) Sacc[a][b] = (f32x4){0.f, 0.f, 0.f, 0.f};
    float mstate = 0.f;
    if constexpr (!STATE_ONLY) {
        float nval = 0.f;
        for (int g = 0; g < n_prev; ++g) { const float* rec = st_in + (size_t)g * ST_REC; const float m_loc = rec[16640], B = rec[16641];
            const float m_new = fmaxf(B + mstate, m_loc), a1 = __expf(B + mstate - m_new), a2 = __expf(m_loc - m_new);
#pragma unroll
            for (int dd = 0; dd < 2; ++dd)
#pragma unroll
                for (int e4 = 0; e4 < 4; ++e4) { const f32x4 sl = *(const f32x4*)(rec + (size_t)((((w * 2 + dd) * 4 + e4) * 64 + lane) * 4)); Sacc[dd][e4] = a1 * Sacc[dd][e4] + a2 * sl; }
            if (tid < 256) nval = a1 * nval + a2 * rec[16384 + tid];
            mstate = m_new; }
        if (tid < 256) sm[SM_N + tid] = nval;
        __syncthreads();
#pragma unroll
        for (int dd = 0; dd < 2; ++dd)
#pragma unroll
            for (int i = 0; i < 4; ++i) Sacc[dd][4][i] = (fr == 0) ? sm[SM_N + (w * 2 + dd) * 16 + 4 * fq + i] : 0.f;
        if (fr == 0) {
#pragma unroll
            for (int dd = 0; dd < 2; ++dd) { u32x2 nb; nb.x = pk2(Sacc[dd][4][0], Sacc[dd][4][1]); nb.y = pk2(Sacc[dd][4][2], Sacc[dd][4][3]); *(LAS u32x2*)(NBF + ((w * 2 + dd) * 16 + 4 * fq) * 2) = nb; }
        }
#pragma unroll
        for (int dd = 0; dd < 2; ++dd)
#pragma unroll
            for (int e4 = 0; e4 < 4; ++e4) { const f32x4 sv = Sacc[dd][e4]; u32x2 wv; wv.x = pk2(sv[0], sv[1]); wv.y = pk2(sv[2], sv[3]);
                *(LAS u32x2*)(lds + L_ST + (e4 * 16 + fr) * QS + ((w * 2 + dd) * 16 + 4 * fq) * 2) = wv; }
    } else {
        if (tid < 256) sm[SM_N + tid] = 0.f;
    }
#define CH_LOAD(c) do { \
        _Pragma("unroll") for (int i = 0; i < 4; ++i) { const int id = tid + 512 * i, row = id >> 5, ch = id & 31; const size_t lr = (size_t)(base + sgn * ((c) * 64 + row)); \
            if (!STATE_ONLY) rq[i] = *(const u32x4*)(qc + lr * 1024 + hoff + ch * 8); rk[i] = *(const u32x4*)(kc + lr * 1024 + hoff + ch * 8); } \
        { const int row = tid >> 3, ch = tid & 7; const size_t lr = (size_t)(base + sgn * ((c) * 64 + row)); rv = *(const u32x4*)(mv + lr * 1024 + hoff + split * 64 + ch * 8); } \
 } while (0)
#define CH_STORE() do { \
        _Pragma("unroll") for (int i = 0; i < 4; ++i) { const int id = tid + 512 * i, row = id >> 5, ch = id & 31; \
            if (!STATE_ONLY) *(LAS u32x4*)(lds + L_Q + row * QS + ch * 16) = rq[i]; *(LAS u32x4*)(lds + L_K + row * QS + ch * 16) = rk[i]; } \
        { const int row = tid >> 3, ch = tid & 7; *(LAS u32x4*)(lds + L_V + row * VS + ch * 16) = rv; } } while (0)
    CH_LOAD(c0);
    for (int cc = w; cc < c1 - c0; cc += 8) {
        const size_t lr = (size_t)(base + sgn * ((c0 + cc) * 64 + lane));
        const float li = gates[lr * 16 + dir * 8 + head], gfv = gates[lr * 16 + dir * 8 + 4 + head];
        const float lf = fminf(gfv, 0.f) - log1pf(__expf(-fabsf(gfv)));
        float b = lf;
#pragma unroll
        for (int o = 1; o < 64; o <<= 1) { const float t = __shfl_up(b, o); if (lane >= o) b += t; }
        const float u = li - b; float cm = u;
#pragma unroll
        for (int o = 1; o < 64; o <<= 1) { const float t = __shfl_up(cm, o); if (lane >= o) cm = fmaxf(cm, t); }
        GU[cc * 64 + lane] = u; GC[cc * 64 + lane] = cm; GB[cc * 64 + lane] = b;
    }
    CH_STORE();
    __syncthreads();
    if (tid == 0) { float m = mstate, bt = 0.f;
        for (int cc = 0; cc < c1 - c0; ++cc) { GM[cc] = m; const float M63 = fmaxf(m, GC[cc * 64 + 63]), b63 = GB[cc * 64 + 63]; m = b63 + M63; bt += b63; }
        GM[32] = m; GM[33] = bt; }
    const int tA = w & 3, jt0 = (w >> 2) * 2;
    for (int c = c0; c < c1; ++c) {
        if (c + 1 < c1) CH_LOAD(c + 1);
        __syncthreads();
        const int cg_ = (c - c0) * 64; const float m_c = GM[c - c0]; const float M63 = fmaxf(m_c, GC[cg_ + 63]);
        f32x4 h0 = (f32x4){0.f, 0.f, 0.f, 0.f}, h1 = h0, qn0 = h0, qn1 = h0;
        if constexpr (!STATE_ONLY) {
            f32x4 sc0 = (f32x4){0.f, 0.f, 0.f, 0.f}, sc1 = sc0;
#pragma unroll 4
            for (int kk = 0; kk < 8; ++kk) {
                const bf16x8 a = *(LAS bf16x8*)(lds + L_K + (tA * 16 + fr) * QS + kk * 64 + fq * 16);
                const bf16x8 a2 = *(LAS bf16x8*)(lds + L_ST + (tA * 16 + fr) * QS + kk * 64 + fq * 16);
                const bf16x8 b0 = *(LAS bf16x8*)(lds + L_Q + (jt0 * 16 + fr) * QS + kk * 64 + fq * 16);
                const bf16x8 b1 = *(LAS bf16x8*)(lds + L_Q + ((jt0 + 1) * 16 + fr) * QS + kk * 64 + fq * 16);
                sc0 = mfma16(a, b0, sc0); sc1 = mfma16(a, b1, sc1);
                h0 = mfma16(a2, b0, h0); h1 = mfma16(a2, b1, h1);
                const bf16x8 nf = *(LAS bf16x8*)(NBF + kk * 64 + fq * 16);
                qn0 = mfma16(nf, b0, qn0); qn1 = mfma16(nf, b1, qn1);
            }
            const int sb = tA * 16 + 4 * fq;
            const f32x4 uv = *(LAS f32x4*)(GU + cg_ + sb);
#pragma unroll
            for (int jt = 0; jt < 2; ++jt) { const int j = (jt0 + jt) * 16 + fr; const float Mj = fmaxf(m_c, GC[cg_ + j]); const f32x4 sc = jt ? sc1 : sc0;
                float v[4];
#pragma unroll
                for (int i = 0; i < 4; ++i) v[i] = (sb + i <= j) ? sc[i] * __expf(uv[i] - Mj) : 0.f;
                u32x2 wv; wv.x = pk2(v[0], v[1]); wv.y = pk2(v[2], v[3]);
                *(LAS u32x2*)(lds + L_P + j * VS + sb * 2) = wv;
                }
        }
        {
            const int s = tid >> 3, ch = tid & 7; const float ws_ = __expf(GU[cg_ + s] - M63); const u32x4 vv = *(LAS u32x4*)(lds + L_V + s * VS + ch * 16);
            u32x4 o; o.x = pk2(bflo(vv.x) * ws_, bfhi(vv.x) * ws_); o.y = pk2(bflo(vv.y) * ws_, bfhi(vv.y) * ws_); o.z = pk2(bflo(vv.z) * ws_, bfhi(vv.z) * ws_); o.w = pk2(bflo(vv.w) * ws_, bfhi(vv.w) * ws_);
            *(LAS u32x4*)(lds + L_VW + s * VSW + ch * 16) = o;
            if (ch == 0) { *(LAS u32x4*)(lds + L_VW + s * VSW + 128) = (u32x4){pk2(ws_, 0.f), 0u, 0u, 0u}; *(LAS u32x4*)(lds + L_VW + s * VSW + 144) = (u32x4){0u, 0u, 0u, 0u}; }
        }
        __syncthreads();
        if constexpr (!STATE_ONLY) {
            const int j0 = jt0 * 16 + fr, j1 = j0 + 16;
            const float Mj0 = fmaxf(m_c, GC[cg_ + j0]), Mj1 = fmaxf(m_c, GC[cg_ + j1]);
            const float wi0 = __expf(m_c - Mj0), wi1 = __expf(m_c - Mj1);
            h0 *= wi0; h1 *= wi1;
            f32x4 rs0 = (f32x4){0.f, 0.f, 0.f, 0.f}, rs1 = rs0;
            const bf16x8 ones = (bf16x8){(short)0x3F80, (short)0x3F80, (short)0x3F80, (short)0x3F80, (short)0x3F80, (short)0x3F80, (short)0x3F80, (short)0x3F80};
#pragma unroll
            for (int ks = 0; ks < 2; ++ks) {
                const int o0 = (ks * 32 + 8 * fq + (fr >> 2)) * VS + (tA * 16 + 4 * (fr & 3)) * 2;
                const bf16x8 a = tr8(lds + L_V, o0, o0 + 4 * VS);
                const bf16x8 b0 = *(LAS bf16x8*)(lds + L_P + j0 * VS + ks * 64 + fq * 16);
                const bf16x8 b1 = *(LAS bf16x8*)(lds + L_P + j1 * VS + ks * 64 + fq * 16);
                h0 = mfma16(a, b0, h0); h1 = mfma16(a, b1, h1);
                rs0 = mfma16(ones, b0, rs0); rs1 = mfma16(ones, b1, rs1);
            }
            const float den0 = wi0 * qn0[0] + rs0[0], den1 = wi1 * qn1[0] + rs1[0];
            const float sc0 = __builtin_amdgcn_rcpf(fmaxf(fabsf(den0), __expf(-GB[cg_ + j0] - Mj0))), sc1 = __builtin_amdgcn_rcpf(fmaxf(fabsf(den1), __expf(-GB[cg_ + j1] - Mj1)));
            h0 *= sc0; h1 *= sc1;
            const size_t lr0 = (size_t)(base + sgn * (c * 64 + j0)), lr1 = (size_t)(base + sgn * (c * 64 + j1));
            const int eo = split * 64 + tA * 16 + 4 * fq;
            u32x2 w0, w1; w0.x = pk2(h0[0], h0[1]); w0.y = pk2(h0[2], h0[3]); w1.x = pk2(h1[0], h1[1]); w1.y = pk2(h1[2], h1[3]);
            *(u32x2*)(hout + lr0 * 1024 + hoff + eo) = w0; *(u32x2*)(hout + lr1 * 1024 + hoff + eo) = w1;
        }
        {
            const float a_ = __expf(m_c - M63);
#pragma unroll
            for (int dd = 0; dd < 2; ++dd)
#pragma unroll
                for (int e4 = 0; e4 < 5; ++e4) Sacc[dd][e4] *= a_;
#pragma unroll 1
            for (int ks = 0; ks < 2; ++ks) {
                const int rbase = ks * 32 + 8 * fq + (fr >> 2);
                bf16x8 A[2], B[5];
#pragma unroll
                for (int dd = 0; dd < 2; ++dd) { const int o0 = rbase * QS + ((w * 2 + dd) * 16 + 4 * (fr & 3)) * 2; A[dd] = tr8(lds + L_K, o0, o0 + 4 * QS); }
#pragma unroll
                for (int e4 = 0; e4 < 5; ++e4) { const int o0 = rbase * VSW + (e4 * 16 + 4 * (fr & 3)) * 2; B[e4] = tr8(lds + L_VW, o0, o0 + 4 * VSW); }
#pragma unroll
                for (int dd = 0; dd < 2; ++dd)
#pragma unroll
                    for (int e4 = 0; e4 < 5; ++e4) Sacc[dd][e4] = mfma16(A[dd], B[e4], Sacc[dd][e4]);
            }
            if constexpr (!STATE_ONLY) {
#pragma unroll
                for (int dd = 0; dd < 2; ++dd)
#pragma unroll
                    for (int e4 = 0; e4 < 4; ++e4) { const f32x4 sv = Sacc[dd][e4]; u32x2 wv; wv.x = pk2(sv[0], sv[1]); wv.y = pk2(sv[2], sv[3]);
                        *(LAS u32x2*)(lds + L_ST + (e4 * 16 + fr) * QS + ((w * 2 + dd) * 16 + 4 * fq) * 2) = wv; }
            }
            if (fr == 0) {
#pragma unroll
                for (int dd = 0; dd < 2; ++dd) { *(LAS f32x4*)(sm + SM_N + (w * 2 + dd) * 16 + 4 * fq) = Sacc[dd][4];
                    if (!STATE_ONLY) { u32x2 nb; nb.x = pk2(Sacc[dd][4][0], Sacc[dd][4][1]); nb.y = pk2(Sacc[dd][4][2], Sacc[dd][4][3]); *(LAS u32x2*)(NBF + ((w * 2 + dd) * 16 + 4 * fq) * 2) = nb; } }
            }
        }
        __syncthreads();
        if (c + 1 < c1) { CH_STORE(); }
    }
#undef CH_LOAD
#undef CH_STORE
    if constexpr (STATE_ONLY) {
#pragma unroll
        for (int dd = 0; dd < 2; ++dd)
#pragma unroll
            for (int e4 = 0; e4 < 4; ++e4) *(f32x4*)(st_out + (size_t)((((w * 2 + dd) * 4 + e4) * 64 + lane) * 4)) = Sacc[dd][e4];
        if (tid < 256) st_out[16384 + tid] = sm[SM_N + tid];
        if (tid == 0) { st_out[16640] = GM[32]; st_out[16641] = GM[33]; }
    }
}

__device__ __forceinline__ void na_item(const Params& p, unsigned char* shm, int T0, int gpair, int head) {
    LAS unsigned char* lds = (LAS unsigned char*)shm;
    LAS float* rpbs = (LAS float*)(lds + L_RPB);
    constexpr int VOFF = 73728;
    const int tid = threadIdx.x, w = tid >> 6, lane = tid & 63, fr = lane & 15, fq = lane >> 4;
    const int n = w & 3, rr = w >> 2;
    const us* nq = actp(p, 5); const us* nk = actp(p, 6); const us* nv = actp(p, 7); const us* nz = actp(p, 8);
    us* yb = (us*)(p.ws + p.o_xn);
    const size_t hstr = (size_t)p.Mr * 64;
    const int tokA = T0 + gpair * 128; int s0, len; seq_of(tokA, s0, len);
    const int rows = len / 64, r0 = (tokA - s0) / 64, r = r0 + rr;
    const int rsb = min(max(r0 - 4, 0), rows - 8), rs1 = min(max(r0 - 3, 0), rows - 8);
    const int rs = rr ? rs1 : rsb;
    const int nkeys = (rs1 + 8 - rsb) * 64;
    const int wl0 = s0 + rsb * 64 - T0;
    const int kb = min(max(16 * n - 8, 0), 32);
    const size_t lrq = (size_t)(tokA - T0 + rr * 64 + 16 * n + fr);
    u32x4 kreg[9], vreg[9];
#pragma unroll
    for (int i = 0; i < 9; ++i) { const int id = tid + 512 * i, key = id >> 3, ch = id & 7;
        if (key < nkeys) { kreg[i] = *(const u32x4*)(nk + (size_t)head * hstr + (size_t)(wl0 + key) * 64 + ch * 8); vreg[i] = *(const u32x4*)(nv + (size_t)head * hstr + (size_t)(wl0 + key) * 64 + ch * 8); } }
    bf16x8 qf[2];
#pragma unroll
    for (int ks = 0; ks < 2; ++ks) qf[ks] = *(const bf16x8*)(nq + head * hstr + lrq * 64 + ks * 32 + fq * 8);
    float rp0 = 0.f;
    if (tid < 465) rp0 = p.rpb[head * 465 + tid] * 1.44269504f;
#pragma unroll
    for (int i = 0; i < 9; ++i) { const int id = tid + 512 * i, key = id >> 3, ch = id & 7;
        if (key < nkeys) { const int o = key * 128 + ((ch ^ (key & 7)) * 16); *(LAS u32x4*)(lds + o) = kreg[i]; *(LAS u32x4*)(lds + VOFF + o) = vreg[i]; } }
    if (tid < 465) rpbs[tid] = rp0;
    __syncthreads();
    u32x2 zreg[4];
#pragma unroll
    for (int dt = 0; dt < 4; ++dt) zreg[dt] = *(const u32x2*)(nz + lrq * 1024 + head * 64 + dt * 16 + 4 * fq);
    f32x4 s[16];
    const int krow0 = (rs - rsb) * 64 + kb + fr;
#pragma unroll
    for (int t = 0; t < 16; ++t) { s[t] = (f32x4){0.f, 0.f, 0.f, 0.f};
        const int key = krow0 + (t >> 1) * 64 + 16 * (t & 1);
#pragma unroll
        for (int ks = 0; ks < 2; ++ks) { const bf16x8 kf = *(LAS bf16x8*)(lds + key * 128 + (((ks * 4 + fq) ^ (key & 7)) * 16)); s[t] = mfma16(kf, qf[ks], s[t]); } }
    const int c = 16 * n + fr, cs = min(max(c - 8, 0), 48);
    bool vf[2][4];
#pragma unroll
    for (int hf2 = 0; hf2 < 2; ++hf2)
#pragma unroll
        for (int i = 0; i < 4; ++i) vf[hf2][i] = (unsigned)(kb + 16 * hf2 + 4 * fq + i - cs) < 16u;
    LAS float* bp = rpbs + ((rs - r + 7) * 31 + (kb - 16 * n + 4 * fq - fr + 15));
    float mx = -1e30f;
#pragma unroll
    for (int t = 0; t < 16; ++t)
#pragma unroll
        for (int i = 0; i < 4; ++i) { const float v = vf[t & 1][i] ? s[t][i] * 0.18033688f + bp[(t >> 1) * 31 + 16 * (t & 1) + i] : -1e30f; s[t][i] = v; mx = fmaxf(mx, v); }
    mx = fmaxf(mx, __shfl_xor(mx, 16)); mx = fmaxf(mx, __shfl_xor(mx, 32));
    float sum = 0.f;
#pragma unroll
    for (int t = 0; t < 16; ++t)
#pragma unroll
        for (int i = 0; i < 4; ++i) { const float e = __builtin_amdgcn_exp2f(s[t][i] - mx); s[t][i] = e; sum += e; }
    sum += __shfl_xor(sum, 16); sum += __shfl_xor(sum, 32);
    f32x4 o[4];
#pragma unroll
    for (int dt = 0; dt < 4; ++dt) o[dt] = (f32x4){0.f, 0.f, 0.f, 0.f};
    const int vrow0 = (rs - rsb) * 64 + kb + 4 * fq + (fr >> 2), pch = (fr & 3) >> 1, phalf = (fr & 3) & 1;
#pragma unroll
    for (int kk = 0; kk < 8; ++kk) {
        u32x4 pw; pw.x = pk2(s[2 * kk][0], s[2 * kk][1]); pw.y = pk2(s[2 * kk][2], s[2 * kk][3]); pw.z = pk2(s[2 * kk + 1][0], s[2 * kk + 1][1]); pw.w = pk2(s[2 * kk + 1][2], s[2 * kk + 1][3]);
        const bf16x8 pf = __builtin_bit_cast(bf16x8, pw);
        const int k0 = vrow0 + kk * 64, k1 = k0 + 16;
#pragma unroll
        for (int dt = 0; dt < 4; ++dt) { const int chunk = 2 * dt + pch;
            const bf16x8 a = tr8(lds + VOFF, k0 * 128 + ((chunk ^ (k0 & 7)) * 16) + phalf * 8, k1 * 128 + ((chunk ^ (k1 & 7)) * 16) + phalf * 8); o[dt] = mfma16(a, pf, o[dt]); }
    }
    const float inv = __builtin_amdgcn_rcpf(sum);
#pragma unroll
    for (int dt = 0; dt < 4; ++dt) { const size_t off = lrq * 1024 + head * 64 + dt * 16 + 4 * fq; const u32x2 z = zreg[dt];
        u32x2 wv; wv.x = pk2(o[dt][0] * inv * siluf_(bflo(z.x)), o[dt][1] * inv * siluf_(bfhi(z.x))); wv.y = pk2(o[dt][2] * inv * siluf_(bflo(z.y)), o[dt][3] * inv * siluf_(bfhi(z.y)));
        *(u32x2*)(yb + off) = wv; }
}

struct NaGeom { int s0, rows, r0, rsb, rs1; };
__device__ __forceinline__ NaGeom na_geom(int T0, int gpair) {
    NaGeom g; const int tokA = T0 + gpair * 128; int len; seq_of(tokA, g.s0, len);
    g.rows = len / 64; g.r0 = (tokA - g.s0) / 64;
    g.rsb = min(max(g.r0 - 4, 0), g.rows - 8); g.rs1 = min(max(g.r0 - 3, 0), g.rows - 8); return g;
}
__device__ __forceinline__ void na_band(const Params& p, unsigned char* shm, int T0, int Mc) {
    LAS unsigned char* lds = (LAS unsigned char*)shm;
    LAS float* rpbs = (LAS float*)(lds + L_RPB);
    constexpr int VOFF = 73728;
    const int tid = threadIdx.x, w = tid >> 6, lane = tid & 63, fr = lane & 15, fq = lane >> 4;
    const int n = w & 3, rr = w >> 2;
    const int head = blockIdx.x & 15, band = blockIdx.x >> 4, ppb = (Mc / 128) / 16;
    const us* nq = actp(p, 5) + (size_t)head * p.Mr * 64; const us* nk = actp(p, 6) + (size_t)head * p.Mr * 64; const us* nv = actp(p, 7) + (size_t)head * p.Mr * 64;
    const us* nz = actp(p, 8); us* yb = (us*)(p.ws + p.o_xn);
    const int kb = min(max(16 * n - 8, 0), 32);
    const int c = 16 * n + fr, cs = min(max(c - 8, 0), 48);
    const int ccol = tid >> 3, cch = tid & 7;
    const int cswz = (ccol * 128) + ((cch ^ (ccol & 7)) * 16);
    if (tid < 465) rpbs[tid] = p.rpb[head * 465 + tid] * 1.44269504f;
    bool vf[2][4];
#pragma unroll
    for (int hf2 = 0; hf2 < 2; ++hf2)
#pragma unroll
        for (int i = 0; i < 4; ++i) vf[hf2][i] = (unsigned)(kb + 16 * hf2 + 4 * fq + i - cs) < 16u;
    u32x4 kpf[2], vpf[2]; bf16x8 qfn[2];
    int prev_hi = 0, prev_s0 = -1;
    {
        const int gp0 = band * ppb; const size_t lq = (size_t)(gp0 * 128 + rr * 64 + 16 * n + fr);
#pragma unroll
        for (int ks = 0; ks < 2; ++ks) qfn[ks] = *(const bf16x8*)(nq + lq * 64 + ks * 32 + fq * 8);
    }
    for (int k = 0; k < ppb; ++k) {
        const int gpair = band * ppb + k; const NaGeom g = na_geom(T0, gpair);
        const int hi = g.rs1 + 8; const bool fresh = (g.s0 != prev_s0);
        const int r = g.r0 + rr, rs = rr ? g.rs1 : g.rsb;
        const size_t lrq = (size_t)(gpair * 128 + rr * 64 + 16 * n + fr);
        const size_t rowbase = (size_t)(g.s0 - T0) * 64 + (size_t)ccol * 64 + cch * 8;
        __syncthreads();
        if (fresh) {
            u32x4 kreg[9], vreg[9];
#pragma unroll
            for (int i = 0; i < 9; ++i) { const int R = g.rsb + i; if (R < hi) { kreg[i] = *(const u32x4*)(nk + rowbase + (size_t)R * 4096); vreg[i] = *(const u32x4*)(nv + rowbase + (size_t)R * 4096); } }
#pragma unroll
            for (int i = 0; i < 9; ++i) { const int R = g.rsb + i; if (R < hi) { const int o = (R % 9) * 8192 + cswz; *(LAS u32x4*)(lds + o) = kreg[i]; *(LAS u32x4*)(lds + VOFF + o) = vreg[i]; } }
        } else {
#pragma unroll
            for (int i = 0; i < 2; ++i) { const int R = prev_hi + i; if (R < hi) { const int o = (R % 9) * 8192 + cswz; *(LAS u32x4*)(lds + o) = kpf[i]; *(LAS u32x4*)(lds + VOFF + o) = vpf[i]; } }
        }
        const bf16x8 qf0 = qfn[0], qf1 = qfn[1];
        __syncthreads();
        u32x2 zreg[4];
#pragma unroll
        for (int dt = 0; dt < 4; ++dt) zreg[dt] = *(const u32x2*)(nz + lrq * 1024 + head * 64 + dt * 16 + 4 * fq);
        if (k + 1 < ppb) {
            const NaGeom g2 = na_geom(T0, gpair + 1); const int hi2 = g2.rs1 + 8;
            if (g2.s0 == g.s0) {
#pragma unroll
                for (int i = 0; i < 2; ++i) { const int R = hi + i; if (R < hi2) { kpf[i] = *(const u32x4*)(nk + rowbase + (size_t)R * 4096); vpf[i] = *(const u32x4*)(nv + rowbase + (size_t)R * 4096); } }
            }
            const size_t lq = (size_t)((gpair + 1) * 128 + rr * 64 + 16 * n + fr);
#pragma unroll
            for (int ks = 0; ks < 2; ++ks) qfn[ks] = *(const bf16x8*)(nq + lq * 64 + ks * 32 + fq * 8);
        }
        prev_hi = hi; prev_s0 = g.s0;
        int slot[8];
#pragma unroll
        for (int i = 0; i < 8; ++i) slot[i] = (rs + i) % 9;
        f32x4 s[16];
#pragma unroll
        for (int t = 0; t < 16; ++t) { s[t] = (f32x4){0.f, 0.f, 0.f, 0.f};
            const int key = slot[t >> 1] * 64 + kb + 16 * (t & 1) + fr;
            const bf16x8 kf0 = *(LAS bf16x8*)(lds + key * 128 + (((0 + fq) ^ (key & 7)) * 16)), kf1 = *(LAS bf16x8*)(lds + key * 128 + (((4 + fq) ^ (key & 7)) * 16));
            s[t] = mfma16(kf0, qf0, s[t]); s[t] = mfma16(kf1, qf1, s[t]); }
        LAS float* bp = rpbs + ((rs - r + 7) * 31 + (kb - 16 * n + 4 * fq - fr + 15));
        float mx = -1e30f;
#pragma unroll
        for (int t = 0; t < 16; ++t)
#pragma unroll
            for (int i = 0; i < 4; ++i) { const float v = vf[t & 1][i] ? s[t][i] * 0.18033688f + bp[(t >> 1) * 31 + 16 * (t & 1) + i] : -1e30f; s[t][i] = v; mx = fmaxf(mx, v); }
        mx = fmaxf(mx, __shfl_xor(mx, 16)); mx = fmaxf(mx, __shfl_xor(mx, 32));
        float sum = 0.f;
#pragma unroll
        for (int t = 0; t < 16; ++t)
#pragma unroll
            for (int i = 0; i < 4; ++i) { const float e = __builtin_amdgcn_exp2f(s[t][i] - mx); s[t][i] = e; sum += e; }
        sum += __shfl_xor(sum, 16); sum += __shfl_xor(sum, 32);
        f32x4 o[4];
#pragma unroll
        for (int dt = 0; dt < 4; ++dt) o[dt] = (f32x4){0.f, 0.f, 0.f, 0.f};
        const int vcol0 = kb + 4 * fq + (fr >> 2), pch = (fr & 3) >> 1, phalf = (fr & 3) & 1;
#pragma unroll
        for (int kk = 0; kk < 8; ++kk) {
            u32x4 pw; pw.x = pk2(s[2 * kk][0], s[2 * kk][1]); pw.y = pk2(s[2 * kk][2], s[2 * kk][3]); pw.z = pk2(s[2 * kk + 1][0], s[2 * kk + 1][1]); pw.w = pk2(s[2 * kk + 1][2], s[2 * kk + 1][3]);
            const bf16x8 pf = __builtin_bit_cast(bf16x8, pw);
            const int k0 = slot[kk] * 64 + vcol0, k1 = k0 + 16;
#pragma unroll
            for (int dt = 0; dt < 4; ++dt) { const int chunk = 2 * dt + pch;
                const bf16x8 a = tr8(lds + VOFF, k0 * 128 + ((chunk ^ (k0 & 7)) * 16) + phalf * 8, k1 * 128 + ((chunk ^ (k1 & 7)) * 16) + phalf * 8); o[dt] = mfma16(a, pf, o[dt]); }
        }
        const float inv = __builtin_amdgcn_rcpf(sum);
#pragma unroll
        for (int dt = 0; dt < 4; ++dt) { const size_t off = lrq * 1024 + head * 64 + dt * 16 + 4 * fq; const u32x2 z = zreg[dt];
            u32x2 wv; wv.x = pk2(o[dt][0] * inv * siluf_(bflo(z.x)), o[dt][1] * inv * siluf_(bfhi(z.x))); wv.y = pk2(o[dt][2] * inv * siluf_(bflo(z.y)), o[dt][3] * inv * siluf_(bfhi(z.y)));
            *(u32x2*)(yb + off) = wv; }
    }
}

__device__ __forceinline__ void phase_mix(const Params& p, unsigned char* shm, int T0, int Mc, int cidx, int flags) {
    float* state = (float*)(p.ws + p.o_state);
    const int n_pre = (flags & 1) ? 7 * 32 : 0;
    const int n_chain = (flags & 2) ? (Mc / UNIT) * 32 : 0;
    const int n_na = (flags & 4) ? (Mc / 128) * 16 : 0;
    for (int item = blockIdx.x; item < n_pre; item += gridDim.x) { __syncthreads();
        const int g = item >> 5, combo = item & 31;
        mlstm_chain<true>(p, shm, T0, Mc, 0, TOK_P, combo & 3, (combo >> 2) & 1, combo >> 3, 32 * g, 32 * g + 32, nullptr, 0, state + (size_t)(combo * 8 + g) * ST_REC); }
    for (int item = blockIdx.x; item < n_chain; item += gridDim.x) { __syncthreads();
        const int si = item >> 5, combo = item & 31;
        if (T0 == 0 && si < 8) mlstm_chain<false>(p, shm, T0, Mc, 0, TOK_P, combo & 3, (combo >> 2) & 1, combo >> 3, 32 * si, 32 * si + 32, state + (size_t)(combo * 8) * ST_REC, si, nullptr);
        else mlstm_chain<false>(p, shm, T0, Mc, T0 + si * UNIT, UNIT, combo & 3, (combo >> 2) & 1, combo >> 3, 0, 32, nullptr, 0, nullptr); }
    if (n_na) { __syncthreads();
        if (gridDim.x == 256) na_band(p, shm, T0, Mc);
        else for (int idx = blockIdx.x; idx < n_na; idx += gridDim.x) { __syncthreads(); na_item(p, shm, T0, idx >> 4, idx & 15); } }
    __syncthreads();
}

#define XB_TMO      128
#define XB_XCNT(j)  (256  + 64 * (j))
#define XB_XSUB(j)  (1280 + 64 * (j))
#define XB_XGEN(j)  (2304 + 64 * (j))
#define XB_TOP      3328
#define XB_TOPGEN   3392
#define XCD_BAR_WORDS 3456
#define XB_SPIN_CAP (1u << 18)
#define XB_TOP      3328
#define XB_TOPGEN   3392
#define XCD_BAR_WORDS 3456
#define XB_SPIN_CAP (1u << 18)

__device__ __forceinline__ unsigned xb_ld(unsigned* p)              { return __hip_atomic_load(p, __ATOMIC_RELAXED, __HIP_MEMORY_SCOPE_AGENT); }
__device__ __forceinline__ unsigned xb_add(unsigned* p, unsigned v) { return __hip_atomic_fetch_add(p, v, __ATOMIC_RELAXED, __HIP_MEMORY_SCOPE_AGENT); }
__device__ __forceinline__ unsigned xb_xcc_id() { return (unsigned)__builtin_amdgcn_s_getreg((3 << 11) | 20) & 0xFu; }
#define XB_SPIN(cond, bar) do { unsigned _sp = 0; while (cond) { __builtin_amdgcn_s_sleep(1); \
    if ((++_sp & 255u) == 0u) { if (xb_ld(&(bar)[XB_TMO])) break; if (_sp > XB_SPIN_CAP) { atomicAdd(&(bar)[XB_TMO], 1u); break; } } } } while (0)

struct XcdBarrier {
    unsigned* bar; unsigned x;
    volatile LAS unsigned* st;
};

__device__ __forceinline__ XcdBarrier xcd_barrier_post(unsigned* bar, volatile LAS unsigned* st) {
    XcdBarrier b; b.bar = bar; b.x = xb_xcc_id(); b.st = st;
    if (threadIdx.x == 0) (void)xb_add(&bar[XB_XCNT(b.x)], 1u);
    return b;
}
__device__ __forceinline__ void xcd_barrier_complete(unsigned* bar, unsigned x, unsigned& nloc, unsigned& nx) {
    const unsigned G = gridDim.x * gridDim.y * gridDim.z;
    unsigned sum, cnt, mine, sp = 0u;
    for (;;) {
        sum = 0u; cnt = 0u; mine = 0u;
#pragma unroll
        for (unsigned j = 0; j < 16; ++j) { const unsigned c = xb_ld(&bar[XB_XCNT(j)]); sum += c; cnt += (c > 0u) ? 1u : 0u; mine = (j == x) ? c : mine; }
        if (sum == G) break;
        __builtin_amdgcn_s_sleep(1);
        if ((++sp & 255u) == 0u) { if (xb_ld(&bar[XB_TMO])) break; if (sp > XB_SPIN_CAP) { atomicAdd(&bar[XB_TMO], 1u); break; } }
    }
    nloc = mine > 0u ? mine : 1u; nx = cnt > 0u ? cnt : 1u;
}

__device__ __forceinline__ void xcd_barrier(const XcdBarrier& b) {
    asm volatile("s_waitcnt vmcnt(0)" ::: "memory");
    __syncthreads();
    if (threadIdx.x == 0) {
        unsigned* bar = b.bar;
        __builtin_amdgcn_s_waitcnt(0);
        unsigned nloc = b.st[0], nx = b.st[1];
        if (nloc == 0u) { xcd_barrier_complete(bar, b.x, nloc, nx); b.st[0] = nloc; b.st[1] = nx; }
        const unsigned old = xb_add(&bar[XB_XSUB(b.x)], 1u);
        const unsigned gen = old / nloc;
        if (old + 1u == (gen + 1u) * nloc) {
            __builtin_amdgcn_fence(__ATOMIC_RELEASE, "agent");
            asm volatile("s_waitcnt vmcnt(0)" ::: "memory");
            const unsigned og = xb_add(&bar[XB_TOP], 1u);
            const unsigned tg = og / nx;
            if (og + 1u == (tg + 1u) * nx) xb_add(&bar[XB_TOPGEN], 1u);
            else XB_SPIN(xb_ld(&bar[XB_TOPGEN]) == tg, bar);
            __builtin_amdgcn_fence(__ATOMIC_ACQUIRE, "agent");
            xb_add(&bar[XB_XGEN(b.x)], 1u);
            asm volatile("s_waitcnt vmcnt(0)" ::: "memory");
        } else {
            XB_SPIN(xb_ld(&bar[XB_XGEN(b.x)]) == gen, bar);
            __builtin_amdgcn_fence(__ATOMIC_ACQUIRE, "agent");
            asm volatile("s_waitcnt vmcnt(0)" ::: "memory");
        }
    }
    __syncthreads();
}

#ifndef PHM
#define PHM 0xFFF
#endif
#define IN(k) (lo <= (k) && (k) < hi)
#define INB(b, k) (((PHM >> (b)) & 1) && IN(k))
#define SEAM(k) do { if (IN(k) && IN((k) + 1)) xcd_barrier(bar); } while (0)
__device__ __forceinline__ void round_body(const Params& p, unsigned char* shm, const XcdBarrier& bar, const int round, const int lo, const int hi) {
    const int T0 = round * p.Mr, pb = 1 + 8 * round;
    const int Mc = (TOK_ALL - T0) < p.Mr ? (TOK_ALL - T0) : p.Mr;
    if (INB(1, pb)) { EpiIn E; E.act = actp(p, 0); E.split_stride = (size_t)p.Mr * 1024; E.gates = (float*)(p.ws + p.o_gates); E.b_gate = p.b_gate;
        run_gemm(shm, (const us*)(p.ws + p.o_xn), (const us*)(p.ws + p.o_winT), Mc, 11264, 1024, E); }
    SEAM(pb);
    if (INB(2, pb + 1)) { phase_gates(p, Mc); phase_conv(p, T0, Mc); }
    SEAM(pb + 1);
    if (round == 0) {
        if (INB(3, pb + 2)) phase_mix(p, shm, T0, Mc, 0, 1 | 4);
        SEAM(pb + 2);
        if (INB(4, pb + 3)) phase_mix(p, shm, T0, Mc, 1, 2);
    } else {
        if (INB(4, pb + 3)) phase_mix(p, shm, T0, Mc, 1 + round, 2 | 4);
    }
    SEAM(pb + 3);
    if (INB(5, pb + 4)) phase_ya(p, Mc);
    SEAM(pb + 4);
    if (INB(6, pb + 5)) {
        EpiPair E; E.ga = actp(p, 9); E.gb = actp(p, 10); E.merged = actp(p, 1);
        run_gemm_pair(shm, actp(p, 0), (const us*)(p.ws + p.o_wdaT), (const us*)(p.ws + p.o_xn), (const us*)(p.ws + p.o_wdbT), Mc, 1024, 1024, E);
    }
    SEAM(pb + 5);
    if (INB(7, pb + 6)) { EpiOut E; E.out = p.out + (size_t)T0 * 1024; E.xp = p.xp; E.xs = p.xs; E.T0 = T0; run_gemm(shm, actp(p, 1), (const us*)(p.ws + p.o_woutT), Mc, 1024, 1024, E); }
    SEAM(pb + 6);
    if (INB(8, pb + 7)) { phase_fnorm(p, T0, Mc); if (T0 + Mc < TOK_ALL) phase_xnorm(p, T0 + Mc, (TOK_ALL - T0 - Mc) < p.Mr ? (TOK_ALL - T0 - Mc) : p.Mr); }
    if (T0 + Mc < TOK_ALL) SEAM(pb + 7);
}
__global__ __launch_bounds__(512, 2) void mega(Params p) {
    extern __shared__ __attribute__((aligned(16))) unsigned char shm[];
    cg::grid_group grid = cg::this_grid();
    const int lo = p.ph_lo, hi = p.ph_hi;
    volatile LAS unsigned* bst = (volatile LAS unsigned*)((LAS unsigned char*)shm + (LDS_BYTES - 32));
    if (threadIdx.x == 0) { bst[0] = 0u; bst[1] = 0u; }
    __syncthreads();
    const XcdBarrier bar = xcd_barrier_post((unsigned*)(p.ws + p.o_bar), bst);
    if (INB(0, 0)) { phase_weights(p, shm); phase_xnorm(p, 0, p.Mr); }
    if (IN(0) && IN(1)) grid.sync();
    round_body(p, shm, bar, 0, lo, hi);
    round_body(p, shm, bar, 1, lo, hi);
    round_body(p, shm, bar, 2, lo, hi);
#undef IN
#undef SEAM
}

#ifndef N_LAUNCH_MODE
#define N_LAUNCH_MODE 1
#endif
extern "C" void kernel_launch(void* const* d_in, const int* in_sizes, int n_in, void* d_out, int out_size, void* d_ws, size_t ws_size, hipStream_t stream) {
    static int grid = 0;
    if (grid == 0) {
        int dev = 0, cus = 0, per_cu = 0;
        hipGetDevice(&dev); hipDeviceGetAttribute(&cus, hipDeviceAttributeMultiprocessorCount, dev);
        if (hipFuncSetAttribute((const void*)mega, hipFuncAttributeMaxDynamicSharedMemorySize, LDS_BYTES) != hipSuccess) fprintf(stderr, "kernel_launch: hipFuncSetAttribute failed\n");
        if (hipOccupancyMaxActiveBlocksPerMultiprocessor(&per_cu, (const void*)mega, 512, LDS_BYTES) != hipSuccess || per_cu < 1) { fprintf(stderr, "kernel_launch: occupancy query says %d\n", per_cu); per_cu = 1; }
        (void)hipGetLastError();
        grid = cus * 1;
        if (grid <= 0) grid = 256;
    }
    Params p{};
    p.xp = (const float*)d_in[0]; p.xs = (const float*)d_in[1]; p.norm_w = (const float*)d_in[2]; p.w_in = (const float*)d_in[3]; p.b_gate = (const float*)d_in[4];
    p.conv_w = (const float*)d_in[5]; p.conv_b = (const float*)d_in[6]; p.mh_w = (const float*)d_in[7]; p.rpb = (const float*)d_in[8];
    p.wda = (const float*)d_in[9]; p.wdb = (const float*)d_in[10]; p.wout = (const float*)d_in[11]; p.fnw = (const float*)d_in[12];
    p.out = (float*)d_out; p.ws = (unsigned char*)d_ws;
    size_t off = 0;
    p.o_winT = off; off += (size_t)NPAD * 1024 * 2;
    p.o_wdaT = off; off += (size_t)1024 * 1024 * 2; p.o_wdbT = off; off += (size_t)1024 * 1024 * 2; p.o_woutT = off; off += (size_t)1024 * 1024 * 2;
    p.o_ctr = off; off += 256;
    p.o_bar = off; off += (size_t)XCD_BAR_WORDS * 4;
    p.o_state = off; off += (size_t)256 * ST_REC * 4;
    const int Mr = 32768;
    p.Mr = Mr; p.nrounds = 3;
    p.o_gates = off; off += (size_t)Mr * 64;
    p.o_xn = off; off += (size_t)Mr * 2048;
    p.o_act = off; off += (size_t)Mr * 11 * 2048;
    if (off > ws_size) { fprintf(stderr, "kernel_launch: workspace too small (%zu > %zu)\n", off, ws_size); return; }
    hipMemsetAsync((char*)d_ws + p.o_ctr, 0, 256 + (size_t)XCD_BAR_WORDS * 4, stream);
    const int nph = 1 + 8 * p.nrounds;
#if N_LAUNCH_MODE == 1
    p.ph_lo = 0; p.ph_hi = nph;
    void* args[] = {&p};
    hipError_t e = hipLaunchCooperativeKernel((const void*)mega, dim3(grid), dim3(512), args, LDS_BYTES, stream);
    if (e != hipSuccess) fprintf(stderr, "kernel_launch: cooperative launch failed: %s (grid %d)\n", hipGetErrorString(e), grid);
#else
    for (int ph = 0; ph < nph; ++ph) { p.ph_lo = ph; p.ph_hi = ph + 1; hipLaunchKernelGGL(mega, dim3(grid), dim3(512), LDS_BYTES, stream, p); }
#endif
}
```

```cpp
#include <hip/hip_runtime.h>
#include <hip/hip_cooperative_groups.h>
#include <cstdio>
namespace cg = cooperative_groups;
namespace pg8 {
#define PG8_LAS __attribute__((address_space(3)))
typedef unsigned short bf16_t;
typedef short bf16x8 __attribute__((ext_vector_type(8)));
typedef float f32x4 __attribute__((ext_vector_type(4)));
typedef unsigned u32x4 __attribute__((ext_vector_type(4)));
constexpr int BM = 256, BK = 64, HALF = 128, HTB = HALF * BK * 2  , STAGE_BYTES = 8 * HTB, NXCD = 8, WGM = 8;

__host__ __device__ __forceinline__ int lds_byte(int r, int c) { const int st = (r >> 4) * 2 + (c >> 5), rr = r & 15, cc = c & 31, ob = rr * 64 + cc * 2; return st * 1024 + (ob ^ (((ob >> 9) & 1) << 5)); }
__host__ __device__ __forceinline__ void stage_rc(int b, int& R, int& C) { const int st = b / 1024, sb = b % 1024, swz = sb ^ (((sb >> 9) & 1) << 5); R = (st >> 1) * 16 + swz / 64; C = (st & 1) * 32 + (swz % 64) / 2; }
__host__ __device__ __forceinline__ int perm32(int rho) { const int n = rho >> 4, i = rho & 15; return 8 * (i >> 2) + 4 * n + (i & 3); }

struct Unit { int pm, pn, w; };
struct Gemm { const bf16_t* A; const bf16_t* Bt; int M, N, K; const bf16_t* A2; const bf16_t* Bt2; };

struct StaticOrder {
    int nM, nN, nwg, G, c;
    __host__ __device__ void init(int M, int N, int G_, int c_) { nM = M / BM; nN = N / BM; nwg = nM * nN; G = G_; c = c_; }
    __host__ __device__ bool next(int i, Unit& u) const {
        const long L = (long)i * G + c; if (L >= nwg) return false;
        int wgid = (int)L; { const int q = nwg / NXCD, r = nwg % NXCD, xcd = wgid % NXCD, off = wgid / NXCD; wgid = (xcd < r ? xcd * (q + 1) : r * (q + 1) + (xcd - r) * q) + off; }
        const int nig = WGM * nN, gid = wgid / nig, fm = gid * WGM, gsz = (nM - fm) < WGM ? (nM - fm) : WGM;
        u.pm = fm + ((wgid % nig) % gsz); u.pn = (wgid % nig) / gsz; u.w = 0; return true;
    }
    __device__ __forceinline__ void a_ready(const Unit&) const {}
    __device__ __forceinline__ void done(const Unit&) const {}
};
__device__ __forceinline__ unsigned cvt_pk_bf16(float lo, float hi) { unsigned r; asm volatile("v_cvt_pk_bf16_f32 %0, %1, %2" : "=v"(r) : "v"(lo), "v"(hi)); return r; }
template <class Epi, class Sched, bool STAMP = false>
__device__ __forceinline__ void gemm_phase(PG8_LAS unsigned char* lds, const Gemm g, const Sched& S, const Epi& E, unsigned long long* stamps) {
    const int tid = threadIdx.x, wid = __builtin_amdgcn_readfirstlane(tid >> 6), lane = tid & 63, wr = wid >> 2, wc = wid & 3, fr = lane & 15, fq = lane >> 4;
    const int K = g.K, nt = K / BK;
    int ts_lo = 0, ts_hi = 0, nts = 0; const unsigned long long rt_entry = STAMP ? (unsigned long long)wall_clock64() : 0ull;
#define PG8_STAMP() do { if (STAMP && wid == 0 && nts < 64) { const unsigned long long _c = (unsigned long long)clock64(); \
        ts_lo = (lane == nts) ? (int)(unsigned)_c : ts_lo; ts_hi = (lane == nts) ? (int)(unsigned)(_c >> 32) : ts_hi; ++nts; } } while (0)
    PG8_STAMP();
    unsigned voffA[2], voffB[2];
#pragma unroll
    for (int i = 0; i < 2; ++i) { int R, C; stage_rc(tid * 16 + i * 8192, R, C); const int Rb = Epi::PERM ? ((R & ~31) + perm32(R & 31)) : R;
        voffA[i] = (unsigned)(R * K + C) * 2u; voffB[i] = (unsigned)(Rb * K + C) * 2u; }
    const size_t kstep = (size_t)(BK * 2);
    const size_t hstep = (size_t)HALF * K * 2;
    const size_t tstep = 2 * hstep;
    const unsigned ldsw = (unsigned)wid * 1024u;
    const int aoff = lds_byte(wr * 64 + fr, fq * 8), boff = lds_byte(wc * 32 + fr, fq * 8);
#define PG8_SA(b, h) (((b) * 2 + (h)) * HTB)
#define PG8_SB(b, h) ((4 + (b) * 2 + (h)) * HTB)
#define PG8_STAGE(bufoff, gbase, voff) do { _Pragma("unroll") for (int _i = 0; _i < 2; ++_i) \
        __builtin_amdgcn_global_load_lds((const unsigned*)((const char*)(gbase) + (voff)[_i]), (PG8_LAS unsigned*)(lds + (bufoff) + ldsw + _i * 8192), 16, 0, 0); } while (0)
#define PG8_LDA(dst, b, h) do { _Pragma("unroll") for (int m = 0; m < 4; ++m) _Pragma("unroll") for (int k = 0; k < 2; ++k) dst[m][k] = *(const PG8_LAS bf16x8*)(lds + PG8_SA(b, h) + aoff + m * 2048 + k * 1024); } while (0)
#define PG8_LDB(dst, b, h) do { _Pragma("unroll") for (int n = 0; n < 2; ++n) _Pragma("unroll") for (int k = 0; k < 2; ++k) dst[n][k] = *(const PG8_LAS bf16x8*)(lds + PG8_SB(b, h) + boff + n * 2048 + k * 1024); } while (0)
#define PG8_MMA(ai, bj, At, Bt) do { __builtin_amdgcn_s_setprio(1); _Pragma("unroll") for (int m = 0; m < 4; ++m) _Pragma("unroll") for (int n = 0; n < 2; ++n) _Pragma("unroll") for (int k = 0; k < 2; ++k) \
        acc[ai][bj][m][n] = __builtin_amdgcn_mfma_f32_16x16x32_bf16(Bt[n][k], At[m][k], acc[ai][bj][m][n], 0, 0, 0); __builtin_amdgcn_s_setprio(0); } while (0)
#define PG8_WAIT_V(n) asm volatile("s_waitcnt vmcnt(" #n ")" ::: "memory")
#define PG8_WAIT_L(n) asm volatile("s_waitcnt lgkmcnt(" #n ")" ::: "memory")
#define PG8_BAR __builtin_amdgcn_s_barrier()
#define PG8_SCHED __builtin_amdgcn_sched_barrier(0)
    Unit cur, nxt; int ui = 0;
    if (!S.next(0, cur)) return;
    f32x4 acc[2][2][4][2];
#pragma unroll
    for (int a = 0; a < 2; ++a)
#pragma unroll
        for (int b = 0; b < 2; ++b)
#pragma unroll
            for (int m = 0; m < 4; ++m)
#pragma unroll
                for (int n = 0; n < 2; ++n) acc[a][b][m][n] = (f32x4){0.f, 0.f, 0.f, 0.f};
    bf16x8 At[4][2], B0[2][2], B1[2][2];
    const char* cA = (const char*)(cur.w ? g.A2 : g.A) + (size_t)cur.pm * tstep; const char* cB = (const char*)(cur.w ? g.Bt2 : g.Bt) + (size_t)cur.pn * tstep;
    S.a_ready(cur);
    PG8_STAGE(PG8_SB(0, 0), cB, voffB); PG8_STAGE(PG8_SB(0, 1), cB + hstep, voffB); PG8_STAGE(PG8_SA(0, 0), cA, voffA); PG8_STAGE(PG8_SA(0, 1), cA + hstep, voffA);
    if (wr == 1) PG8_BAR;
    PG8_WAIT_V(2); PG8_BAR;
    PG8_STAGE(PG8_SB(1, 0), cB + kstep, voffB); PG8_STAGE(PG8_SA(1, 0), cA + kstep, voffA); PG8_STAGE(PG8_SB(1, 1), cB + hstep + kstep, voffB);
    PG8_WAIT_V(6); PG8_BAR;
    PG8_STAMP();
    for (;;) {
        const bool has_next = S.next(ui + 1, nxt);
        const char* nA = has_next ? (const char*)(nxt.w ? g.A2 : g.A) + (size_t)nxt.pm * tstep : cA; const char* nB = has_next ? (const char*)(nxt.w ? g.Bt2 : g.Bt) + (size_t)nxt.pn * tstep : cB;
        for (int t = 0; t < nt; t += 2) {
            const bool last = (t == nt - 2);
            const char* a1 = cA + (size_t)(t + 1) * kstep;
            const char* a2 = last ? nA : cA + (size_t)(t + 2) * kstep; const char* b2 = last ? nB : cB + (size_t)(t + 2) * kstep;
            const char* a3 = a2 + kstep; const char* b3 = b2 + kstep;
            if (last && has_next) S.a_ready(nxt);
            PG8_LDB(B0, 0, 0); PG8_LDB(B1, 0, 1); PG8_SCHED; PG8_LDA(At, 0, 0); PG8_STAGE(PG8_SA(1, 1), a1 + hstep, voffA);
            PG8_WAIT_V(8); PG8_WAIT_L(0); PG8_BAR; PG8_MMA(0, 0, At, B0); PG8_MMA(0, 1, At, B1); PG8_BAR; PG8_SCHED;
            PG8_LDA(At, 0, 1); PG8_STAGE(PG8_SB(0, 0), b2, voffB); PG8_STAGE(PG8_SB(0, 1), b2 + hstep, voffB); PG8_STAGE(PG8_SA(0, 0), a2, voffA);
            PG8_WAIT_V(8); PG8_WAIT_L(0); PG8_BAR; PG8_MMA(1, 0, At, B0); PG8_MMA(1, 1, At, B1); PG8_BAR; PG8_SCHED;
            PG8_LDB(B0, 1, 0); PG8_LDB(B1, 1, 1); PG8_SCHED; PG8_LDA(At, 1, 0); PG8_STAGE(PG8_SA(0, 1), a2 + hstep, voffA);
            PG8_WAIT_V(8); PG8_WAIT_L(0); PG8_BAR; PG8_MMA(0, 0, At, B0); PG8_MMA(0, 1, At, B1); PG8_BAR; PG8_SCHED;
            PG8_LDA(At, 1, 1); PG8_STAGE(PG8_SB(1, 0), b3, voffB); PG8_STAGE(PG8_SB(1, 1), b3 + hstep, voffB); PG8_STAGE(PG8_SA(1, 0), a3, voffA);
            PG8_WAIT_V(8); PG8_WAIT_L(0); PG8_BAR; PG8_MMA(1, 0, At, B0); PG8_MMA(1, 1, At, B1); PG8_BAR; PG8_SCHED;
        }
        PG8_STAMP();
        if (wr == 0) PG8_BAR;
        if constexpr (!Epi::AFTER_DRAIN) { E(acc, cur, wr, wc, fr, fq); S.done(cur); }
        PG8_STAMP();
        if (!has_next) break;
        if (!(Epi::PAIR && cur.w == 0)) {
#pragma unroll
        for (int a = 0; a < 2; ++a)
#pragma unroll
            for (int b = 0; b < 2; ++b)
#pragma unroll
                for (int m = 0; m < 4; ++m)
#pragma unroll
                    for (int n = 0; n < 2; ++n) acc[a][b][m][n] = (f32x4){0.f, 0.f, 0.f, 0.f};
        }
        cur = nxt; cA = nA; cB = nB; ++ui;
        if (wr == 1) PG8_BAR;
    }
    PG8_WAIT_V(0);
    PG8_BAR;
    if constexpr (Epi::AFTER_DRAIN) { E.fused(acc, cur, wr, wc, fr, fq, lds, wid, lane); S.done(cur); }
    PG8_STAMP();
    if (STAMP && wid == 0) { stamps[lane] = lane < nts ? (((unsigned long long)(unsigned)ts_hi << 32) | (unsigned)ts_lo) : 0ull;
        if (lane == 62) stamps[62] = rt_entry; if (lane == 63) stamps[63] = (unsigned long long)wall_clock64(); }
#undef PG8_STAMP
#undef PG8_SA
#undef PG8_SB
#undef PG8_STAGE
#undef PG8_LDA
#undef PG8_LDB
#undef PG8_MMA
#undef PG8_WAIT_V
#undef PG8_WAIT_L
#undef PG8_BAR
#undef PG8_SCHED
}
}

#define LAS __attribute__((address_space(3)))
typedef unsigned short us;
typedef short bf16x8 __attribute__((ext_vector_type(8)));
typedef short s16x4 __attribute__((ext_vector_type(4)));
typedef float f32x4 __attribute__((ext_vector_type(4)));
typedef unsigned u32x4 __attribute__((ext_vector_type(4)));
typedef unsigned u32x2 __attribute__((ext_vector_type(2)));

constexpr int TOK_P = 16384, TOK_ALL = 81920, UNIT = 2048;
constexpr int DIN = 11280, NPAD = 11520;
constexpr int LDS_BYTES = 163840;
constexpr int L_ITEM = LDS_BYTES - 16;
constexpr int QS = 528, VS = 144;
constexpr int VSW = 176;
constexpr int L_Q = 0, L_K = 33792, L_ST = 67584, L_V = 101376, L_VW = 110592, L_P = 121856, L_SM = 131072;
constexpr int SM_W = 256, SM_QN = 320, SM_RS = 384  , SM_N = 640  ;
constexpr int L_NP = 132864  , L_GU = 134912, L_GC = 143104, L_GB = 151296, L_GM = 159488;
constexpr int NA_VH = 73728, L_RPB = 147456;

struct Params {
    const float *xp, *xs, *norm_w, *w_in, *b_gate, *conv_w, *conv_b, *mh_w, *rpb, *wda, *wdb, *wout, *fnw;
    float* out;
    unsigned char* ws;
    unsigned long long o_winT, o_wdaT, o_wdbT, o_woutT, o_ctr, o_bar, o_state, o_gates, o_xn, o_act;
    int Mr, nrounds, ph_lo, ph_hi;
};

__device__ __forceinline__ us f2bf(float f) { unsigned u = __float_as_uint(f); u += 0x7FFFu + ((u >> 16) & 1u); return (us)(u >> 16); }
__device__ __forceinline__ float bf2f(unsigned b) { return __uint_as_float(b << 16); }
typedef float f32x2_ __attribute__((ext_vector_type(2)));
typedef __bf16 bf16x2_ __attribute__((ext_vector_type(2)));
__device__ __forceinline__ unsigned pk2(float lo, float hi) { f32x2_ v = {lo, hi}; bf16x2_ b = __builtin_convertvector(v, bf16x2_); return __builtin_bit_cast(unsigned, b); }
__device__ __forceinline__ float bflo(unsigned w) { return __uint_as_float(w << 16); }
__device__ __forceinline__ float bfhi(unsigned w) { return __uint_as_float(w & 0xFFFF0000u); }
__device__ __forceinline__ float sigmoidf_(float x) { return __builtin_amdgcn_rcpf(1.0f + __expf(-x)); }
__device__ __forceinline__ float siluf_(float x) { return x * __builtin_amdgcn_rcpf(1.0f + __expf(-x)); }
__device__ __forceinline__ const float* xrow(const Params& p, int t) { return t < TOK_P ? p.xp + (size_t)t * 1024 : p.xs + (size_t)(t - TOK_P) * 1024; }
__device__ __forceinline__ void seq_of(int t, int& s0, int& len) { if (t < TOK_P) { s0 = 0; len = TOK_P; } else { s0 = TOK_P + ((t - TOK_P) / UNIT) * UNIT; len = UNIT; } }
__device__ __forceinline__ us* actp(const Params& p, int i) { return (us*)(p.ws + p.o_act) + (size_t)i * p.Mr * 1024; }
__device__ __forceinline__ f32x4 mfma16(bf16x8 a, bf16x8 b, f32x4 c) { return __builtin_amdgcn_mfma_f32_16x16x32_bf16(a, b, c, 0, 0, 0); }
__device__ __forceinline__ bf16x8 tr8(LAS unsigned char* base, int off0, int off1) {
    s16x4 lo = __builtin_amdgcn_ds_read_tr16_b64_v4i16((LAS s16x4*)(base + off0));
    s16x4 hi = __builtin_amdgcn_ds_read_tr16_b64_v4i16((LAS s16x4*)(base + off1));
    return __builtin_shufflevector(lo, hi, 0, 1, 2, 3, 4, 5, 6, 7);
}

struct EpiIn {
    static constexpr bool PERM = true, AFTER_DRAIN = false, PAIR = false;
    us* act; size_t split_stride; float* gates; const float* b_gate;
    __device__ __forceinline__ void operator()(const pg8::f32x4 (&acc)[2][2][4][2], const pg8::Unit& u, int wr, int wc, int fr, int fq) const {
        const int row0 = u.pm * 256 + wr * 64 + fr;
        if (u.pn < 44) {
            const int t = u.pn >> 2;
            us* base = act + (size_t)t * split_stride;
            const int col0 = (u.pn & 3) * 256 + wc * 32 + 8 * fq;
            if (t >= 5 && t <= 7) {
                const size_t hstride = split_stride >> 4;
#pragma unroll
                for (int ai = 0; ai < 2; ++ai)
#pragma unroll
                    for (int m = 0; m < 4; ++m) { const size_t ro = (size_t)(row0 + ai * 128 + m * 16) * 64;
#pragma unroll
                        for (int bj = 0; bj < 2; ++bj) { const pg8::f32x4 v0 = acc[ai][bj][m][0], v1 = acc[ai][bj][m][1]; const int col = col0 + bj * 128;
                            u32x4 w; w.x = pk2(v0[0], v0[1]); w.y = pk2(v0[2], v0[3]); w.z = pk2(v1[0], v1[1]); w.w = pk2(v1[2], v1[3]);
                            *(u32x4*)(base + (size_t)(col >> 6) * hstride + ro + (col & 63)) = w; } }
            } else
#pragma unroll
            for (int ai = 0; ai < 2; ++ai)
#pragma unroll
                for (int m = 0; m < 4; ++m) { us* rowp = base + (size_t)(row0 + ai * 128 + m * 16) * 1024 + col0;
#pragma unroll
                    for (int bj = 0; bj < 2; ++bj) { const pg8::f32x4 v0 = acc[ai][bj][m][0], v1 = acc[ai][bj][m][1];
                        u32x4 w; w.x = pk2(v0[0], v0[1]); w.y = pk2(v0[2], v0[3]); w.z = pk2(v1[0], v1[1]); w.w = pk2(v1[2], v1[3]);
                        *(u32x4*)(rowp + bj * 128) = w; } }
        } else {
            if (wc == 0 && fq < 2) {
#pragma unroll
                for (int n = 0; n < 2; ++n) { const int c = 8 * fq + 4 * n; const f32x4 bv = *(const f32x4*)(b_gate + c);
#pragma unroll
                    for (int ai = 0; ai < 2; ++ai)
#pragma unroll
                        for (int m = 0; m < 4; ++m) { const int row = row0 + ai * 128 + m * 16; *(f32x4*)(gates + (size_t)row * 16 + c) = acc[ai][0][m][n] + bv; } }
            }
        }
    }
};
struct PairOrder : pg8::StaticOrder {
    __device__ bool next(int i, pg8::Unit& u) const { const bool ok = pg8::StaticOrder::next(i >> 1, u); u.w = i & 1; return ok; }
};
struct EpiPair {
    static constexpr bool PERM = true, AFTER_DRAIN = false, PAIR = true;
    const us* ga; const us* gb; us* merged;
    __device__ __forceinline__ void operator()(pg8::f32x4 (&acc)[2][2][4][2], const pg8::Unit& u, int wr, int wc, int fr, int fq) const {
        const int row0 = u.pm * 256 + wr * 64 + fr, col0 = u.pn * 256 + wc * 32 + 8 * fq;
        if (u.w == 0) {
#pragma unroll
            for (int ai = 0; ai < 2; ++ai) {
                u32x4 a[4][2], b[4][2];
#pragma unroll
                for (int m = 0; m < 4; ++m)
#pragma unroll
                    for (int bj = 0; bj < 2; ++bj) { const size_t o = (size_t)(row0 + ai * 128 + m * 16) * 1024 + col0 + bj * 128; a[m][bj] = *(const u32x4*)(ga + o); b[m][bj] = *(const u32x4*)(gb + o); }
#pragma unroll
                for (int m = 0; m < 4; ++m)
#pragma unroll
                    for (int bj = 0; bj < 2; ++bj)
#pragma unroll
                        for (int q = 0; q < 4; ++q) { const unsigned aw = a[m][bj][q], bw = b[m][bj][q];
                            const float r0 = (1.0f + __expf(-bflo(bw))) * __builtin_amdgcn_rcpf(1.0f + __expf(-bflo(aw))), r1 = (1.0f + __expf(-bfhi(bw))) * __builtin_amdgcn_rcpf(1.0f + __expf(-bfhi(aw)));
                            acc[ai][bj][m][q >> 1][(q & 1) * 2] *= r0; acc[ai][bj][m][q >> 1][(q & 1) * 2 + 1] *= r1; }
                asm volatile("" ::: "memory");
            }
        } else {
#pragma unroll
            for (int ai = 0; ai < 2; ++ai) {
                u32x4 b[4][2];
#pragma unroll
                for (int m = 0; m < 4; ++m)
#pragma unroll
                    for (int bj = 0; bj < 2; ++bj) { const size_t o = (size_t)(row0 + ai * 128 + m * 16) * 1024 + col0 + bj * 128; b[m][bj] = *(const u32x4*)(gb + o); }
#pragma unroll
                for (int m = 0; m < 4; ++m)
#pragma unroll
                    for (int bj = 0; bj < 2; ++bj) { const size_t o = (size_t)(row0 + ai * 128 + m * 16) * 1024 + col0 + bj * 128; u32x4 w;
#pragma unroll
                        for (int q = 0; q < 4; ++q) { const unsigned bw = b[m][bj][q];
                            w[q] = pk2(acc[ai][bj][m][q >> 1][(q & 1) * 2] * sigmoidf_(bflo(bw)), acc[ai][bj][m][q >> 1][(q & 1) * 2 + 1] * sigmoidf_(bfhi(bw))); }
                        *(u32x4*)(merged + o) = w; }
                asm volatile("" ::: "memory");
            }
        }
    }
};
struct EpiOut {
    static constexpr bool PERM = false, AFTER_DRAIN = false, PAIR = false;
    float* out; const float* xp; const float* xs; int T0;
    __device__ __forceinline__ void operator()(const pg8::f32x4 (&acc)[2][2][4][2], const pg8::Unit& u, int wr, int wc, int fr, int fq) const {
        const int row0 = u.pm * 256 + wr * 64 + fr, col0 = u.pn * 256 + wc * 32 + 4 * fq;
#pragma unroll
        for (int ai = 0; ai < 2; ++ai)
#pragma unroll
            for (int m = 0; m < 4; ++m) { const int row = row0 + ai * 128 + m * 16; const int t = T0 + row;
                const float* xr = (t < TOK_P ? xp + (size_t)t * 1024 : xs + (size_t)(t - TOK_P) * 1024) + col0; float* orow = out + (size_t)row * 1024 + col0;
#pragma unroll
                for (int bj = 0; bj < 2; ++bj)
#pragma unroll
                    for (int n = 0; n < 2; ++n) { const int o = bj * 128 + n * 16; *(f32x4*)(orow + o) = *(const f32x4*)(xr + o) + acc[ai][bj][m][n]; } }
    }
};

template <class Epi> __device__ __forceinline__ void run_gemm(unsigned char* shm, const us* A, const us* Bt, int M, int N, int K, const Epi& E) {
    pg8::Gemm g; g.A = A; g.Bt = Bt; g.M = M; g.N = N; g.K = K; g.A2 = A; g.Bt2 = Bt;
    pg8::StaticOrder S; S.init(M, N, (int)gridDim.x, (int)blockIdx.x);
    pg8::gemm_phase<Epi, pg8::StaticOrder, false>((LAS unsigned char*)shm, g, S, E, nullptr);
}

__device__ __forceinline__ void run_gemm_pair(unsigned char* shm, const us* A, const us* Bt, const us* A2, const us* Bt2, int M, int N, int K, const EpiPair& E) {
    pg8::Gemm g; g.A = A; g.Bt = Bt; g.M = M; g.N = N; g.K = K; g.A2 = A2; g.Bt2 = Bt2;
    PairOrder S; S.init(M, N, (int)gridDim.x, (int)blockIdx.x);
    pg8::gemm_phase<EpiPair, PairOrder, false>((LAS unsigned char*)shm, g, S, E, nullptr);
}

__device__ __forceinline__ void phase_weights(const Params& p, unsigned char* shm) {
    float* tile = (float*)shm;
    const int tid = threadIdx.x;
    for (int job = blockIdx.x; job < 2880 + 768; job += gridDim.x) {
        const float* src; int ld, col0, nvalid, kt; us* dst;
        if (job < 2880) { const int nt = job >> 4; kt = job & 15; src = p.w_in; ld = DIN; const int n0 = nt * 64;
            if (n0 < 5120) { col0 = n0; nvalid = 64; } else if (n0 < 11264) { col0 = n0 + 16; nvalid = 64; } else if (n0 == 11264) { col0 = 5120; nvalid = 16; } else { col0 = 0; nvalid = 0; }
            dst = (us*)(p.ws + p.o_winT) + (size_t)n0 * 1024;
        } else { const int j2 = job - 2880, which = j2 >> 8, t = j2 & 255, nt = t >> 4; kt = t & 15; ld = 1024; col0 = nt * 64; nvalid = 64;
            src = which == 0 ? p.wda : (which == 1 ? p.wdb : p.wout);
            dst = (us*)(p.ws + (which == 0 ? p.o_wdaT : (which == 1 ? p.o_wdbT : p.o_woutT))) + (size_t)nt * 64 * 1024; }
        __syncthreads();
        { const int j = tid & 63, i0 = tid >> 6;
#pragma unroll
          for (int ii = 0; ii < 8; ++ii) { const int i = i0 + 8 * ii; tile[i * 65 + j] = (j < nvalid) ? src[(size_t)(kt * 64 + i) * ld + col0 + j] : 0.f; } }
        __syncthreads();
        { const int i = tid & 63, j0 = tid >> 6;
#pragma unroll
          for (int jj = 0; jj < 8; ++jj) { const int j = j0 + 8 * jj; dst[(size_t)j * 1024 + kt * 64 + i] = f2bf(tile[i * 65 + j]); } }
    }
    __syncthreads();
}

__device__ __forceinline__ void phase_xnorm(const Params& p, int T0, int Mc) {
    const int wave = threadIdx.x >> 6, lane = threadIdx.x & 63;
    us* xn = (us*)(p.ws + p.o_xn);
    f32x4 nw[4];
#pragma unroll
    for (int j = 0; j < 4; ++j) nw[j] = *(const f32x4*)(p.norm_w + lane * 4 + 256 * j);
    for (int r = blockIdx.x * 8 + wave; r < Mc; r += gridDim.x * 8) {
        const float* xr = xrow(p, T0 + r);
        f32x4 v[4]; float ss = 0.f;
#pragma unroll
        for (int j = 0; j < 4; ++j) { v[j] = *(const f32x4*)(xr + lane * 4 + 256 * j); ss += v[j][0] * v[j][0] + v[j][1] * v[j][1] + v[j][2] * v[j][2] + v[j][3] * v[j][3]; }
#pragma unroll
        for (int o = 32; o >= 1; o >>= 1) ss += __shfl_xor(ss, o);
        const float rs = rsqrtf(ss * (1.0f / 1024.0f) + 1e-6f);
#pragma unroll
        for (int j = 0; j < 4; ++j) { u32x2 w; w.x = pk2(v[j][0] * rs * nw[j][0], v[j][1] * rs * nw[j][1]); w.y = pk2(v[j][2] * rs * nw[j][2], v[j][3] * rs * nw[j][3]);
            *(u32x2*)(xn + (size_t)r * 1024 + lane * 4 + 256 * j) = w; }
    }
}

__device__ __forceinline__ void phase_fnorm(const Params& p, int T0, int Mc) {
    const int wave = threadIdx.x >> 6, lane = threadIdx.x & 63;
    f32x4 nw[4];
#pragma unroll
    for (int j = 0; j < 4; ++j) nw[j] = *(const f32x4*)(p.fnw + lane * 4 + 256 * j);
    for (int r = blockIdx.x * 8 + wave; r < Mc; r += gridDim.x * 8) {
        float* xr = p.out + (size_t)(T0 + r) * 1024;
        f32x4 v[4]; float ss = 0.f;
#pragma unroll
        for (int j = 0; j < 4; ++j) { v[j] = *(const f32x4*)(xr + lane * 4 + 256 * j); ss += v[j][0] * v[j][0] + v[j][1] * v[j][1] + v[j][2] * v[j][2] + v[j][3] * v[j][3]; }
#pragma unroll
        for (int o = 32; o >= 1; o >>= 1) ss += __shfl_xor(ss, o);
        const float rs = rsqrtf(ss * (1.0f / 1024.0f) + 1e-6f);
#pragma unroll
        for (int j = 0; j < 4; ++j) { f32x4 w; w[0] = v[j][0] * rs * nw[j][0]; w[1] = v[j][1] * rs * nw[j][1]; w[2] = v[j][2] * rs * nw[j][2]; w[3] = v[j][3] * rs * nw[j][3];
            *(f32x4*)(xr + lane * 4 + 256 * j) = w; }
    }
}

__device__ __forceinline__ void phase_gates(const Params& p, int Mc) {
    const int wave = threadIdx.x >> 6, lane = threadIdx.x & 63, fr = lane & 15, fq = lane >> 4;
    const us* xn = (const us*)(p.ws + p.o_xn);
    const us* wg = (const us*)(p.ws + p.o_winT) + (size_t)(11264 + fr) * 1024 + fq * 8;
    float* gates = (float*)(p.ws + p.o_gates);
    const float bias = p.b_gate[fr];
    for (int task = blockIdx.x * 8 + wave; task < Mc / 16; task += gridDim.x * 8) {
        const us* ar = xn + (size_t)(task * 16 + fr) * 1024 + fq * 8;
        f32x4 acc0 = (f32x4){0.f, 0.f, 0.f, 0.f}, acc1 = acc0;
#pragma unroll 8
        for (int kk = 0; kk < 32; kk += 2) {
            const bf16x8 a0 = *(const bf16x8*)(ar + kk * 32), a1 = *(const bf16x8*)(ar + kk * 32 + 32);
            const bf16x8 b0 = *(const bf16x8*)(wg + kk * 32), b1 = *(const bf16x8*)(wg + kk * 32 + 32);
            acc0 = mfma16(a0, b0, acc0); acc1 = mfma16(a1, b1, acc1);
        }
#pragma unroll
        for (int i = 0; i < 4; ++i) gates[(size_t)(task * 16 + 4 * fq + i) * 16 + fr] = acc0[i] + acc1[i] + bias;
    }
}

__device__ __forceinline__ void phase_conv(const Params& p, int T0, int Mc) {
    const int tid = threadIdx.x, ct = tid & 255, tensor = ct >> 7, cgp = ct & 127, sub = tid >> 8;
    const us* src = actp(p, tensor);
    us* dst = (us*)(p.out + (size_t)T0 * 1024) + (size_t)tensor * Mc * 1024;
    const int ch0 = tensor * 1024 + cgp * 8;
    float w[5][8], b[8];
#pragma unroll
    for (int e = 0; e < 8; ++e) { b[e] = p.conv_b[ch0 + e];
#pragma unroll
        for (int i = 0; i < 5; ++i) w[i][e] = p.conv_w[i * 2048 + ch0 + e]; }
    const float oscale = tensor ? 0.0625f : 1.0f;
    for (int item = blockIdx.x; item < Mc / 32; item += gridDim.x) {
        const int r0 = (item * 2 + sub) * 16;
        int s0, len; seq_of(T0 + r0, s0, len);
        const int lo = s0 - T0, hi = lo + len;
        u32x4 rows[20];
#pragma unroll
        for (int i = 0; i < 20; ++i) { const int r = r0 - 2 + i; rows[i] = (r >= lo && r < hi) ? *(const u32x4*)(src + (size_t)r * 1024 + cgp * 8) : (u32x4){0u, 0u, 0u, 0u}; }
#pragma unroll
        for (int o = 0; o < 16; ++o) {
            float a[8];
#pragma unroll
            for (int e = 0; e < 8; ++e) a[e] = b[e];
#pragma unroll
            for (int i = 0; i < 5; ++i) { const u32x4 rw = rows[o + i];
                a[0] += w[i][0] * bflo(rw.x); a[1] += w[i][1] * bfhi(rw.x); a[2] += w[i][2] * bflo(rw.y); a[3] += w[i][3] * bfhi(rw.y);
                a[4] += w[i][4] * bflo(rw.z); a[5] += w[i][5] * bfhi(rw.z); a[6] += w[i][6] * bflo(rw.w); a[7] += w[i][7] * bfhi(rw.w); }
#pragma unroll
            for (int e = 0; e < 8; ++e) a[e] = siluf_(a[e]) * oscale;
            u32x4 wv; wv.x = pk2(a[0], a[1]); wv.y = pk2(a[2], a[3]); wv.z = pk2(a[4], a[5]); wv.w = pk2(a[6], a[7]);
            *(u32x4*)(dst + (size_t)(r0 + o) * 1024 + cgp * 8) = wv;
        }
    }
}

__device__ __forceinline__ void phase_ya(const Params& p, int Mc) {
    const int wave = threadIdx.x >> 6, lane = threadIdx.x & 63;
    const us* hf = actp(p, 0); const us* hb = actp(p, 1); const us* mo = actp(p, 3); const us* mz = actp(p, 4);
    us* ya = actp(p, 0);
    float mw[16];
#pragma unroll
    for (int i = 0; i < 16; ++i) mw[i] = p.mh_w[lane * 16 + i];
    for (int r = blockIdx.x * 8 + wave; r < Mc; r += gridDim.x * 8) {
        const size_t o = (size_t)r * 1024 + lane * 16;
        float h[16]; float ss = 0.f;
        unsigned zz[8];
#pragma unroll
        for (int c = 0; c < 2; ++c) {
            const u32x4 a = *(const u32x4*)(hf + o + c * 8), b = *(const u32x4*)(hb + o + c * 8), g = *(const u32x4*)(mo + o + c * 8), z = *(const u32x4*)(mz + o + c * 8);
#pragma unroll
            for (int q = 0; q < 4; ++q) { const unsigned aw = a[q], bw = b[q], gw = g[q];
                h[c * 8 + 2 * q] = (bflo(aw) + bflo(bw)) * sigmoidf_(bflo(gw)); h[c * 8 + 2 * q + 1] = (bfhi(aw) + bfhi(bw)) * sigmoidf_(bfhi(gw)); zz[c * 4 + q] = z[q]; }
        }
#pragma unroll
        for (int i = 0; i < 16; ++i) ss += h[i] * h[i];
        ss += __shfl_xor(ss, 1); ss += __shfl_xor(ss, 2); ss += __shfl_xor(ss, 4); ss += __shfl_xor(ss, 8);
        const float rn = rsqrtf(ss * (1.0f / 256.0f) + 1e-6f);
        unsigned w[8];
#pragma unroll
        for (int q = 0; q < 8; ++q) w[q] = pk2(h[2 * q] * rn * mw[2 * q] * siluf_(bflo(zz[q])), h[2 * q + 1] * rn * mw[2 * q + 1] * siluf_(bfhi(zz[q])));
        *(u32x4*)(ya + o) = (u32x4){w[0], w[1], w[2], w[3]}; *(u32x4*)(ya + o + 8) = (u32x4){w[4], w[5], w[6], w[7]};
    }
}

constexpr int ST_REC = 16896;
template <bool STATE_ONLY>
__device__ __forceinline__ void mlstm_chain(const Params& p, unsigned char* shm, int T0, int Mc, int s0, int len, int head, int dir, int split, int c0, int c1,
                                            const float* st_in, int n_prev, float* st_out) {
    LAS unsigned char* lds = (LAS unsigned char*)shm;
    LAS float* sm = (LAS float*)(lds + L_SM);
    const int tid = threadIdx.x, w = tid >> 6, lane = tid & 63, fr = lane & 15, fq = lane >> 4;
    const us* qc = (const us*)(p.out + (size_t)T0 * 1024); const us* kc = qc + (size_t)Mc * 1024;
    const us* mv = actp(p, 2); const float* gates = (const float*)(p.ws + p.o_gates);
    us* hout = actp(p, dir);
    const int base = dir ? (s0 + len - 1 - T0) : (s0 - T0); const int sgn = dir ? -1 : 1;
    const size_t hoff = (size_t)head * 256;
    u32x4 rq[4], rk[4], rv;
    LAS float* GU = (LAS float*)(lds + L_GU); LAS float* GC = (LAS float*)(lds + L_GC); LAS float* GB = (LAS float*)(lds + L_GB); LAS float* GM = (LAS float*)(lds + L_GM); LAS unsigned char* NBF = lds + L_NP;
    f32x4 Sacc[2][5];
#pragma unroll
    for (int a = 0; a < 2; ++a)
#pragma unroll
        for (int b = 0; b < 5; ++b) Sacc[a][b] = (f32x4){0.f, 0.f, 0.f, 0.f};
    float mstate = 0.f;
    if constexpr (!STATE_ONLY) {
        float nval = 0.f;
        for (int g = 0; g < n_prev; ++g) { const float* rec = st_in + (size_t)g * ST_REC; const float m_loc = rec[16640], B = rec[16641];
            const float m_new = fmaxf(B + mstate, m_loc), a1 = __expf(B + mstate - m_new), a2 = __expf(m_loc - m_new);
#pragma unroll
            for (int dd = 0; dd < 2; ++dd)
#pragma unroll
                for (int e4 = 0; e4 < 4; ++e4) { const f32x4 sl = *(const f32x4*)(rec + (size_t)((((w * 2 + dd) * 4 + e4) * 64 + lane) * 4)); Sacc[dd][e4] = a1 * Sacc[dd][e4] + a2 * sl; }
            if (tid < 256) nval = a1 * nval + a2 * rec[16384 + tid];
            mstate = m_new; }
        if (tid < 256) sm[SM_N + tid] = nval;
        __syncthreads();
#pragma unroll
        for (int dd = 0; dd < 2; ++dd)
#pragma unroll
            for (int i = 0; i < 4; ++i) Sacc[dd][4][i] = (fr == 0) ? sm[SM_N + (w * 2 + dd) * 16 + 4 * fq + i] : 0.f;
        if (fr == 0) {
#pragma unroll
            for (int dd = 0; dd < 2; ++dd) { u32x2 nb; nb.x = pk2(Sacc[dd][4][0], Sacc[dd][4][1]); nb.y = pk2(Sacc[dd][4][2], Sacc[dd][4][3]); *(LAS u32x2*)(NBF + ((w * 2 + dd) * 16 + 4 * fq) * 2) = nb; }
        }
#pragma unroll
        for (int dd = 0; dd < 2; ++dd)
#pragma unroll
            for (int e4 = 0; e4 < 4; ++e4) { const f32x4 sv = Sacc[dd][e4]; u32x2 wv; wv.x = pk2(sv[0], sv[1]); wv.y = pk2(sv[2], sv[3]);
                *(LAS u32x2*)(lds + L_ST + (e4 * 16 + fr) * QS + ((w * 2 + dd) * 16 + 4 * fq) * 2) = wv; }
    } else {
        if (tid < 256) sm[SM_N + tid] = 0.f;
    }
#define CH_LOAD(c) do { \
        _Pragma("unroll") for (int i = 0; i < 4; ++i) { const int id = tid + 512 * i, row = id >> 5, ch = id & 31; const size_t lr = (size_t)(base + sgn * ((c) * 64 + row)); \
            if (!STATE_ONLY) rq[i] = *(const u32x4*)(qc + lr * 1024 + hoff + ch * 8); rk[i] = *(const u32x4*)(kc + lr * 1024 + hoff + ch * 8); } \
        { const int row = tid >> 3, ch = tid & 7; const size_t lr = (size_t)(base + sgn * ((c) * 64 + row)); rv = *(const u32x4*)(mv + lr * 1024 + hoff + split * 64 + ch * 8); } \
 } while (0)
#define CH_STORE() do { \
        _Pragma("unroll") for (int i = 0; i < 4; ++i) { const int id = tid + 512 * i, row = id >> 5, ch = id & 31; \
            if (!STATE_ONLY) *(LAS u32x4*)(lds + L_Q + row * QS + ch * 16) = rq[i]; *(LAS u32x4*)(lds + L_K + row * QS + ch * 16) = rk[i]; } \
        { const int row = tid >> 3, ch = tid & 7; *(LAS u32x4*)(lds + L_V + row * VS + ch * 16) = rv; } } while (0)
    CH_LOAD(c0);
    for (int cc = w; cc < c1 - c0; cc += 8) {
        const size_t lr = (size_t)(base + sgn * ((c0 + cc) * 64 + lane));
        const float li = gates[lr * 16 + dir * 8 + head], gfv = gates[lr * 16 + dir * 8 + 4 + head];
        const float lf = fminf(gfv, 0.f) - log1pf(__expf(-fabsf(gfv)));
        float b = lf;
#pragma unroll
        for (int o = 1; o < 64; o <<= 1) { const float t = __shfl_up(b, o); if (lane >= o) b += t; }
        const float u = li - b; float cm = u;
#pragma unroll
        for (int o = 1; o < 64; o <<= 1) { const float t = __shfl_up(cm, o); if (lane >= o) cm = fmaxf(cm, t); }
        GU[cc * 64 + lane] = u; GC[cc * 64 + lane] = cm; GB[cc * 64 + lane] = b;
    }
    CH_STORE();
    __syncthreads();
    if (tid == 0) { float m = mstate, bt = 0.f;
        for (int cc = 0; cc < c1 - c0; ++cc) { GM[cc] = m; const float M63 = fmaxf(m, GC[cc * 64 + 63]), b63 = GB[cc * 64 + 63]; m = b63 + M63; bt += b63; }
        GM[32] = m; GM[33] = bt; }
    const int tA = w & 3, jt0 = (w >> 2) * 2;
    for (int c = c0; c < c1; ++c) {
        if (c + 1 < c1) CH_LOAD(c + 1);
        __syncthreads();
        const int cg_ = (c - c0) * 64; const float m_c = GM[c - c0]; const float M63 = fmaxf(m_c, GC[cg_ + 63]);
        f32x4 h0 = (f32x4){0.f, 0.f, 0.f, 0.f}, h1 = h0, qn0 = h0, qn1 = h0;
        if constexpr (!STATE_ONLY) {
            f32x4 sc0 = (f32x4){0.f, 0.f, 0.f, 0.f}, sc1 = sc0;
#pragma unroll 4
            for (int kk = 0; kk < 8; ++kk) {
                const bf16x8 a = *(LAS bf16x8*)(lds + L_K + (tA * 16 + fr) * QS + kk * 64 + fq * 16);
                const bf16x8 a2 = *(LAS bf16x8*)(lds + L_ST + (tA * 16 + fr) * QS + kk * 64 + fq * 16);
                const bf16x8 b0 = *(LAS bf16x8*)(lds + L_Q + (jt0 * 16 + fr) * QS + kk * 64 + fq * 16);
                const bf16x8 b1 = *(LAS bf16x8*)(lds + L_Q + ((jt0 + 1) * 16 + fr) * QS + kk * 64 + fq * 16);
                sc0 = mfma16(a, b0, sc0); sc1 = mfma16(a, b1, sc1);
                h0 = mfma16(a2, b0, h0); h1 = mfma16(a2, b1, h1);
                const bf16x8 nf = *(LAS bf16x8*)(NBF + kk * 64 + fq * 16);
                qn0 = mfma16(nf, b0, qn0); qn1 = mfma16(nf, b1, qn1);
            }
            const int sb = tA * 16 + 4 * fq;
            const f32x4 uv = *(LAS f32x4*)(GU + cg_ + sb);
#pragma unroll
            for (int jt = 0; jt < 2; ++jt) { const int j = (jt0 + jt) * 16 + fr; const float Mj = fmaxf(m_c, GC[cg_ + j]); const f32x4 sc = jt ? sc1 : sc0;
                float v[4];
#pragma unroll
                for (int i = 0; i < 4; ++i) v[i] = (sb + i <= j) ? sc[i] * __expf(uv[i] - Mj) : 0.f;
                u32x2 wv; wv.x = pk2(v[0], v[1]); wv.y = pk2(v[2], v[3]);
                *(LAS u32x2*)(lds + L_P + j * VS + sb * 2) = wv;
                }
        }
        {
            const int s = tid >> 3, ch = tid & 7; const float ws_ = __expf(GU[cg_ + s] - M63); const u32x4 vv = *(LAS u32x4*)(lds + L_V + s * VS + ch * 16);
            u32x4 o; o.x = pk2(bflo(vv.x) * ws_, bfhi(vv.x) * ws_); o.y = pk2(bflo(vv.y) * ws_, bfhi(vv.y) * ws_); o.z = pk2(bflo(vv.z) * ws_, bfhi(vv.z) * ws_); o.w = pk2(bflo(vv.w) * ws_, bfhi(vv.w) * ws_);
            *(LAS u32x4*)(lds + L_VW + s * VSW + ch * 16) = o;
            if (ch == 0) { *(LAS u32x4*)(lds + L_VW + s * VSW + 128) = (u32x4){pk2(ws_, 0.f), 0u, 0u, 0u}; *(LAS u32x4*)(lds + L_VW + s * VSW + 144) = (u32x4){0u, 0u, 0u, 0u}; }
        }
        __syncthreads();
        if constexpr (!STATE_ONLY) {
            const int j0 = jt0 * 16 + fr, j1 = j0 + 16;
            const float Mj0 = fmaxf(m_c, GC[cg_ + j0]), Mj1 = fmaxf(m_c, GC[cg_ + j1]);
            const float wi0 = __expf(m_c - Mj0), wi1 = __expf(m_c - Mj1);
            h0 *= wi0; h1 *= wi1;
            f32x4 rs0 = (f32x4){0.f, 0.f, 0.f, 0.f}, rs1 = rs0;
            const bf16x8 ones = (bf16x8){(short)0x3F80, (short)0x3F80, (short)0x3F80, (short)0x3F80, (short)0x3F80, (short)0x3F80, (short)0x3F80, (short)0x3F80};
#pragma unroll
            for (int ks = 0; ks < 2; ++ks) {
                const int o0 = (ks * 32 + 8 * fq + (fr >> 2)) * VS + (tA * 16 + 4 * (fr & 3)) * 2;
                const bf16x8 a = tr8(lds + L_V, o0, o0 + 4 * VS);
                const bf16x8 b0 = *(LAS bf16x8*)(lds + L_P + j0 * VS + ks * 64 + fq * 16);
                const bf16x8 b1 = *(LAS bf16x8*)(lds + L_P + j1 * VS + ks * 64 + fq * 16);
                h0 = mfma16(a, b0, h0); h1 = mfma16(a, b1, h1);
                rs0 = mfma16(ones, b0, rs0); rs1 = mfma16(ones, b1, rs1);
            }
            const float den0 = wi0 * qn0[0] + rs0[0], den1 = wi1 * qn1[0] + rs1[0];
            const float sc0 = __builtin_amdgcn_rcpf(fmaxf(fabsf(den0), __expf(-GB[cg_ + j0] - Mj0))), sc1 = __builtin_amdgcn_rcpf(fmaxf(fabsf(den1), __expf(-GB[cg_ + j1] - Mj1)));
            h0 *= sc0; h1 *= sc1;
            const size_t lr0 = (size_t)(base + sgn * (c * 64 + j0)), lr1 = (size_t)(base + sgn * (c * 64 + j1));
            const int eo = split * 64 + tA * 16 + 4 * fq;
            u32x2 w0, w1; w0.x = pk2(h0[0], h0[1]); w0.y = pk2(h0[2], h0[3]); w1.x = pk2(h1[0], h1[1]); w1.y = pk2(h1[2], h1[3]);
            *(u32x2*)(hout + lr0 * 1024 + hoff + eo) = w0; *(u32x2*)(hout + lr1 * 1024 + hoff + eo) = w1;
        }
        {
            const float a_ = __expf(m_c - M63);
#pragma unroll
            for (int dd = 0; dd < 2; ++dd)
#pragma unroll
                for (int e4 = 0; e4 < 5; ++e4) Sacc[dd][e4] *= a_;
#pragma unroll 1
            for (int ks = 0; ks < 2; ++ks) {
                const int rbase = ks * 32 + 8 * fq + (fr >> 2);
                bf16x8 A[2], B[5];
#pragma unroll
                for (int dd = 0; dd < 2; ++dd) { const int o0 = rbase * QS + ((w * 2 + dd) * 16 + 4 * (fr & 3)) * 2; A[dd] = tr8(lds + L_K, o0, o0 + 4 * QS); }
#pragma unroll
                for (int e4 = 0; e4 < 5; ++e4) { const int o0 = rbase * VSW + (e4 * 16 + 4 * (fr & 3)) * 2; B[e4] = tr8(lds + L_VW, o0, o0 + 4 * VSW); }
#pragma unroll
                for (int dd = 0; dd < 2; ++dd)
#pragma unroll
                    for (int e4 = 0; e4 < 5; ++e4) Sacc[dd][e4] = mfma16(A[dd], B[e4], Sacc[dd][e4]);
            }
            if constexpr (!STATE_ONLY) {
#pragma unroll
                for (int dd = 0; dd < 2; ++dd)
#pragma unroll
                    for (int e4 = 0; e4 < 4; ++e4) { const f32x4 sv = Sacc[dd][e4]; u32x2 wv; wv.x = pk2(sv[0], sv[1]); wv.y = pk2(sv[2], sv[3]);
                        *(LAS u32x2*)(lds + L_ST + (e4 * 16 + fr) * QS + ((w * 2 + dd) * 16 + 4 * fq) * 2) = wv; }
            }
            if (fr == 0) {
#pragma unroll
                for (int dd = 0; dd < 2; ++dd) { *(LAS f32x4*)(sm + SM_N + (w * 2 + dd) * 16 + 4 * fq) = Sacc[dd][4];
                    if (!STATE_ONLY) { u32x2 nb; nb.x = pk2(Sacc[dd][4][0], Sacc[dd][4][1]); nb.y = pk2(Sacc[dd][4][2], Sacc[dd][4][3]); *(LAS u32x2*)(NBF + ((w * 2 + dd) * 16 + 4 * fq) * 2) = nb; } }
            }
        }
        __syncthreads();
        if (c + 1 < c1) { CH_STORE(); }
    }
#undef CH_LOAD
#undef CH_STORE
    if constexpr (STATE_ONLY) {
#pragma unroll
        for (int dd = 0; dd < 2; ++dd)
#pragma unroll
            for (int e4 = 0; e4 < 4; ++e4) *(f32x4*)(st_out + (size_t)((((w * 2 + dd) * 4 + e4) * 64 + lane) * 4)) = Sacc[dd][e4];
        if (tid < 256) st_out[16384 + tid] = sm[SM_N + tid];
        if (tid == 0) { st_out[16640] = GM[32]; st_out[16641] = GM[33]; }
    }
}

__device__ __forceinline__ void na_item(const Params& p, unsigned char* shm, int T0, int gpair, int head) {
    LAS unsigned char* lds = (LAS unsigned char*)shm;
    LAS float* rpbs = (LAS float*)(lds + L_RPB);
    constexpr int VOFF = 73728;
    const int tid = threadIdx.x, w = tid >> 6, lane = tid & 63, fr = lane & 15, fq = lane >> 4;
    const int n = w & 3, rr = w >> 2;
    const us* nq = actp(p, 5); const us* nk = actp(p, 6); const us* nv = actp(p, 7); const us* nz = actp(p, 8);
    us* yb = (us*)(p.ws + p.o_xn);
    const size_t hstr = (size_t)p.Mr * 64;
    const int tokA = T0 + gpair * 128; int s0, len; seq_of(tokA, s0, len);
    const int rows = len / 64, r0 = (tokA - s0) / 64, r = r0 + rr;
    const int rsb = min(max(r0 - 4, 0), rows - 8), rs1 = min(max(r0 - 3, 0), rows - 8);
    const int rs = rr ? rs1 : rsb;
    const int nkeys = (rs1 + 8 - rsb) * 64;
    const int wl0 = s0 + rsb * 64 - T0;
    const int kb = min(max(16 * n - 8, 0), 32);
    const size_t lrq = (size_t)(tokA - T0 + rr * 64 + 16 * n + fr);
    u32x4 kreg[9], vreg[9];
#pragma unroll
    for (int i = 0; i < 9; ++i) { const int id = tid + 512 * i, key = id >> 3, ch = id & 7;
        if (key < nkeys) { kreg[i] = *(const u32x4*)(nk + (size_t)head * hstr + (size_t)(wl0 + key) * 64 + ch * 8); vreg[i] = *(const u32x4*)(nv + (size_t)head * hstr + (size_t)(wl0 + key) * 64 + ch * 8); } }
    bf16x8 qf[2];
#pragma unroll
    for (int ks = 0; ks < 2; ++ks) qf[ks] = *(const bf16x8*)(nq + head * hstr + lrq * 64 + ks * 32 + fq * 8);
    float rp0 = 0.f;
    if (tid < 465) rp0 = p.rpb[head * 465 + tid] * 1.44269504f;
#pragma unroll
    for (int i = 0; i < 9; ++i) { const int id = tid + 512 * i, key = id >> 3, ch = id & 7;
        if (key < nkeys) { const int o = key * 128 + ((ch ^ (key & 7)) * 16); *(LAS u32x4*)(lds + o) = kreg[i]; *(LAS u32x4*)(lds + VOFF + o) = vreg[i]; } }
    if (tid < 465) rpbs[tid] = rp0;
    __syncthreads();
    u32x2 zreg[4];
#pragma unroll
    for (int dt = 0; dt < 4; ++dt) zreg[dt] = *(const u32x2*)(nz + lrq * 1024 + head * 64 + dt * 16 + 4 * fq);
    f32x4 s[16];
    const int krow0 = (rs - rsb) * 64 + kb + fr;
#pragma unroll
    for (int t = 0; t < 16; ++t) { s[t] = (f32x4){0.f, 0.f, 0.f, 0.f};
        const int key = krow0 + (t >> 1) * 64 + 16 * (t & 1);
#pragma unroll
        for (int ks = 0; ks < 2; ++ks) { const bf16x8 kf = *(LAS bf16x8*)(lds + key * 128 + (((ks * 4 + fq) ^ (key & 7)) * 16)); s[t] = mfma16(kf, qf[ks], s[t]); } }
    const int c = 16 * n + fr, cs = min(max(c - 8, 0), 48);
    bool vf[2][4];
#pragma unroll
    for (int hf2 = 0; hf2 < 2; ++hf2)
#pragma unroll
        for (int i = 0; i < 4; ++i) vf[hf2][i] = (unsigned)(kb + 16 * hf2 + 4 * fq + i - cs) < 16u;
    LAS float* bp = rpbs + ((rs - r + 7) * 31 + (kb - 16 * n + 4 * fq - fr + 15));
    float mx = -1e30f;
#pragma unroll
    for (int t = 0; t < 16; ++t)
#pragma unroll
        for (int i = 0; i < 4; ++i) { const float v = vf[t & 1][i] ? s[t][i] * 0.18033688f + bp[(t >> 1) * 31 + 16 * (t & 1) + i] : -1e30f; s[t][i] = v; mx = fmaxf(mx, v); }
    mx = fmaxf(mx, __shfl_xor(mx, 16)); mx = fmaxf(mx, __shfl_xor(mx, 32));
    float sum = 0.f;
#pragma unroll
    for (int t = 0; t < 16; ++t)
#pragma unroll
        for (int i = 0; i < 4; ++i) { const float e = __builtin_amdgcn_exp2f(s[t][i] - mx); s[t][i] = e; sum += e; }
    sum += __shfl_xor(sum, 16); sum += __shfl_xor(sum, 32);
    f32x4 o[4];
#pragma unroll
    for (int dt = 0; dt < 4; ++dt) o[dt] = (f32x4){0.f, 0.f, 0.f, 0.f};
    const int vrow0 = (rs - rsb) * 64 + kb + 4 * fq + (fr >> 2), pch = (fr & 3) >> 1, phalf = (fr & 3) & 1;
#pragma unroll
    for (int kk = 0; kk < 8; ++kk) {
        u32x4 pw; pw.x = pk2(s[2 * kk][0], s[2 * kk][1]); pw.y = pk2(s[2 * kk][2], s[2 * kk][3]); pw.z = pk2(s[2 * kk + 1][0], s[2 * kk + 1][1]); pw.w = pk2(s[2 * kk + 1][2], s[2 * kk + 1][3]);
        const bf16x8 pf = __builtin_bit_cast(bf16x8, pw);
        const int k0 = vrow0 + kk * 64, k1 = k0 + 16;
#pragma unroll
        for (int dt = 0; dt < 4; ++dt) { const int chunk = 2 * dt + pch;
            const bf16x8 a = tr8(lds + VOFF, k0 * 128 + ((chunk ^ (k0 & 7)) * 16) + phalf * 8, k1 * 128 + ((chunk ^ (k1 & 7)) * 16) + phalf * 8); o[dt] = mfma16(a, pf, o[dt]); }
    }
    const float inv = __builtin_amdgcn_rcpf(sum);
#pragma unroll
    for (int dt = 0; dt < 4; ++dt) { const size_t off = lrq * 1024 + head * 64 + dt * 16 + 4 * fq; const u32x2 z = zreg[dt];
        u32x2 wv; wv.x = pk2(o[dt][0] * inv * siluf_(bflo(z.x)), o[dt][1] * inv * siluf_(bfhi(z.x))); wv.y = pk2(o[dt][2] * inv * siluf_(bflo(z.y)), o[dt][3] * inv * siluf_(bfhi(z.y)));
        *(u32x2*)(yb + off) = wv; }
}

struct NaGeom { int s0, rows, r0, rsb, rs1; };
__device__ __forceinline__ NaGeom na_geom(int T0, int gpair) {
    NaGeom g; const int tokA = T0 + gpair * 128; int len; seq_of(tokA, g.s0, len);
    g.rows = len / 64; g.r0 = (tokA - g.s0) / 64;
    g.rsb = min(max(g.r0 - 4, 0), g.rows - 8); g.rs1 = min(max(g.r0 - 3, 0), g.rows - 8); return g;
}
__device__ __forceinline__ void na_band(const Params& p, unsigned char* shm, int T0, int Mc) {
    LAS unsigned char* lds = (LAS unsigned char*)shm;
    LAS float* rpbs = (LAS float*)(lds + L_RPB);
    constexpr int VOFF = 73728;
    const int tid = threadIdx.x, w = tid >> 6, lane = tid & 63, fr = lane & 15, fq = lane >> 4;
    const int n = w & 3, rr = w >> 2;
    const int head = blockIdx.x & 15, band = blockIdx.x >> 4, ppb = (Mc / 128) / 16;
    const us* nq = actp(p, 5) + (size_t)head * p.Mr * 64; const us* nk = actp(p, 6) + (size_t)head * p.Mr * 64; const us* nv = actp(p, 7) + (size_t)head * p.Mr * 64;
    const us* nz = actp(p, 8); us* yb = (us*)(p.ws + p.o_xn);
    const int kb = min(max(16 * n - 8, 0), 32);
    const int c = 16 * n + fr, cs = min(max(c - 8, 0), 48);
    const int ccol = tid >> 3, cch = tid & 7;
    const int cswz = (ccol * 128) + ((cch ^ (ccol & 7)) * 16);
    if (tid < 465) rpbs[tid] = p.rpb[head * 465 + tid] * 1.44269504f;
    bool vf[2][4];
#pragma unroll
    for (int hf2 = 0; hf2 < 2; ++hf2)
#pragma unroll
        for (int i = 0; i < 4; ++i) vf[hf2][i] = (unsigned)(kb + 16 * hf2 + 4 * fq + i - cs) < 16u;
    u32x4 kpf[2], vpf[2]; bf16x8 qfn[2];
    int prev_hi = 0, prev_s0 = -1;
    {
        const int gp0 = band * ppb; const size_t lq = (size_t)(gp0 * 128 + rr * 64 + 16 * n + fr);
#pragma unroll
        for (int ks = 0; ks < 2; ++ks) qfn[ks] = *(const bf16x8*)(nq + lq * 64 + ks * 32 + fq * 8);
    }
    for (int k = 0; k < ppb; ++k) {
        const int gpair = band * ppb + k; const NaGeom g = na_geom(T0, gpair);
        const int hi = g.rs1 + 8; const bool fresh = (g.s0 != prev_s0);
        const int r = g.r0 + rr, rs = rr ? g.rs1 : g.rsb;
        const size_t lrq = (size_t)(gpair * 128 + rr * 64 + 16 * n + fr);
        const size_t rowbase = (size_t)(g.s0 - T0) * 64 + (size_t)ccol * 64 + cch * 8;
        __syncthreads();
        if (fresh) {
            u32x4 kreg[9], vreg[9];
#pragma unroll
            for (int i = 0; i < 9; ++i) { const int R = g.rsb + i; if (R < hi) { kreg[i] = *(const u32x4*)(nk + rowbase + (size_t)R * 4096); vreg[i] = *(const u32x4*)(nv + rowbase + (size_t)R * 4096); } }
#pragma unroll
            for (int i = 0; i < 9; ++i) { const int R = g.rsb + i; if (R < hi) { const int o = (R % 9) * 8192 + cswz; *(LAS u32x4*)(lds + o) = kreg[i]; *(LAS u32x4*)(lds + VOFF + o) = vreg[i]; } }
        } else {
#pragma unroll
            for (int i = 0; i < 2; ++i) { const int R = prev_hi + i; if (R < hi) { const int o = (R % 9) * 8192 + cswz; *(LAS u32x4*)(lds + o) = kpf[i]; *(LAS u32x4*)(lds + VOFF + o) = vpf[i]; } }
        }
        const bf16x8 qf0 = qfn[0], qf1 = qfn[1];
        __syncthreads();
        u32x2 zreg[4];
#pragma unroll
        for (int dt = 0; dt < 4; ++dt) zreg[dt] = *(const u32x2*)(nz + lrq * 1024 + head * 64 + dt * 16 + 4 * fq);
        if (k + 1 < ppb) {
            const NaGeom g2 = na_geom(T0, gpair + 1); const int hi2 = g2.rs1 + 8;
            if (g2.s0 == g.s0) {
#pragma unroll
                for (int i = 0; i < 2; ++i) { const int R = hi + i; if (R < hi2) { kpf[i] = *(const u32x4*)(nk + rowbase + (size_t)R * 4096); vpf[i] = *(const u32x4*)(nv + rowbase + (size_t)R * 4096); } }
            }
            const size_t lq = (size_t)((gpair + 1) * 128 + rr * 64 + 16 * n + fr);
#pragma unroll
            for (int ks = 0; ks < 2; ++ks) qfn[ks] = *(const bf16x8*)(nq + lq * 64 + ks * 32 + fq * 8);
        }
        prev_hi = hi; prev_s0 = g.s0;
        int slot[8];
#pragma unroll
        for (int i = 0; i < 8; ++i) slot[i] = (rs + i) % 9;
        f32x4 s[16];
#pragma unroll
        for (int t = 0; t < 16; ++t) { s[t] = (f32x4){0.f, 0.f, 0.f, 0.f};
            const int key = slot[t >> 1] * 64 + kb + 16 * (t & 1) + fr;
            const bf16x8 kf0 = *(LAS bf16x8*)(lds + key * 128 + (((0 + fq) ^ (key & 7)) * 16)), kf1 = *(LAS bf16x8*)(lds + key * 128 + (((4 + fq) ^ (key & 7)) * 16));
            s[t] = mfma16(kf0, qf0, s[t]); s[t] = mfma16(kf1, qf1, s[t]); }
        LAS float* bp = rpbs + ((rs - r + 7) * 31 + (kb - 16 * n + 4 * fq - fr + 15));
        float mx = -1e30f;
#pragma unroll
        for (int t = 0; t < 16; ++t)
#pragma unroll
            for (int i = 0; i < 4; ++i) { const float v = vf[t & 1][i] ? s[t][i] * 0.18033688f + bp[(t >> 1) * 31 + 16 * (t & 1) + i] : -1e30f; s[t][i] = v; mx = fmaxf(mx, v); }
        mx = fmaxf(mx, __shfl_xor(mx, 16)); mx = fmaxf(mx, __shfl_xor(mx, 32));
        float sum = 0.f;
#pragma unroll
        for (int t = 0; t < 16; ++t)
#pragma unroll
            for (int i = 0; i < 4; ++i) { const float e = __builtin_amdgcn_exp2f(s[t][i] - mx); s[t][i] = e; sum += e; }
        sum += __shfl_xor(sum, 16); sum += __shfl_xor(sum, 32);
        f32x4 o[4];
#pragma unroll
        for (int dt = 0; dt < 4; ++dt) o[dt] = (f32x4){0.f, 0.f, 0.f, 0.f};
        const int vcol0 = kb + 4 * fq + (fr >> 2), pch = (fr & 3) >> 1, phalf = (fr & 3) & 1;
#pragma unroll
        for (int kk = 0; kk < 8; ++kk) {
            u32x4 pw; pw.x = pk2(s[2 * kk][0], s[2 * kk][1]); pw.y = pk2(s[2 * kk][2], s[2 * kk][3]); pw.z = pk2(s[2 * kk + 1][0], s[2 * kk + 1][1]); pw.w = pk2(s[2 * kk + 1][2], s[2 * kk + 1][3]);
            const bf16x8 pf = __builtin_bit_cast(bf16x8, pw);
            const int k0 = slot[kk] * 64 + vcol0, k1 = k0 + 16;
#pragma unroll
            for (int dt = 0; dt < 4; ++dt) { const int chunk = 2 * dt + pch;
                const bf16x8 a = tr8(lds + VOFF, k0 * 128 + ((chunk ^ (k0 & 7)) * 16) + phalf * 8, k1 * 128 + ((chunk ^ (k1 & 7)) * 16) + phalf * 8); o[dt] = mfma16(a, pf, o[dt]); }
        }
        const float inv = __builtin_amdgcn_rcpf(sum);
#pragma unroll
        for (int dt = 0; dt < 4; ++dt) { const size_t off = lrq * 1024 + head * 64 + dt * 16 + 4 * fq; const u32x2 z = zreg[dt];
            u32x2 wv; wv.x = pk2(o[dt][0] * inv * siluf_(bflo(z.x)), o[dt][1] * inv * siluf_(bfhi(z.x))); wv.y = pk2(o[dt][2] * inv * siluf_(bflo(z.y)), o[dt][3] * inv * siluf_(bfhi(z.y)));
            *(u32x2*)(yb + off) = wv; }
    }
}

__device__ __forceinline__ void phase_mix(const Params& p, unsigned char* shm, int T0, int Mc, int cidx, int flags) {
    float* state = (float*)(p.ws + p.o_state);
    const int n_pre = (flags & 1) ? 7 * 32 : 0;
    const int n_chain = (flags & 2) ? (Mc / UNIT) * 32 : 0;
    const int n_na = (flags & 4) ? (Mc / 128) * 16 : 0;
    for (int item = blockIdx.x; item < n_pre; item += gridDim.x) { __syncthreads();
        const int g = item >> 5, combo = item & 31;
        mlstm_chain<true>(p, shm, T0, Mc, 0, TOK_P, combo & 3, (combo >> 2) & 1, combo >> 3, 32 * g, 32 * g + 32, nullptr, 0, state + (size_t)(combo * 8 + g) * ST_REC); }
    for (int item = blockIdx.x; item < n_chain; item += gridDim.x) { __syncthreads();
        const int si = item >> 5, combo = item & 31;
        if (T0 == 0 && si < 8) mlstm_chain<false>(p, shm, T0, Mc, 0, TOK_P, combo & 3, (combo >> 2) & 1, combo >> 3, 32 * si, 32 * si + 32, state + (size_t)(combo * 8) * ST_REC, si, nullptr);
        else mlstm_chain<false>(p, shm, T0, Mc, T0 + si * UNIT, UNIT, combo & 3, (combo >> 2) & 1, combo >> 3, 0, 32, nullptr, 0, nullptr); }
    if (n_na) { __syncthreads();
        if (gridDim.x == 256) na_band(p, shm, T0, Mc);
        else for (int idx = blockIdx.x; idx < n_na; idx += gridDim.x) { __syncthreads(); na_item(p, shm, T0, idx >> 4, idx & 15); } }
    __syncthreads();
}

#define XB_TMO      128
#define XB_XCNT(j)  (256  + 64 * (j))
#define XB_XSUB(j)  (1280 + 64 * (j))
#define XB_XGEN(j)  (2304 + 64 * (j))
#define XB_TOP      3328
#define XB_TOPGEN   3392
#define XCD_BAR_WORDS 3456
#define XB_SPIN_CAP (1u << 18)
#define XB_TOP      3328
#define XB_TOPGEN   3392
#define XCD_BAR_WORDS 3456
#define XB_SPIN_CAP (1u << 18)

__device__ __forceinline__ unsigned xb_ld(unsigned* p)              { return __hip_atomic_load(p, __ATOMIC_RELAXED, __HIP_MEMORY_SCOPE_AGENT); }
__device__ __forceinline__ unsigned xb_add(unsigned* p, unsigned v) { return __hip_atomic_fetch_add(p, v, __ATOMIC_RELAXED, __HIP_MEMORY_SCOPE_AGENT); }
__device__ __forceinline__ unsigned xb_xcc_id() { return (unsigned)__builtin_amdgcn_s_getreg((3 << 11) | 20) & 0xFu; }
#define XB_SPIN(cond, bar) do { unsigned _sp = 0; while (cond) { __builtin_amdgcn_s_sleep(1); \
    if ((++_sp & 255u) == 0u) { if (xb_ld(&(bar)[XB_TMO])) break; if (_sp > XB_SPIN_CAP) { atomicAdd(&(bar)[XB_TMO], 1u); break; } } } } while (0)

struct XcdBarrier {
    unsigned* bar; unsigned x;
    volatile LAS unsigned* st;
};

__device__ __forceinline__ XcdBarrier xcd_barrier_post(unsigned* bar, volatile LAS unsigned* st) {
    XcdBarrier b; b.bar = bar; b.x = xb_xcc_id(); b.st = st;
    if (threadIdx.x == 0) (void)xb_add(&bar[XB_XCNT(b.x)], 1u);
    return b;
}
__device__ __forceinline__ void xcd_barrier_complete(unsigned* bar, unsigned x, unsigned& nloc, unsigned& nx) {
    const unsigned G = gridDim.x * gridDim.y * gridDim.z;
    unsigned sum, cnt, mine, sp = 0u;
    for (;;) {
        sum = 0u; cnt = 0u; mine = 0u;
#pragma unroll
        for (unsigned j = 0; j < 16; ++j) { const unsigned c = xb_ld(&bar[XB_XCNT(j)]); sum += c; cnt += (c > 0u) ? 1u : 0u; mine = (j == x) ? c : mine; }
        if (sum == G) break;
        __builtin_amdgcn_s_sleep(1);
        if ((++sp & 255u) == 0u) { if (xb_ld(&bar[XB_TMO])) break; if (sp > XB_SPIN_CAP) { atomicAdd(&bar[XB_TMO], 1u); break; } }
    }
    nloc = mine > 0u ? mine : 1u; nx = cnt > 0u ? cnt : 1u;
}

__device__ __forceinline__ void xcd_barrier(const XcdBarrier& b) {
    asm volatile("s_waitcnt vmcnt(0)" ::: "memory");
    __syncthreads();
    if (threadIdx.x == 0) {
        unsigned* bar = b.bar;
        __builtin_amdgcn_s_waitcnt(0);
        unsigned nloc = b.st[0], nx = b.st[1];
        if (nloc == 0u) { xcd_barrier_complete(bar, b.x, nloc, nx); b.st[0] = nloc; b.st[1] = nx; }
        const unsigned old = xb_add(&bar[XB_XSUB(b.x)], 1u);
        const unsigned gen = old / nloc;
        if (old + 1u == (gen + 1u) * nloc) {
            __builtin_amdgcn_fence(__ATOMIC_RELEASE, "agent");
            asm volatile("s_waitcnt vmcnt(0)" ::: "memory");
            const unsigned og = xb_add(&bar[XB_TOP], 1u);
            const unsigned tg = og / nx;
            if (og + 1u == (tg + 1u) * nx) xb_add(&bar[XB_TOPGEN], 1u);
            else XB_SPIN(xb_ld(&bar[XB_TOPGEN]) == tg, bar);
            __builtin_amdgcn_fence(__ATOMIC_ACQUIRE, "agent");
            xb_add(&bar[XB_XGEN(b.x)], 1u);
            asm volatile("s_waitcnt vmcnt(0)" ::: "memory");
        } else {
            XB_SPIN(xb_ld(&bar[XB_XGEN(b.x)]) == gen, bar);
            __builtin_amdgcn_fence(__ATOMIC_ACQUIRE, "agent");
            asm volatile("s_waitcnt vmcnt(0)" ::: "memory");
        }
    }
    __syncthreads();
}

#ifndef PHM
#define PHM 0xFFF
#endif
#define IN(k) (lo <= (k) && (k) < hi)
#define INB(b, k) (((PHM >> (b)) & 1) && IN(k))
#define SEAM(k) do { if (IN(k) && IN((k) + 1)) xcd_barrier(bar); } while (0)
__device__ __forceinline__ void round_body(const Params& p, unsigned char* shm, const XcdBarrier& bar, const int round, const int lo, const int hi) {
    const int T0 = round * p.Mr, pb = 1 + 8 * round;
    const int Mc = (TOK_ALL - T0) < p.Mr ? (TOK_ALL - T0) : p.Mr;
    if (INB(1, pb)) { EpiIn E; E.act = actp(p, 0); E.split_stride = (size_t)p.Mr * 1024; E.gates = (float*)(p.ws + p.o_gates); E.b_gate = p.b_gate;
        run_gemm(shm, (const us*)(p.ws + p.o_xn), (const us*)(p.ws + p.o_winT), Mc, 11264, 1024, E); }
    SEAM(pb);
    if (INB(2, pb + 1)) { phase_gates(p, Mc); phase_conv(p, T0, Mc); }
    SEAM(pb + 1);
    if (round == 0) {
        if (INB(3, pb + 2)) phase_mix(p, shm, T0, Mc, 0, 1 | 4);
        SEAM(pb + 2);
        if (INB(4, pb + 3)) phase_mix(p, shm, T0, Mc, 1, 2);
    } else {
        if (INB(4, pb + 3)) phase_mix(p, shm, T0, Mc, 1 + round, 2 | 4);
    }
    SEAM(pb + 3);
    if (INB(5, pb + 4)) phase_ya(p, Mc);
    SEAM(pb + 4);
    if (INB(6, pb + 5)) {
        EpiPair E; E.ga = actp(p, 9); E.gb = actp(p, 10); E.merged = actp(p, 1);
        run_gemm_pair(shm, actp(p, 0), (const us*)(p.ws + p.o_wdaT), (const us*)(p.ws + p.o_xn), (const us*)(p.ws + p.o_wdbT), Mc, 1024, 1024, E);
    }
    SEAM(pb + 5);
    if (INB(7, pb + 6)) { EpiOut E; E.out = p.out + (size_t)T0 * 1024; E.xp = p.xp; E.xs = p.xs; E.T0 = T0; run_gemm(shm, actp(p, 1), (const us*)(p.ws + p.o_woutT), Mc, 1024, 1024, E); }
    SEAM(pb + 6);
    if (INB(8, pb + 7)) { phase_fnorm(p, T0, Mc); if (T0 + Mc < TOK_ALL) phase_xnorm(p, T0 + Mc, (TOK_ALL - T0 - Mc) < p.Mr ? (TOK_ALL - T0 - Mc) : p.Mr); }
    if (T0 + Mc < TOK_ALL) SEAM(pb + 7);
}
__global__ __launch_bounds__(512, 2) void mega(Params p) {
    extern __shared__ __attribute__((aligned(16))) unsigned char shm[];
    cg::grid_group grid = cg::this_grid();
    const int lo = p.ph_lo, hi = p.ph_hi;
    volatile LAS unsigned* bst = (volatile LAS unsigned*)((LAS unsigned char*)shm + (LDS_BYTES - 32));
    if (threadIdx.x == 0) { bst[0] = 0u; bst[1] = 0u; }
    __syncthreads();
    const XcdBarrier bar = xcd_barrier_post((unsigned*)(p.ws + p.o_bar), bst);
    if (INB(0, 0)) { phase_weights(p, shm); phase_xnorm(p, 0, p.Mr); }
    if (IN(0) && IN(1)) grid.sync();
    round_body(p, shm, bar, 0, lo, hi);
    round_body(p, shm, bar, 1, lo, hi);
    round_body(p, shm, bar, 2, lo, hi);
#undef IN
#undef SEAM
}

#ifndef N_LAUNCH_MODE
#define N_LAUNCH_MODE 1
#endif
extern "C" void kernel_launch(void* const* d_in, const int* in_sizes, int n_in, void* d_out, int out_size, void* d_ws, size_t ws_size, hipStream_t stream) {
    static int grid = 0;
    if (grid == 0) {
        int dev = 0, cus = 0, per_cu = 0;
        hipGetDevice(&dev); hipDeviceGetAttribute(&cus, hipDeviceAttributeMultiprocessorCount, dev);
        if (hipFuncSetAttribute((const void*)mega, hipFuncAttributeMaxDynamicSharedMemorySize, LDS_BYTES) != hipSuccess) fprintf(stderr, "kernel_launch: hipFuncSetAttribute failed\n");
        if (hipOccupancyMaxActiveBlocksPerMultiprocessor(&per_cu, (const void*)mega, 512, LDS_BYTES) != hipSuccess || per_cu < 1) { fprintf(stderr, "kernel_launch: occupancy query says %d\n", per_cu); per_cu = 1; }
        (void)hipGetLastError();
        grid = cus * 1;
        if (grid <= 0) grid = 256;
    }
    Params p{};
    p.xp = (const float*)d_in[0]; p.xs = (const float*)d_in[1]; p.norm_w = (const float*)d_in[2]; p.w_in = (const float*)d_in[3]; p.b_gate = (const float*)d_in[4];
    p.conv_w = (const float*)d_in[5]; p.conv_b = (const float*)d_in[6]; p.mh_w = (const float*)d_in[7]; p.rpb = (const float*)d_in[8];
    p.wda = (const float*)d_in[9]; p.wdb = (const float*)d_in[10]; p.wout = (const float*)d_in[11]; p.fnw = (const float*)d_in[12];
    p.out = (float*)d_out; p.ws = (unsigned char*)d_ws;
    size_t off = 0;
    p.o_winT = off; off += (size_t)NPAD * 1024 * 2;
    p.o_wdaT = off; off += (size_t)1024 * 1024 * 2; p.o_wdbT = off; off += (size_t)1024 * 1024 * 2; p.o_woutT = off; off += (size_t)1024 * 1024 * 2;
    p.o_ctr = off; off += 256;
    p.o_bar = off; off += (size_t)XCD_BAR_WORDS * 4;
    p.o_state = off; off += (size_t)256 * ST_REC * 4;
    const int Mr = 32768;
    p.Mr = Mr; p.nrounds = 3;
    p.o_gates = off; off += (size_t)Mr * 64;
    p.o_xn = off; off += (size_t)Mr * 2048;
    p.o_act = off; off += (size_t)Mr * 11 * 2048;
    if (off > ws_size) { fprintf(stderr, "kernel_launch: workspace too small (%zu > %zu)\n", off, ws_size); return; }
    hipMemsetAsync((char*)d_ws + p.o_ctr, 0, 256 + (size_t)XCD_BAR_WORDS * 4, stream);
    const int nph = 1 + 8 * p.nrounds;
#if N_LAUNCH_MODE == 1
    p.ph_lo = 0; p.ph_hi = nph;
    void* args[] = {&p};
    hipError_t e = hipLaunchCooperativeKernel((const void*)mega, dim3(grid), dim3(512), args, LDS_BYTES, stream);
    if (e != hipSuccess) fprintf(stderr, "kernel_launch: cooperative launch failed: %s (grid %d)\n", hipGetErrorString(e), grid);
#else
    for (int ph = 0; ph < nph; ++ph) { p.ph_lo = ph; p.ph_hi = ph + 1; hipLaunchKernelGGL(mega, dim3(grid), dim3(512), LDS_BYTES, stream, p); }
#endif
}
```

```cpp
#include <hip/hip_runtime.h>
#include <hip/hip_cooperative_groups.h>
#include <cstdio>
namespace cg = cooperative_groups;
namespace pg8 {
#define PG8_LAS __attribute__((address_space(3)))
typedef unsigned short bf16_t;
typedef short bf16x8 __attribute__((ext_vector_type(8)));
typedef float f32x4 __attribute__((ext_vector_type(4)));
typedef unsigned u32x4 __attribute__((ext_vector_type(4)));
constexpr int BM = 256, BK = 64, HALF = 128, HTB = HALF * BK * 2  , STAGE_BYTES = 8 * HTB, NXCD = 8, WGM = 8;

__host__ __device__ __forceinline__ int lds_byte(int r, int c) { const int st = (r >> 4) * 2 + (c >> 5), rr = r & 15, cc = c & 31, ob = rr * 64 + cc * 2; return st * 1024 + (ob ^ (((ob >> 9) & 1) << 5)); }
__host__ __device__ __forceinline__ void stage_rc(int b, int& R, int& C) { const int st = b / 1024, sb = b % 1024, swz = sb ^ (((sb >> 9) & 1) << 5); R = (st >> 1) * 16 + swz / 64; C = (st & 1) * 32 + (swz % 64) / 2; }
__host__ __device__ __forceinline__ int perm32(int rho) { const int n = rho >> 4, i = rho & 15; return 8 * (i >> 2) + 4 * n + (i & 3); }

struct Unit { int pm, pn, w; };
struct Gemm { const bf16_t* A; const bf16_t* Bt; int M, N, K; const bf16_t* A2; const bf16_t* Bt2; };

struct StaticOrder {
    int nM, nN, nwg, G, c;
    __host__ __device__ void init(int M, int N, int G_, int c_) { nM = M / BM; nN = N / BM; nwg = nM * nN; G = G_; c = c_; }
    __host__ __device__ bool next(int i, Unit& u) const {
        const long L = (long)i * G + c; if (L >= nwg) return false;
        int wgid = (int)L; { const int q = nwg / NXCD, r = nwg % NXCD, xcd = wgid % NXCD, off = wgid / NXCD; wgid = (xcd < r ? xcd * (q + 1) : r * (q + 1) + (xcd - r) * q) + off; }
        const int nig = WGM * nN, gid = wgid / nig, fm = gid * WGM, gsz = (nM - fm) < WGM ? (nM - fm) : WGM;
        u.pm = fm + ((wgid % nig) % gsz); u.pn = (wgid % nig) / gsz; u.w = 0; return true;
    }
    __device__ __forceinline__ void a_ready(const Unit&) const {}
    __device__ __forceinline__ void done(const Unit&) const {}
};
__device__ __forceinline__ unsigned cvt_pk_bf16(float lo, float hi) { unsigned r; asm volatile("v_cvt_pk_bf16_f32 %0, %1, %2" : "=v"(r) : "v"(lo), "v"(hi)); return r; }
template <class Epi, class Sched, bool STAMP = false>
__device__ __forceinline__ void gemm_phase(PG8_LAS unsigned char* lds, const Gemm g, const Sched& S, const Epi& E, unsigned long long* stamps) {
    const int tid = threadIdx.x, wid = __builtin_amdgcn_readfirstlane(tid >> 6), lane = tid & 63, wr = wid >> 2, wc = wid & 3, fr = lane & 15, fq = lane >> 4;
    const int K = g.K, nt = K / BK;
    int ts_lo = 0, ts_hi = 0, nts = 0; const unsigned long long rt_entry = STAMP ? (unsigned long long)wall_clock64() : 0ull;
#define PG8_STAMP() do { if (STAMP && wid == 0 && nts < 64) { const unsigned long long _c = (unsigned long long)clock64(); \
        ts_lo = (lane == nts) ? (int)(unsigned)_c : ts_lo; ts_hi = (lane == nts) ? (int)(unsigned)(_c >> 32) : ts_hi; ++nts; } } while (0)
    PG8_STAMP();
    unsigned voffA[2], voffB[2];
#pragma unroll
    for (int i = 0; i < 2; ++i) { int R, C; stage_rc(tid * 16 + i * 8192, R, C); const int Rb = Epi::PERM ? ((R & ~31) + perm32(R & 31)) : R;
        voffA[i] = (unsigned)(R * K + C) * 2u; voffB[i] = (unsigned)(Rb * K + C) * 2u; }
    const size_t kstep = (size_t)(BK * 2);
    const size_t hstep = (size_t)HALF * K * 2;
    const size_t tstep = 2 * hstep;
    const unsigned ldsw = (unsigned)wid * 1024u;
    const int aoff = lds_byte(wr * 64 + fr, fq * 8), boff = lds_byte(wc * 32 + fr, fq * 8);
#define PG8_SA(b, h) (((b) * 2 + (h)) * HTB)
#define PG8_SB(b, h) ((4 + (b) * 2 + (h)) * HTB)
#define PG8_STAGE(bufoff, gbase, voff) do { _Pragma("unroll") for (int _i = 0; _i < 2; ++_i) \
        __builtin_amdgcn_global_load_lds((const unsigned*)((const char*)(gbase) + (voff)[_i]), (PG8_LAS unsigned*)(lds + (bufoff) + ldsw + _i * 8192), 16, 0, 0); } while (0)
#define PG8_LDA(dst, b, h) do { _Pragma("unroll") for (int m = 0; m < 4; ++m) _Pragma("unroll") for (int k = 0; k < 2; ++k) dst[m][k] = *(const PG8_LAS bf16x8*)(lds + PG8_SA(b, h) + aoff + m * 2048 + k * 1024); } while (0)
#define PG8_LDB(dst, b, h) do { _Pragma("unroll") for (int n = 0; n < 2; ++n) _Pragma("unroll") for (int k = 0; k < 2; ++k) dst[n][k] = *(const PG8_LAS bf16x8*)(lds + PG8_SB(b, h) + boff + n * 2048 + k * 1024); } while (0)
#define PG8_MMA(ai, bj, At, Bt) do { __builtin_amdgcn_s_setprio(1); _Pragma("unroll") for (int m = 0; m < 4; ++m) _Pragma("unroll") for (int n = 0; n < 2; ++n) _Pragma("unroll") for (int k = 0; k < 2; ++k) \
        acc[ai][bj][m][n] = __builtin_amdgcn_mfma_f32_16x16x32_bf16(Bt[n][k], At[m][k], acc[ai][bj][m][n], 0, 0, 0); __builtin_amdgcn_s_setprio(0); } while (0)
#define PG8_WAIT_V(n) asm volatile("s_waitcnt vmcnt(" #n ")" ::: "memory")
#define PG8_WAIT_L(n) asm volatile("s_waitcnt lgkmcnt(" #n ")" ::: "memory")
#define PG8_BAR __builtin_amdgcn_s_barrier()
#define PG8_SCHED __builtin_amdgcn_sched_barrier(0)
    Unit cur, nxt; int ui = 0;
    if (!S.next(0, cur)) return;
    f32x4 acc[2][2][4][2];
#pragma unroll
    for (int a = 0; a < 2; ++a)
#pragma unroll
        for (int b = 0; b < 2; ++b)
#pragma unroll
            for (int m = 0; m < 4; ++m)
#pragma unroll
                for (int n = 0; n < 2; ++n) acc[a][b][m][n] = (f32x4){0.f, 0.f, 0.f, 0.f};
    bf16x8 At[4][2], B0[2][2], B1[2][2];
    const char* cA = (const char*)(cur.w ? g.A2 : g.A) + (size_t)cur.pm * tstep; const char* cB = (const char*)(cur.w ? g.Bt2 : g.Bt) + (size_t)cur.pn * tstep;
    S.a_ready(cur);
    PG8_STAGE(PG8_SB(0, 0), cB, voffB); PG8_STAGE(PG8_SB(0, 1), cB + hstep, voffB); PG8_STAGE(PG8_SA(0, 0), cA, voffA); PG8_STAGE(PG8_SA(0, 1), cA + hstep, voffA);
    if (wr == 1) PG8_BAR;
    PG8_WAIT_V(2); PG8_BAR;
    PG8_STAGE(PG8_SB(1, 0), cB + kstep, voffB); PG8_STAGE(PG8_SA(1, 0), cA + kstep, voffA); PG8_STAGE(PG8_SB(1, 1), cB + hstep + kstep, voffB);
    PG8_WAIT_V(6); PG8_BAR;
    PG8_STAMP();
    for (;;) {
        const bool has_next = S.next(ui + 1, nxt);
        const char* nA = has_next ? (const char*)(nxt.w ? g.A2 : g.A) + (size_t)nxt.pm * tstep : cA; const char* nB = has_next ? (const char*)(nxt.w ? g.Bt2 : g.Bt) + (size_t)nxt.pn * tstep : cB;
        for (int t = 0; t < nt; t += 2) {
            const bool last = (t == nt - 2);
            const char* a1 = cA + (size_t)(t + 1) * kstep;
            const char* a2 = last ? nA : cA + (size_t)(t + 2) * kstep; const char* b2 = last ? nB : cB + (size_t)(t + 2) * kstep;
            const char* a3 = a2 + kstep; const char* b3 = b2 + kstep;
            if (last && has_next) S.a_ready(nxt);
            PG8_LDB(B0, 0, 0); PG8_LDB(B1, 0, 1); PG8_SCHED; PG8_LDA(At, 0, 0); PG8_STAGE(PG8_SA(1, 1), a1 + hstep, voffA);
            PG8_WAIT_V(8); PG8_WAIT_L(0); PG8_BAR; PG8_MMA(0, 0, At, B0); PG8_MMA(0, 1, At, B1); PG8_BAR; PG8_SCHED;
            PG8_LDA(At, 0, 1); PG8_STAGE(PG8_SB(0, 0), b2, voffB); PG8_STAGE(PG8_SB(0, 1), b2 + hstep, voffB); PG8_STAGE(PG8_SA(0, 0), a2, voffA);
            PG8_WAIT_V(8); PG8_WAIT_L(0); PG8_BAR; PG8_MMA(1, 0, At, B0); PG8_MMA(1, 1, At, B1); PG8_BAR; PG8_SCHED;
            PG8_LDB(B0, 1, 0); PG8_LDB(B1, 1, 1); PG8_SCHED; PG8_LDA(At, 1, 0); PG8_STAGE(PG8_SA(0, 1), a2 + hstep, voffA);
            PG8_WAIT_V(8); PG8_WAIT_L(0); PG8_BAR; PG8_MMA(0, 0, At, B0); PG8_MMA(0, 1, At, B1); PG8_BAR; PG8_SCHED;
            PG8_LDA(At, 1, 1); PG8_STAGE(PG8_SB(1, 0), b3, voffB); PG8_STAGE(PG8_SB(1, 1), b3 + hstep, voffB); PG8_STAGE(PG8_SA(1, 0), a3, voffA);
            PG8_WAIT_V(8); PG8_WAIT_L(0); PG8_BAR; PG8_MMA(1, 0, At, B0); PG8_MMA(1, 1, At, B1); PG8_BAR; PG8_SCHED;
        }
        PG8_STAMP();
        if (wr == 0) PG8_BAR;
        if constexpr (!Epi::AFTER_DRAIN) { E(acc, cur, wr, wc, fr, fq); S.done(cur); }
        PG8_STAMP();
        if (!has_next) break;
        if (!(Epi::PAIR && cur.w == 0)) {
#pragma unroll
        for (int a = 0; a < 2; ++a)
#pragma unroll
            for (int b = 0; b < 2; ++b)
#pragma unroll
                for (int m = 0; m < 4; ++m)
#pragma unroll
                    for (int n = 0; n < 2; ++n) acc[a][b][m][n] = (f32x4){0.f, 0.f, 0.f, 0.f};
        }
        cur = nxt; cA = nA; cB = nB; ++ui;
        if (wr == 1) PG8_BAR;
    }
    PG8_WAIT_V(0);
    PG8_BAR;
    if constexpr (Epi::AFTER_DRAIN) { E.fused(acc, cur, wr, wc, fr, fq, lds, wid, lane); S.done(cur); }
    PG8_STAMP();
    if (STAMP && wid == 0) { stamps[lane] = lane < nts ? (((unsigned long long)(unsigned)ts_hi << 32) | (unsigned)ts_lo) : 0ull;
        if (lane == 62) stamps[62] = rt_entry; if (lane == 63) stamps[63] = (unsigned long long)wall_clock64(); }
#undef PG8_STAMP
#undef PG8_SA
#undef PG8_SB
#undef PG8_STAGE
#undef PG8_LDA
#undef PG8_LDB
#undef PG8_MMA
#undef PG8_WAIT_V
#undef PG8_WAIT_L
#undef PG8_BAR
#undef PG8_SCHED
}
}

#define LAS __attribute__((address_space(3)))
typedef unsigned short us;
typedef short bf16x8 __attribute__((ext_vector_type(8)));
typedef short s16x4 __attribute__((ext_vector_type(4)));
typedef float f32x4 __attribute__((ext_vector_type(4)));
typedef unsigned u32x4 __attribute__((ext_vector_type(4)));
typedef unsigned u32x2 __attribute__((ext_vector_type(2)));

constexpr int TOK_P = 16384, TOK_ALL = 81920, UNIT = 2048;
constexpr int DIN = 11280, NPAD = 11520;
constexpr int LDS_BYTES = 163840;
constexpr int L_ITEM = LDS_BYTES - 16;
constexpr int QS = 528, VS = 144;
constexpr int VSW = 176;
constexpr int L_Q = 0, L_K = 33792, L_ST = 67584, L_V = 101376, L_VW = 110592, L_P = 121856, L_SM = 131072;
constexpr int SM_W = 256, SM_QN = 320, SM_RS = 384  , SM_N = 640  ;
constexpr int L_NP = 132864  , L_GU = 134912, L_GC = 143104, L_GB = 151296, L_GM = 159488;
constexpr int NA_VH = 73728, L_RPB = 147456;

struct Params {
    const float *xp, *xs, *norm_w, *w_in, *b_gate, *conv_w, *conv_b, *mh_w, *rpb, *wda, *wdb, *wout, *fnw;
    float* out;
    unsigned char* ws;
    unsigned long long o_winT, o_wdaT, o_wdbT, o_woutT, o_ctr, o_bar, o_state, o_gates, o_xn, o_act;
    int Mr, nrounds, ph_lo, ph_hi;
};

__device__ __forceinline__ us f2bf(float f) { unsigned u = __float_as_uint(f); u += 0x7FFFu + ((u >> 16) & 1u); return (us)(u >> 16); }
__device__ __forceinline__ float bf2f(unsigned b) { return __uint_as_float(b << 16); }
typedef float f32x2_ __attribute__((ext_vector_type(2)));
typedef __bf16 bf16x2_ __attribute__((ext_vector_type(2)));
__device__ __forceinline__ unsigned pk2(float lo, float hi) { f32x2_ v = {lo, hi}; bf16x2_ b = __builtin_convertvector(v, bf16x2_); return __builtin_bit_cast(unsigned, b); }
__device__ __forceinline__ float bflo(unsigned w) { return __uint_as_float(w << 16); }
__device__ __forceinline__ float bfhi(unsigned w) { return __uint_as_float(w & 0xFFFF0000u); }
__device__ __forceinline__ float sigmoidf_(float x) { return __builtin_amdgcn_rcpf(1.0f + __expf(-x)); }
__device__ __forceinline__ float siluf_(float x) { return x * __builtin_amdgcn_rcpf(1.0f + __expf(-x)); }
__device__ __forceinline__ const float* xrow(const Params& p, int t) { return t < TOK_P ? p.xp + (size_t)t * 1024 : p.xs + (size_t)(t - TOK_P) * 1024; }
__device__ __forceinline__ void seq_of(int t, int& s0, int& len) { if (t < TOK_P) { s0 = 0; len = TOK_P; } else { s0 = TOK_P + ((t - TOK_P) / UNIT) * UNIT; len = UNIT; } }
__device__ __forceinline__ us* actp(const Params& p, int i) { return (us*)(p.ws + p.o_act) + (size_t)i * p.Mr * 1024; }
__device__ __forceinline__ f32x4 mfma16(bf16x8 a, bf16x8 b, f32x4 c) { return __builtin_amdgcn_mfma_f32_16x16x32_bf16(a, b, c, 0, 0, 0); }
__device__ __forceinline__ bf16x8 tr8(LAS unsigned char* base, int off0, int off1) {
    s16x4 lo = __builtin_amdgcn_ds_read_tr16_b64_v4i16((LAS s16x4*)(base + off0));
    s16x4 hi = __builtin_amdgcn_ds_read_tr16_b64_v4i16((LAS s16x4*)(base + off1));
    return __builtin_shufflevector(lo, hi, 0, 1, 2, 3, 4, 5, 6, 7);
}

struct EpiIn {
    static constexpr bool PERM = true, AFTER_DRAIN = false, PAIR = false;
    us* act; size_t split_stride; float* gates; const float* b_gate;
    __device__ __forceinline__ void operator()(const pg8::f32x4 (&acc)[2][2][4][2], const pg8::Unit& u, int wr, int wc, int fr, int fq) const {
        const int row0 = u.pm * 256 + wr * 64 + fr;
        if (u.pn < 44) {
            const int t = u.pn >> 2;
            us* base = act + (size_t)t * split_stride;
            const int col0 = (u.pn & 3) * 256 + wc * 32 + 8 * fq;
            if (t >= 5 && t <= 7) {
                const size_t hstride = split_stride >> 4;
#pragma unroll
                for (int ai = 0; ai < 2; ++ai)
#pragma unroll
                    for (int m = 0; m < 4; ++m) { const size_t ro = (size_t)(row0 + ai * 128 + m * 16) * 64;
#pragma unroll
                        for (int bj = 0; bj < 2; ++bj) { const pg8::f32x4 v0 = acc[ai][bj][m][0], v1 = acc[ai][bj][m][1]; const int col = col0 + bj * 128;
                            u32x4 w; w.x = pk2(v0[0], v0[1]); w.y = pk2(v0[2], v0[3]); w.z = pk2(v1[0], v1[1]); w.w = pk2(v1[2], v1[3]);
                            __builtin_nontemporal_store(w, (u32x4*)(base + (size_t)(col >> 6) * hstride + ro + (col & 63))); } }
            } else
#pragma unroll
            for (int ai = 0; ai < 2; ++ai)
#pragma unroll
                for (int m = 0; m < 4; ++m) { us* rowp = base + (size_t)(row0 + ai * 128 + m * 16) * 1024 + col0;
#pragma unroll
                    for (int bj = 0; bj < 2; ++bj) { const pg8::f32x4 v0 = acc[ai][bj][m][0], v1 = acc[ai][bj][m][1];
                        u32x4 w; w.x = pk2(v0[0], v0[1]); w.y = pk2(v0[2], v0[3]); w.z = pk2(v1[0], v1[1]); w.w = pk2(v1[2], v1[3]);
                        __builtin_nontemporal_store(w, (u32x4*)(rowp + bj * 128)); } }
        } else {
            if (wc == 0 && fq < 2) {
#pragma unroll
                for (int n = 0; n < 2; ++n) { const int c = 8 * fq + 4 * n; const f32x4 bv = *(const f32x4*)(b_gate + c);
#pragma unroll
                    for (int ai = 0; ai < 2; ++ai)
#pragma unroll
                        for (int m = 0; m < 4; ++m) { const int row = row0 + ai * 128 + m * 16; *(f32x4*)(gates + (size_t)row * 16 + c) = acc[ai][0][m][n] + bv; } }
            }
        }
    }
};
struct PairOrder : pg8::StaticOrder {
    __device__ bool next(int i, pg8::Unit& u) const { const bool ok = pg8::StaticOrder::next(i >> 1, u); u.w = i & 1; return ok; }
};
struct EpiPair {
    static constexpr bool PERM = true, AFTER_DRAIN = false, PAIR = true;
    const us* ga; const us* gb; us* merged;
    __device__ __forceinline__ void operator()(pg8::f32x4 (&acc)[2][2][4][2], const pg8::Unit& u, int wr, int wc, int fr, int fq) const {
        const int row0 = u.pm * 256 + wr * 64 + fr, col0 = u.pn * 256 + wc * 32 + 8 * fq;
        if (u.w == 0) {
#pragma unroll
            for (int ai = 0; ai < 2; ++ai) {
                u32x4 a[4][2], b[4][2];
#pragma unroll
                for (int m = 0; m < 4; ++m)
#pragma unroll
                    for (int bj = 0; bj < 2; ++bj) { const size_t o = (size_t)(row0 + ai * 128 + m * 16) * 1024 + col0 + bj * 128; a[m][bj] = *(const u32x4*)(ga + o); b[m][bj] = *(const u32x4*)(gb + o); }
#pragma unroll
                for (int m = 0; m < 4; ++m)
#pragma unroll
                    for (int bj = 0; bj < 2; ++bj)
#pragma unroll
                        for (int q = 0; q < 4; ++q) { const unsigned aw = a[m][bj][q], bw = b[m][bj][q];
                            const float r0 = (1.0f + __expf(-bflo(bw))) * __builtin_amdgcn_rcpf(1.0f + __expf(-bflo(aw))), r1 = (1.0f + __expf(-bfhi(bw))) * __builtin_amdgcn_rcpf(1.0f + __expf(-bfhi(aw)));
                            acc[ai][bj][m][q >> 1][(q & 1) * 2] *= r0; acc[ai][bj][m][q >> 1][(q & 1) * 2 + 1] *= r1; }
                asm volatile("" ::: "memory");
            }
        } else {
#pragma unroll
            for (int ai = 0; ai < 2; ++ai) {
                u32x4 b[4][2];
#pragma unroll
                for (int m = 0; m < 4; ++m)
#pragma unroll
                    for (int bj = 0; bj < 2; ++bj) { const size_t o = (size_t)(row0 + ai * 128 + m * 16) * 1024 + col0 + bj * 128; b[m][bj] = *(const u32x4*)(gb + o); }
#pragma unroll
                for (int m = 0; m < 4; ++m)
#pragma unroll
                    for (int bj = 0; bj < 2; ++bj) { const size_t o = (size_t)(row0 + ai * 128 + m * 16) * 1024 + col0 + bj * 128; u32x4 w;
#pragma unroll
                        for (int q = 0; q < 4; ++q) { const unsigned bw = b[m][bj][q];
                            w[q] = pk2(acc[ai][bj][m][q >> 1][(q & 1) * 2] * sigmoidf_(bflo(bw)), acc[ai][bj][m][q >> 1][(q & 1) * 2 + 1] * sigmoidf_(bfhi(bw))); }
                        *(u32x4*)(merged + o) = w; }
                asm volatile("" ::: "memory");
            }
        }
    }
};
struct EpiOut {
    static constexpr bool PERM = false, AFTER_DRAIN = false, PAIR = false;
    float* out; const float* xp; const float* xs; int T0;
    __device__ __forceinline__ void operator()(const pg8::f32x4 (&acc)[2][2][4][2], const pg8::Unit& u, int wr, int wc, int fr, int fq) const {
        const int row0 = u.pm * 256 + wr * 64 + fr, col0 = u.pn * 256 + wc * 32 + 4 * fq;
#pragma unroll
        for (int ai = 0; ai < 2; ++ai)
#pragma unroll
            for (int m = 0; m < 4; ++m) { const int row = row0 + ai * 128 + m * 16; const int t = T0 + row;
                const float* xr = (t < TOK_P ? xp + (size_t)t * 1024 : xs + (size_t)(t - TOK_P) * 1024) + col0; float* orow = out + (size_t)row * 1024 + col0;
#pragma unroll
                for (int bj = 0; bj < 2; ++bj)
#pragma unroll
                    for (int n = 0; n < 2; ++n) { const int o = bj * 128 + n * 16; *(f32x4*)(orow + o) = *(const f32x4*)(xr + o) + acc[ai][bj][m][n]; } }
    }
};

template <class Epi> __device__ __forceinline__ void run_gemm(unsigned char* shm, const us* A, const us* Bt, int M, int N, int K, const Epi& E) {
    pg8::Gemm g; g.A = A; g.Bt = Bt; g.M = M; g.N = N; g.K = K; g.A2 = A; g.Bt2 = Bt;
    pg8::StaticOrder S; S.init(M, N, (int)gridDim.x, (int)blockIdx.x);
    pg8::gemm_phase<Epi, pg8::StaticOrder, false>((LAS unsigned char*)shm, g, S, E, nullptr);
}

__device__ __forceinline__ void run_gemm_pair(unsigned char* shm, const us* A, const us* Bt, const us* A2, const us* Bt2, int M, int N, int K, const EpiPair& E) {
    pg8::Gemm g; g.A = A; g.Bt = Bt; g.M = M; g.N = N; g.K = K; g.A2 = A2; g.Bt2 = Bt2;
    PairOrder S; S.init(M, N, (int)gridDim.x, (int)blockIdx.x);
    pg8::gemm_phase<EpiPair, PairOrder, false>((LAS unsigned char*)shm, g, S, E, nullptr);
}

__device__ __forceinline__ void phase_weights(const Params& p, unsigned char* shm) {
    float* tile = (float*)shm;
    const int tid = threadIdx.x;
    for (int job = blockIdx.x; job < 2880 + 768; job += gridDim.x) {
        const float* src; int ld, col0, nvalid, kt; us* dst;
        if (job < 2880) { const int nt = job >> 4; kt = job & 15; src = p.w_in; ld = DIN; const int n0 = nt * 64;
            if (n0 < 5120) { col0 = n0; nvalid = 64; } else if (n0 < 11264) { col0 = n0 + 16; nvalid = 64; } else if (n0 == 11264) { col0 = 5120; nvalid = 16; } else { col0 = 0; nvalid = 0; }
            dst = (us*)(p.ws + p.o_winT) + (size_t)n0 * 1024;
        } else { const int j2 = job - 2880, which = j2 >> 8, t = j2 & 255, nt = t >> 4; kt = t & 15; ld = 1024; col0 = nt * 64; nvalid = 64;
            src = which == 0 ? p.wda : (which == 1 ? p.wdb : p.wout);
            dst = (us*)(p.ws + (which == 0 ? p.o_wdaT : (which == 1 ? p.o_wdbT : p.o_woutT))) + (size_t)nt * 64 * 1024; }
        __syncthreads();
        { const int j = tid & 63, i0 = tid >> 6;
#pragma unroll
          for (int ii = 0; ii < 8; ++ii) { const int i = i0 + 8 * ii; tile[i * 65 + j] = (j < nvalid) ? src[(size_t)(kt * 64 + i) * ld + col0 + j] : 0.f; } }
        __syncthreads();
        { const int i = tid & 63, j0 = tid >> 6;
#pragma unroll
          for (int jj = 0; jj < 8; ++jj) { const int j = j0 + 8 * jj; dst[(size_t)j * 1024 + kt * 64 + i] = f2bf(tile[i * 65 + j]); } }
    }
    __syncthreads();
}

__device__ __forceinline__ void phase_xnorm(const Params& p, int T0, int Mc) {
    const int wave = threadIdx.x >> 6, lane = threadIdx.x & 63;
    us* xn = (us*)(p.ws + p.o_xn);
    f32x4 nw[4];
#pragma unroll
    for (int j = 0; j < 4; ++j) nw[j] = *(const f32x4*)(p.norm_w + lane * 4 + 256 * j);
    for (int r = blockIdx.x * 8 + wave; r < Mc; r += gridDim.x * 8) {
        const float* xr = xrow(p, T0 + r);
        f32x4 v[4]; float ss = 0.f;
#pragma unroll
        for (int j = 0; j < 4; ++j) { v[j] = *(const f32x4*)(xr + lane * 4 + 256 * j); ss += v[j][0] * v[j][0] + v[j][1] * v[j][1] + v[j][2] * v[j][2] + v[j][3] * v[j][3]; }
#pragma unroll
        for (int o = 32; o >= 1; o >>= 1) ss += __shfl_xor(ss, o);
        const float rs = rsqrtf(ss * (1.0f / 1024.0f) + 1e-6f);
#pragma unroll
        for (int j = 0; j < 4; ++j) { u32x2 w; w.x = pk2(v[j][0] * rs * nw[j][0], v[j][1] * rs * nw[j][1]); w.y = pk2(v[j][2] * rs * nw[j][2], v[j][3] * rs * nw[j][3]);
            *(u32x2*)(xn + (size_t)r * 1024 + lane * 4 + 256 * j) = w; }
    }
}

__device__ __forceinline__ void phase_fnorm(const Params& p, int T0, int Mc) {
    const int wave = threadIdx.x >> 6, lane = threadIdx.x & 63;
    f32x4 nw[4];
#pragma unroll
    for (int j = 0; j < 4; ++j) nw[j] = *(const f32x4*)(p.fnw + lane * 4 + 256 * j);
    for (int r = blockIdx.x * 8 + wave; r < Mc; r += gridDim.x * 8) {
        float* xr = p.out + (size_t)(T0 + r) * 1024;
        f32x4 v[4]; float ss = 0.f;
#pragma unroll
        for (int j = 0; j < 4; ++j) { v[j] = *(const f32x4*)(xr + lane * 4 + 256 * j); ss += v[j][0] * v[j][0] + v[j][1] * v[j][1] + v[j][2] * v[j][2] + v[j][3] * v[j][3]; }
#pragma unroll
        for (int o = 32; o >= 1; o >>= 1) ss += __shfl_xor(ss, o);
        const float rs = rsqrtf(ss * (1.0f / 1024.0f) + 1e-6f);
#pragma unroll
        for (int j = 0; j < 4; ++j) { f32x4 w; w[0] = v[j][0] * rs * nw[j][0]; w[1] = v[j][1] * rs * nw[j][1]; w[2] = v[j][2] * rs * nw[j][2]; w[3] = v[j][3] * rs * nw[j][3];
            *(f32x4*)(xr + lane * 4 + 256 * j) = w; }
    }
}

__device__ __forceinline__ void phase_gates(const Params& p, int Mc) {
    const int wave = threadIdx.x >> 6, lane = threadIdx.x & 63, fr = lane & 15, fq = lane >> 4;
    const us* xn = (const us*)(p.ws + p.o_xn);
    const us* wg = (const us*)(p.ws + p.o_winT) + (size_t)(11264 + fr) * 1024 + fq * 8;
    float* gates = (float*)(p.ws + p.o_gates);
    const float bias = p.b_gate[fr];
    for (int task = blockIdx.x * 8 + wave; task < Mc / 16; task += gridDim.x * 8) {
        const us* ar = xn + (size_t)(task * 16 + fr) * 1024 + fq * 8;
        f32x4 acc0 = (f32x4){0.f, 0.f, 0.f, 0.f}, acc1 = acc0;
#pragma unroll 8
        for (int kk = 0; kk < 32; kk += 2) {
            const bf16x8 a0 = *(const bf16x8*)(ar + kk * 32), a1 = *(const bf16x8*)(ar + kk * 32 + 32);
            const bf16x8 b0 = *(const bf16x8*)(wg + kk * 32), b1 = *(const bf16x8*)(wg + kk * 32 + 32);
            acc0 = mfma16(a0, b0, acc0); acc1 = mfma16(a1, b1, acc1);
        }
#pragma unroll
        for (int i = 0; i < 4; ++i) gates[(size_t)(task * 16 + 4 * fq + i) * 16 + fr] = acc0[i] + acc1[i] + bias;
    }
}

__device__ __forceinline__ void phase_conv(const Params& p, int T0, int Mc) {
    const int tid = threadIdx.x, ct = tid & 255, tensor = ct >> 7, cgp = ct & 127, sub = tid >> 8;
    const us* src = actp(p, tensor);
    us* dst = (us*)(p.out + (size_t)T0 * 1024) + (size_t)tensor * Mc * 1024;
    const int ch0 = tensor * 1024 + cgp * 8;
    float w[5][8], b[8];
#pragma unroll
    for (int e = 0; e < 8; ++e) { b[e] = p.conv_b[ch0 + e];
#pragma unroll
        for (int i = 0; i < 5; ++i) w[i][e] = p.conv_w[i * 2048 + ch0 + e]; }
    const float oscale = tensor ? 0.0625f : 1.0f;
    for (int item = blockIdx.x; item < Mc / 32; item += gridDim.x) {
        const int r0 = (item * 2 + sub) * 16;
        int s0, len; seq_of(T0 + r0, s0, len);
        const int lo = s0 - T0, hi = lo + len;
        u32x4 rows[20];
#pragma unroll
        for (int i = 0; i < 20; ++i) { const int r = r0 - 2 + i; rows[i] = (r >= lo && r < hi) ? *(const u32x4*)(src + (size_t)r * 1024 + cgp * 8) : (u32x4){0u, 0u, 0u, 0u}; }
#pragma unroll
        for (int o = 0; o < 16; ++o) {
            float a[8];
#pragma unroll
            for (int e = 0; e < 8; ++e) a[e] = b[e];
#pragma unroll
            for (int i = 0; i < 5; ++i) { const u32x4 rw = rows[o + i];
                a[0] += w[i][0] * bflo(rw.x); a[1] += w[i][1] * bfhi(rw.x); a[2] += w[i][2] * bflo(rw.y); a[3] += w[i][3] * bfhi(rw.y);
                a[4] += w[i][4] * bflo(rw.z); a[5] += w[i][5] * bfhi(rw.z); a[6] += w[i][6] * bflo(rw.w); a[7] += w[i][7] * bfhi(rw.w); }
#pragma unroll
            for (int e = 0; e < 8; ++e) a[e] = siluf_(a[e]) * oscale;
            u32x4 wv; wv.x = pk2(a[0], a[1]); wv.y = pk2(a[2], a[3]); wv.z = pk2(a[4], a[5]); wv.w = pk2(a[6], a[7]);
            *(u32x4*)(dst + (size_t)(r0 + o) * 1024 + cgp * 8) = wv;
        }
    }
}

__device__ __forceinline__ void phase_ya(const Params& p, int Mc) {
    const int wave = threadIdx.x >> 6, lane = threadIdx.x & 63;
    const us* hf = actp(p, 0); const us* hb = actp(p, 1); const us* mo = actp(p, 3); const us* mz = actp(p, 4);
    us* ya = actp(p, 0);
    float mw[16];
#pragma unroll
    for (int i = 0; i < 16; ++i) mw[i] = p.mh_w[lane * 16 + i];
    for (int r = blockIdx.x * 8 + wave; r < Mc; r += gridDim.x * 8) {
        const size_t o = (size_t)r * 1024 + lane * 16;
        float h[16]; float ss = 0.f;
        unsigned zz[8];
#pragma unroll
        for (int c = 0; c < 2; ++c) {
            const u32x4 a = *(const u32x4*)(hf + o + c * 8), b = *(const u32x4*)(hb + o + c * 8), g = *(const u32x4*)(mo + o + c * 8), z = *(const u32x4*)(mz + o + c * 8);
#pragma unroll
            for (int q = 0; q < 4; ++q) { const unsigned aw = a[q], bw = b[q], gw = g[q];
                h[c * 8 + 2 * q] = (bflo(aw) + bflo(bw)) * sigmoidf_(bflo(gw)); h[c * 8 + 2 * q + 1] = (bfhi(aw) + bfhi(bw)) * sigmoidf_(bfhi(gw)); zz[c * 4 + q] = z[q]; }
        }
#pragma unroll
        for (int i = 0; i < 16; ++i) ss += h[i] * h[i];
        ss += __shfl_xor(ss, 1); ss += __shfl_xor(ss, 2); ss += __shfl_xor(ss, 4); ss += __shfl_xor(ss, 8);
        const float rn = rsqrtf(ss * (1.0f / 256.0f) + 1e-6f);
        unsigned w[8];
#pragma unroll
        for (int q = 0; q < 8; ++q) w[q] = pk2(h[2 * q] * rn * mw[2 * q] * siluf_(bflo(zz[q])), h[2 * q + 1] * rn * mw[2 * q + 1] * siluf_(bfhi(zz[q])));
        *(u32x4*)(ya + o) = (u32x4){w[0], w[1], w[2], w[3]}; *(u32x4*)(ya + o + 8) = (u32x4){w[4], w[5], w[6], w[7]};
    }
}

constexpr int ST_REC = 16896;
template <bool STATE_ONLY>
__device__ __forceinline__ void mlstm_chain(const Params& p, unsigned char* shm, int T0, int Mc, int s0, int len, int head, int dir, int split, int c0, int c1,
                                            const float* st_in, int n_prev, float* st_out) {
    LAS unsigned char* lds = (LAS unsigned char*)shm;
    LAS float* sm = (LAS float*)(lds + L_SM);
    const int tid = threadIdx.x, w = tid >> 6, lane = tid & 63, fr = lane & 15, fq = lane >> 4;
    const us* qc = (const us*)(p.out + (size_t)T0 * 1024); const us* kc = qc + (size_t)Mc * 1024;
    const us* mv = actp(p, 2); const float* gates = (const float*)(p.ws + p.o_gates);
    us* hout = actp(p, dir);
    const int base = dir ? (s0 + len - 1 - T0) : (s0 - T0); const int sgn = dir ? -1 : 1;
    const size_t hoff = (size_t)head * 256;
    u32x4 rq[4], rk[4], rv;
    LAS float* GU = (LAS float*)(lds + L_GU); LAS float* GC = (LAS float*)(lds + L_GC); LAS float* GB = (LAS float*)(lds + L_GB); LAS float* GM = (LAS float*)(lds + L_GM); LAS unsigned char* NBF = lds + L_NP;
    f32x4 Sacc[2][5];
#pragma unroll
    for (int a = 0; a < 2; ++a)
#pragma unroll
        for (int b = 0; b < 5; ++b) Sacc[a][b] = (f32x4){0.f, 0.f, 0.f, 0.f};
    float mstate = 0.f;
    if constexpr (!STATE_ONLY) {
        float nval = 0.f;
        for (int g = 0; g < n_prev; ++g) { const float* rec = st_in + (size_t)g * ST_REC; const float m_loc = rec[16640], B = rec[16641];
            const float m_new = fmaxf(B + mstate, m_loc), a1 = __expf(B + mstate - m_new), a2 = __expf(m_loc - m_new);
#pragma unroll
            for (int dd = 0; dd < 2; ++dd)
#pragma unroll
                for (int e4 = 0; e4 < 4; ++e4) { const f32x4 sl = *(const f32x4*)(rec + (size_t)((((w * 2 + dd) * 4 + e4) * 64 + lane) * 4)); Sacc[dd][e4] = a1 * Sacc[dd][e4] + a2 * sl; }
            if (tid < 256) nval = a1 * nval + a2 * rec[16384 + tid];
            mstate = m_new; }
        if (tid < 256) sm[SM_N + tid] = nval;
        __syncthreads();
#pragma unroll
        for (int dd = 0; dd < 2; ++dd)
#pragma unroll
            for (int i = 0; i < 4; ++i) Sacc[dd][4][i] = (fr == 0) ? sm[SM_N + (w * 2 + dd) * 16 + 4 * fq + i] : 0.f;
        if (fr == 0) {
#pragma unroll
            for (int dd = 0; dd < 2; ++dd) { u32x2 nb; nb.x = pk2(Sacc[dd][4][0], Sacc[dd][4][1]); nb.y = pk2(Sacc[dd][4][2], Sacc[dd][4][3]); *(LAS u32x2*)(NBF + ((w * 2 + dd) * 16 + 4 * fq) * 2) = nb; }
        }
#pragma unroll
        for (int dd = 0; dd < 2; ++dd)
#pragma unroll
            for (int e4 = 0; e4 < 4; ++e4) { const f32x4 sv = Sacc[dd][e4]; u32x2 wv; wv.x = pk2(sv[0], sv[1]); wv.y = pk2(sv[2], sv[3]);
                *(LAS u32x2*)(lds + L_ST + (e4 * 16 + fr) * QS + ((w * 2 + dd) * 16 + 4 * fq) * 2) = wv; }
    } else {
        if (tid < 256) sm[SM_N + tid] = 0.f;
    }
#define CH_LOAD(c) do { \
        _Pragma("unroll") for (int i = 0; i < 4; ++i) { const int id = tid + 512 * i, row = id >> 5, ch = id & 31; const size_t lr = (size_t)(base + sgn * ((c) * 64 + row)); \
            if (!STATE_ONLY) rq[i] = *(const u32x4*)(qc + lr * 1024 + hoff + ch * 8); rk[i] = *(const u32x4*)(kc + lr * 1024 + hoff + ch * 8); } \
        { const int row = tid >> 3, ch = tid & 7; const size_t lr = (size_t)(base + sgn * ((c) * 64 + row)); rv = *(const u32x4*)(mv + lr * 1024 + hoff + split * 64 + ch * 8); } \
 } while (0)
#define CH_STORE() do { \
        _Pragma("unroll") for (int i = 0; i < 4; ++i) { const int id = tid + 512 * i, row = id >> 5, ch = id & 31; \
            if (!STATE_ONLY) *(LAS u32x4*)(lds + L_Q + row * QS + ch * 16) = rq[i]; *(LAS u32x4*)(lds + L_K + row * QS + ch * 16) = rk[i]; } \
        { const int row = tid >> 3, ch = tid & 7; *(LAS u32x4*)(lds + L_V + row * VS + ch * 16) = rv; } } while (0)
    CH_LOAD(c0);
    for (int cc = w; cc < c1 - c0; cc += 8) {
        const size_t lr = (size_t)(base + sgn * ((c0 + cc) * 64 + lane));
        const float li = gates[lr * 16 + dir * 8 + head], gfv = gates[lr * 16 + dir * 8 + 4 + head];
        const float lf = fminf(gfv, 0.f) - log1pf(__expf(-fabsf(gfv)));
        float b = lf;
#pragma unroll
        for (int o = 1; o < 64; o <<= 1) { const float t = __shfl_up(b, o); if (lane >= o) b += t; }
        const float u = li - b; float cm = u;
#pragma unroll
        for (int o = 1; o < 64; o <<= 1) { const float t = __shfl_up(cm, o); if (lane >= o) cm = fmaxf(cm, t); }
        GU[cc * 64 + lane] = u; GC[cc * 64 + lane] = cm; GB[cc * 64 + lane] = b;
    }
    CH_STORE();
    __syncthreads();
    if (tid == 0) { float m = mstate, bt = 0.f;
        for (int cc = 0; cc < c1 - c0; ++cc) { GM[cc] = m; const float M63 = fmaxf(m, GC[cc * 64 + 63]), b63 = GB[cc * 64 + 63]; m = b63 + M63; bt += b63; }
        GM[32] = m; GM[33] = bt; }
    const int tA = w & 3, jt0 = (w >> 2) * 2;
    for (int c = c0; c < c1; ++c) {
        if (c + 1 < c1) CH_LOAD(c + 1);
        __syncthreads();
        const int cg_ = (c - c0) * 64; const float m_c = GM[c - c0]; const float M63 = fmaxf(m_c, GC[cg_ + 63]);
        f32x4 h0 = (f32x4){0.f, 0.f, 0.f, 0.f}, h1 = h0, qn0 = h0, qn1 = h0;
        if constexpr (!STATE_ONLY) {
            f32x4 sc0 = (f32x4){0.f, 0.f, 0.f, 0.f}, sc1 = sc0;
#pragma unroll 4
            for (int kk = 0; kk < 8; ++kk) {
                const bf16x8 a = *(LAS bf16x8*)(lds + L_K + (tA * 16 + fr) * QS + kk * 64 + fq * 16);
                const bf16x8 a2 = *(LAS bf16x8*)(lds + L_ST + (tA * 16 + fr) * QS + kk * 64 + fq * 16);
                const bf16x8 b0 = *(LAS bf16x8*)(lds + L_Q + (jt0 * 16 + fr) * QS + kk * 64 + fq * 16);
                const bf16x8 b1 = *(LAS bf16x8*)(lds + L_Q + ((jt0 + 1) * 16 + fr) * QS + kk * 64 + fq * 16);
                sc0 = mfma16(a, b0, sc0); sc1 = mfma16(a, b1, sc1);
                h0 = mfma16(a2, b0, h0); h1 = mfma16(a2, b1, h1);
                const bf16x8 nf = *(LAS bf16x8*)(NBF + kk * 64 + fq * 16);
                qn0 = mfma16(nf, b0, qn0); qn1 = mfma16(nf, b1, qn1);
            }
            const int sb = tA * 16 + 4 * fq;
            const f32x4 uv = *(LAS f32x4*)(GU + cg_ + sb);
#pragma unroll
            for (int jt = 0; jt < 2; ++jt) { const int j = (jt0 + jt) * 16 + fr; const float Mj = fmaxf(m_c, GC[cg_ + j]); const f32x4 sc = jt ? sc1 : sc0;
                float v[4];
#pragma unroll
                for (int i = 0; i < 4; ++i) v[i] = (sb + i <= j) ? sc[i] * __expf(uv[i] - Mj) : 0.f;
                u32x2 wv; wv.x = pk2(v[0], v[1]); wv.y = pk2(v[2], v[3]);
                *(LAS u32x2*)(lds + L_P + j * VS + sb * 2) = wv;
                }
        }
        {
            const int s = tid >> 3, ch = tid & 7; const float ws_ = __expf(GU[cg_ + s] - M63); const u32x4 vv = *(LAS u32x4*)(lds + L_V + s * VS + ch * 16);
            u32x4 o; o.x = pk2(bflo(vv.x) * ws_, bfhi(vv.x) * ws_); o.y = pk2(bflo(vv.y) * ws_, bfhi(vv.y) * ws_); o.z = pk2(bflo(vv.z) * ws_, bfhi(vv.z) * ws_); o.w = pk2(bflo(vv.w) * ws_, bfhi(vv.w) * ws_);
            *(LAS u32x4*)(lds + L_VW + s * VSW + ch * 16) = o;
            if (ch == 0) { *(LAS u32x4*)(lds + L_VW + s * VSW + 128) = (u32x4){pk2(ws_, 0.f), 0u, 0u, 0u}; *(LAS u32x4*)(lds + L_VW + s * VSW + 144) = (u32x4){0u, 0u, 0u, 0u}; }
        }
        __syncthreads();
        if constexpr (!STATE_ONLY) {
            const int j0 = jt0 * 16 + fr, j1 = j0 + 16;
            const float Mj0 = fmaxf(m_c, GC[cg_ + j0]), Mj1 = fmaxf(m_c, GC[cg_ + j1]);
            const float wi0 = __expf(m_c - Mj0), wi1 = __expf(m_c - Mj1);
            h0 *= wi0; h1 *= wi1;
            f32x4 rs0 = (f32x4){0.f, 0.f, 0.f, 0.f}, rs1 = rs0;
            const bf16x8 ones = (bf16x8){(short)0x3F80, (short)0x3F80, (short)0x3F80, (short)0x3F80, (short)0x3F80, (short)0x3F80, (short)0x3F80, (short)0x3F80};
#pragma unroll
            for (int ks = 0; ks < 2; ++ks) {
                const int o0 = (ks * 32 + 8 * fq + (fr >> 2)) * VS + (tA * 16 + 4 * (fr & 3)) * 2;
                const bf16x8 a = tr8(lds + L_V, o0, o0 + 4 * VS);
                const bf16x8 b0 = *(LAS bf16x8*)(lds + L_P + j0 * VS + ks * 64 + fq * 16);
                const bf16x8 b1 = *(LAS bf16x8*)(lds + L_P + j1 * VS + ks * 64 + fq * 16);
                h0 = mfma16(a, b0, h0); h1 = mfma16(a, b1, h1);
                rs0 = mfma16(ones, b0, rs0); rs1 = mfma16(ones, b1, rs1);
            }
            const float den0 = wi0 * qn0[0] + rs0[0], den1 = wi1 * qn1[0] + rs1[0];
            const float sc0 = __builtin_amdgcn_rcpf(fmaxf(fabsf(den0), __expf(-GB[cg_ + j0] - Mj0))), sc1 = __builtin_amdgcn_rcpf(fmaxf(fabsf(den1), __expf(-GB[cg_ + j1] - Mj1)));
            h0 *= sc0; h1 *= sc1;
            const size_t lr0 = (size_t)(base + sgn * (c * 64 + j0)), lr1 = (size_t)(base + sgn * (c * 64 + j1));
            const int eo = split * 64 + tA * 16 + 4 * fq;
            u32x2 w0, w1; w0.x = pk2(h0[0], h0[1]); w0.y = pk2(h0[2], h0[3]); w1.x = pk2(h1[0], h1[1]); w1.y = pk2(h1[2], h1[3]);
            *(u32x2*)(hout + lr0 * 1024 + hoff + eo) = w0; *(u32x2*)(hout + lr1 * 1024 + hoff + eo) = w1;
        }
        {
            const float a_ = __expf(m_c - M63);
#pragma unroll
            for (int dd = 0; dd < 2; ++dd)
#pragma unroll
                for (int e4 = 0; e4 < 5; ++e4) Sacc[dd][e4] *= a_;
#pragma unroll 1
            for (int ks = 0; ks < 2; ++ks) {
                const int rbase = ks * 32 + 8 * fq + (fr >> 2);
                bf16x8 A[2], B[5];
#pragma unroll
                for (int dd = 0; dd < 2; ++dd) { const int o0 = rbase * QS + ((w * 2 + dd) * 16 + 4 * (fr & 3)) * 2; A[dd] = tr8(lds + L_K, o0, o0 + 4 * QS); }
#pragma unroll
                for (int e4 = 0; e4 < 5; ++e4) { const int o0 = rbase * VSW + (e4 * 16 + 4 * (fr & 3)) * 2; B[e4] = tr8(lds + L_VW, o0, o0 + 4 * VSW); }
#pragma unroll
                for (int dd = 0; dd < 2; ++dd)
#pragma unroll
                    for (int e4 = 0; e4 < 5; ++e4) Sacc[dd][e4] = mfma16(A[dd], B[e4], Sacc[dd][e4]);
            }
            if constexpr (!STATE_ONLY) {
#pragma unroll
                for (int dd = 0; dd < 2; ++dd)
#pragma unroll
                    for (int e4 = 0; e4 < 4; ++e4) { const f32x4 sv = Sacc[dd][e4]; u32x2 wv; wv.x = pk2(sv[0], sv[1]); wv.y = pk2(sv[2], sv[3]);
                        *(LAS u32x2*)(lds + L_ST + (e4 * 16 + fr) * QS + ((w * 2 + dd) * 16 + 4 * fq) * 2) = wv; }
            }
            if (fr == 0) {
#pragma unroll
                for (int dd = 0; dd < 2; ++dd) { *(LAS f32x4*)(sm + SM_N + (w * 2 + dd) * 16 + 4 * fq) = Sacc[dd][4];
                    if (!STATE_ONLY) { u32x2 nb; nb.x = pk2(Sacc[dd][4][0], Sacc[dd][4][1]); nb.y = pk2(Sacc[dd][4][2], Sacc[dd][4][3]); *(LAS u32x2*)(NBF + ((w * 2 + dd) * 16 + 4 * fq) * 2) = nb; } }
            }
        }
        __syncthreads();
        if (c + 1 < c1) { CH_STORE(); }
    }
#undef CH_LOAD
#undef CH_STORE
    if constexpr (STATE_ONLY) {
#pragma unroll
        for (int dd = 0; dd < 2; ++dd)
#pragma unroll
            for (int e4 = 0; e4 < 4; ++e4) *(f32x4*)(st_out + (size_t)((((w * 2 + dd) * 4 + e4) * 64 + lane) * 4)) = Sacc[dd][e4];
        if (tid < 256) st_out[16384 + tid] = sm[SM_N + tid];
        if (tid == 0) { st_out[16640] = GM[32]; st_out[16641] = GM[33]; }
    }
}

__device__ __forceinline__ void na_item(const Params& p, unsigned char* shm, int T0, int gpair, int head) {
    LAS unsigned char* lds = (LAS unsigned char*)shm;
    LAS float* rpbs = (LAS float*)(lds + L_RPB);
    constexpr int VOFF = 73728;
    const int tid = threadIdx.x, w = tid >> 6, lane = tid & 63, fr = lane & 15, fq = lane >> 4;
    const int n = w & 3, rr = w >> 2;
    const us* nq = actp(p, 5); const us* nk = actp(p, 6); const us* nv = actp(p, 7); const us* nz = actp(p, 8);
    us* yb = (us*)(p.ws + p.o_xn);
    const size_t hstr = (size_t)p.Mr * 64;
    const int tokA = T0 + gpair * 128; int s0, len; seq_of(tokA, s0, len);
    const int rows = len / 64, r0 = (tokA - s0) / 64, r = r0 + rr;
    const int rsb = min(max(r0 - 4, 0), rows - 8), rs1 = min(max(r0 - 3, 0), rows - 8);
    const int rs = rr ? rs1 : rsb;
    const int nkeys = (rs1 + 8 - rsb) * 64;
    const int wl0 = s0 + rsb * 64 - T0;
    const int kb = min(max(16 * n - 8, 0), 32);
    const size_t lrq = (size_t)(tokA - T0 + rr * 64 + 16 * n + fr);
    u32x4 kreg[9], vreg[9];
#pragma unroll
    for (int i = 0; i < 9; ++i) { const int id = tid + 512 * i, key = id >> 3, ch = id & 7;
        if (key < nkeys) { kreg[i] = *(const u32x4*)(nk + (size_t)head * hstr + (size_t)(wl0 + key) * 64 + ch * 8); vreg[i] = *(const u32x4*)(nv + (size_t)head * hstr + (size_t)(wl0 + key) * 64 + ch * 8); } }
    bf16x8 qf[2];
#pragma unroll
    for (int ks = 0; ks < 2; ++ks) qf[ks] = *(const bf16x8*)(nq + head * hstr + lrq * 64 + ks * 32 + fq * 8);
    float rp0 = 0.f;
    if (tid < 465) rp0 = p.rpb[head * 465 + tid] * 1.44269504f;
#pragma unroll
    for (int i = 0; i < 9; ++i) { const int id = tid + 512 * i, key = id >> 3, ch = id & 7;
        if (key < nkeys) { const int o = key * 128 + ((ch ^ (key & 7)) * 16); *(LAS u32x4*)(lds + o) = kreg[i]; *(LAS u32x4*)(lds + VOFF + o) = vreg[i]; } }
    if (tid < 465) rpbs[tid] = rp0;
    __syncthreads();
    u32x2 zreg[4];
#pragma unroll
    for (int dt = 0; dt < 4; ++dt) zreg[dt] = *(const u32x2*)(nz + lrq * 1024 + head * 64 + dt * 16 + 4 * fq);
    f32x4 s[16];
    const int krow0 = (rs - rsb) * 64 + kb + fr;
#pragma unroll
    for (int t = 0; t < 16; ++t) { s[t] = (f32x4){0.f, 0.f, 0.f, 0.f};
        const int key = krow0 + (t >> 1) * 64 + 16 * (t & 1);
#pragma unroll
        for (int ks = 0; ks < 2; ++ks) { const bf16x8 kf = *(LAS bf16x8*)(lds + key * 128 + (((ks * 4 + fq) ^ (key & 7)) * 16)); s[t] = mfma16(kf, qf[ks], s[t]); } }
    const int c = 16 * n + fr, cs = min(max(c - 8, 0), 48);
    bool vf[2][4];
#pragma unroll
    for (int hf2 = 0; hf2 < 2; ++hf2)
#pragma unroll
        for (int i = 0; i < 4; ++i) vf[hf2][i] = (unsigned)(kb + 16 * hf2 + 4 * fq + i - cs) < 16u;
    LAS float* bp = rpbs + ((rs - r + 7) * 31 + (kb - 16 * n + 4 * fq - fr + 15));
    float mx = -1e30f;
#pragma unroll
    for (int t = 0; t < 16; ++t)
#pragma unroll
        for (int i = 0; i < 4; ++i) { const float v = vf[t & 1][i] ? s[t][i] * 0.18033688f + bp[(t >> 1) * 31 + 16 * (t & 1) + i] : -1e30f; s[t][i] = v; mx = fmaxf(mx, v); }
    mx = fmaxf(mx, __shfl_xor(mx, 16)); mx = fmaxf(mx, __shfl_xor(mx, 32));
    float sum = 0.f;
#pragma unroll
    for (int t = 0; t < 16; ++t)
#pragma unroll
        for (int i = 0; i < 4; ++i) { const float e = __builtin_amdgcn_exp2f(s[t][i] - mx); s[t][i] = e; sum += e; }
    sum += __shfl_xor(sum, 16); sum += __shfl_xor(sum, 32);
    f32x4 o[4];
#pragma unroll
    for (int dt = 0; dt < 4; ++dt) o[dt] = (f32x4){0.f, 0.f, 0.f, 0.f};
    const int vrow0 = (rs - rsb) * 64 + kb + 4 * fq + (fr >> 2), pch = (fr & 3) >> 1, phalf = (fr & 3) & 1;
#pragma unroll
    for (int kk = 0; kk < 8; ++kk) {
        u32x4 pw; pw.x = pk2(s[2 * kk][0], s[2 * kk][1]); pw.y = pk2(s[2 * kk][2], s[2 * kk][3]); pw.z = pk2(s[2 * kk + 1][0], s[2 * kk + 1][1]); pw.w = pk2(s[2 * kk + 1][2], s[2 * kk + 1][3]);
        const bf16x8 pf = __builtin_bit_cast(bf16x8, pw);
        const int k0 = vrow0 + kk * 64, k1 = k0 + 16;
#pragma unroll
        for (int dt = 0; dt < 4; ++dt) { const int chunk = 2 * dt + pch;
            const bf16x8 a = tr8(lds + VOFF, k0 * 128 + ((chunk ^ (k0 & 7)) * 16) + phalf * 8, k1 * 128 + ((chunk ^ (k1 & 7)) * 16) + phalf * 8); o[dt] = mfma16(a, pf, o[dt]); }
    }
    const float inv = __builtin_amdgcn_rcpf(sum);
#pragma unroll
    for (int dt = 0; dt < 4; ++dt) { const size_t off = lrq * 1024 + head * 64 + dt * 16 + 4 * fq; const u32x2 z = zreg[dt];
        u32x2 wv; wv.x = pk2(o[dt][0] * inv * siluf_(bflo(z.x)), o[dt][1] * inv * siluf_(bfhi(z.x))); wv.y = pk2(o[dt][2] * inv * siluf_(bflo(z.y)), o[dt][3] * inv * siluf_(bfhi(z.y)));
        *(u32x2*)(yb + off) = wv; }
}

struct NaGeom { int s0, rows, r0, rsb, rs1; };
__device__ __forceinline__ NaGeom na_geom(int T0, int gpair) {
    NaGeom g; const int tokA = T0 + gpair * 128; int len; seq_of(tokA, g.s0, len);
    g.rows = len / 64; g.r0 = (tokA - g.s0) / 64;
    g.rsb = min(max(g.r0 - 4, 0), g.rows - 8); g.rs1 = min(max(g.r0 - 3, 0), g.rows - 8); return g;
}
__device__ __forceinline__ void na_band(const Params& p, unsigned char* shm, int T0, int Mc) {
    LAS unsigned char* lds = (LAS unsigned char*)shm;
    LAS float* rpbs = (LAS float*)(lds + L_RPB);
    constexpr int VOFF = 73728;
    const int tid = threadIdx.x, w = tid >> 6, lane = tid & 63, fr = lane & 15, fq = lane >> 4;
    const int n = w & 3, rr = w >> 2;
    const int head = blockIdx.x & 15, band = blockIdx.x >> 4, ppb = (Mc / 128) / 16;
    const us* nq = actp(p, 5) + (size_t)head * p.Mr * 64; const us* nk = actp(p, 6) + (size_t)head * p.Mr * 64; const us* nv = actp(p, 7) + (size_t)head * p.Mr * 64;
    const us* nz = actp(p, 8); us* yb = (us*)(p.ws + p.o_xn);
    const int kb = min(max(16 * n - 8, 0), 32);
    const int c = 16 * n + fr, cs = min(max(c - 8, 0), 48);
    const int ccol = tid >> 3, cch = tid & 7;
    const int cswz = (ccol * 128) + ((cch ^ (ccol & 7)) * 16);
    if (tid < 465) rpbs[tid] = p.rpb[head * 465 + tid] * 1.44269504f;
    bool vf[2][4];
#pragma unroll
    for (int hf2 = 0; hf2 < 2; ++hf2)
#pragma unroll
        for (int i = 0; i < 4; ++i) vf[hf2][i] = (unsigned)(kb + 16 * hf2 + 4 * fq + i - cs) < 16u;
    u32x4 kpf[2], vpf[2]; bf16x8 qfn[2];
    int prev_hi = 0, prev_s0 = -1;
    {
        const int gp0 = band * ppb; const size_t lq = (size_t)(gp0 * 128 + rr * 64 + 16 * n + fr);
#pragma unroll
        for (int ks = 0; ks < 2; ++ks) qfn[ks] = *(const bf16x8*)(nq + lq * 64 + ks * 32 + fq * 8);
    }
    for (int k = 0; k < ppb; ++k) {
        const int gpair = band * ppb + k; const NaGeom g = na_geom(T0, gpair);
        const int hi = g.rs1 + 8; const bool fresh = (g.s0 != prev_s0);
        const int r = g.r0 + rr, rs = rr ? g.rs1 : g.rsb;
        const size_t lrq = (size_t)(gpair * 128 + rr * 64 + 16 * n + fr);
        const size_t rowbase = (size_t)(g.s0 - T0) * 64 + (size_t)ccol * 64 + cch * 8;
        __syncthreads();
        if (fresh) {
            u32x4 kreg[9], vreg[9];
#pragma unroll
            for (int i = 0; i < 9; ++i) { const int R = g.rsb + i; if (R < hi) { kreg[i] = *(const u32x4*)(nk + rowbase + (size_t)R * 4096); vreg[i] = *(const u32x4*)(nv + rowbase + (size_t)R * 4096); } }
#pragma unroll
            for (int i = 0; i < 9; ++i) { const int R = g.rsb + i; if (R < hi) { const int o = (R % 9) * 8192 + cswz; *(LAS u32x4*)(lds + o) = kreg[i]; *(LAS u32x4*)(lds + VOFF + o) = vreg[i]; } }
        } else {
#pragma unroll
            for (int i = 0; i < 2; ++i) { const int R = prev_hi + i; if (R < hi) { const int o = (R % 9) * 8192 + cswz; *(LAS u32x4*)(lds + o) = kpf[i]; *(LAS u32x4*)(lds + VOFF + o) = vpf[i]; } }
        }
        const bf16x8 qf0 = qfn[0], qf1 = qfn[1];
        __syncthreads();
        u32x2 zreg[4];
#pragma unroll
        for (int dt = 0; dt < 4; ++dt) zreg[dt] = *(const u32x2*)(nz + lrq * 1024 + head * 64 + dt * 16 + 4 * fq);
        if (k + 1 < ppb) {
            const NaGeom g2 = na_geom(T0, gpair + 1); const int hi2 = g2.rs1 + 8;
            if (g2.s0 == g.s0) {
#pragma unroll
                for (int i = 0; i < 2; ++i) { const int R = hi + i; if (R < hi2) { kpf[i] = *(const u32x4*)(nk + rowbase + (size_t)R * 4096); vpf[i] = *(const u32x4*)(nv + rowbase + (size_t)R * 4096); } }
            }
            const size_t lq = (size_t)((gpair + 1) * 128 + rr * 64 + 16 * n + fr);
#pragma unroll
            for (int ks = 0; ks < 2; ++ks) qfn[ks] = *(const bf16x8*)(nq + lq * 64 + ks * 32 + fq * 8);
        }
        prev_hi = hi; prev_s0 = g.s0;
        int slot[8];
#pragma unroll
        for (int i = 0; i < 8; ++i) slot[i] = (rs + i) % 9;
        f32x4 s[16];
#pragma unroll
        for (int t = 0; t < 16; ++t) { s[t] = (f32x4){0.f, 0.f, 0.f, 0.f};
            const int key = slot[t >> 1] * 64 + kb + 16 * (t & 1) + fr;
            const bf16x8 kf0 = *(LAS bf16x8*)(lds + key * 128 + (((0 + fq) ^ (key & 7)) * 16)), kf1 = *(LAS bf16x8*)(lds + key * 128 + (((4 + fq) ^ (key & 7)) * 16));
            s[t] = mfma16(kf0, qf0, s[t]); s[t] = mfma16(kf1, qf1, s[t]); }
        LAS float* bp = rpbs + ((rs - r + 7) * 31 + (kb - 16 * n + 4 * fq - fr + 15));
        float mx = -1e30f;
#pragma unroll
        for (int t = 0; t < 16; ++t)
#pragma unroll
            for (int i = 0; i < 4; ++i) { const float v = vf[t & 1][i] ? s[t][i] * 0.18033688f + bp[(t >> 1) * 31 + 16 * (t & 1) + i] : -1e30f; s[t][i] = v; mx = fmaxf(mx, v); }
        mx = fmaxf(mx, __shfl_xor(mx, 16)); mx = fmaxf(mx, __shfl_xor(mx, 32));
        float sum = 0.f;
#pragma unroll
        for (int t = 0; t < 16; ++t)
#pragma unroll
            for (int i = 0; i < 4; ++i) { const float e = __builtin_amdgcn_exp2f(s[t][i] - mx); s[t][i] = e; sum += e; }
        sum += __shfl_xor(sum, 16); sum += __shfl_xor(sum, 32);
        f32x4 o[4];
#pragma unroll
        for (int dt = 0; dt < 4; ++dt) o[dt] = (f32x4){0.f, 0.f, 0.f, 0.f};
        const int vcol0 = kb + 4 * fq + (fr >> 2), pch = (fr & 3) >> 1, phalf = (fr & 3) & 1;
#pragma unroll
        for (int kk = 0; kk < 8; ++kk) {
            u32x4 pw; pw.x = pk2(s[2 * kk][0], s[2 * kk][1]); pw.y = pk2(s[2 * kk][2], s[2 * kk][3]); pw.z = pk2(s[2 * kk + 1][0], s[2 * kk + 1][1]); pw.w = pk2(s[2 * kk + 1][2], s[2 * kk + 1][3]);
            const bf16x8 pf = __builtin_bit_cast(bf16x8, pw);
            const int k0 = slot[kk] * 64 + vcol0, k1 = k0 + 16;
#pragma unroll
            for (int dt = 0; dt < 4; ++dt) { const int chunk = 2 * dt + pch;
                const bf16x8 a = tr8(lds + VOFF, k0 * 128 + ((chunk ^ (k0 & 7)) * 16) + phalf * 8, k1 * 128 + ((chunk ^ (k1 & 7)) * 16) + phalf * 8); o[dt] = mfma16(a, pf, o[dt]); }
        }
        const float inv = __builtin_amdgcn_rcpf(sum);
#pragma unroll
        for (int dt = 0; dt < 4; ++dt) { const size_t off = lrq * 1024 + head * 64 + dt * 16 + 4 * fq; const u32x2 z = zreg[dt];
            u32x2 wv; wv.x = pk2(o[dt][0] * inv * siluf_(bflo(z.x)), o[dt][1] * inv * siluf_(bfhi(z.x))); wv.y = pk2(o[dt][2] * inv * siluf_(bflo(z.y)), o[dt][3] * inv * siluf_(bfhi(z.y)));
            *(u32x2*)(yb + off) = wv; }
    }
}

__device__ __forceinline__ void phase_mix(const Params& p, unsigned char* shm, int T0, int Mc, int cidx, int flags) {
    float* state = (float*)(p.ws + p.o_state);
    const int n_pre = (flags & 1) ? 7 * 32 : 0;
    const int n_chain = (flags & 2) ? (Mc / UNIT) * 32 : 0;
    const int n_na = (flags & 4) ? (Mc / 128) * 16 : 0;
    for (int item = blockIdx.x; item < n_pre; item += gridDim.x) { __syncthreads();
        const int g = item >> 5, combo = item & 31;
        mlstm_chain<true>(p, shm, T0, Mc, 0, TOK_P, combo & 3, (combo >> 2) & 1, combo >> 3, 32 * g, 32 * g + 32, nullptr, 0, state + (size_t)(combo * 8 + g) * ST_REC); }
    for (int item = blockIdx.x; item < n_chain; item += gridDim.x) { __syncthreads();
        const int si = item >> 5, combo = item & 31;
        if (T0 == 0 && si < 8) mlstm_chain<false>(p, shm, T0, Mc, 0, TOK_P, combo & 3, (combo >> 2) & 1, combo >> 3, 32 * si, 32 * si + 32, state + (size_t)(combo * 8) * ST_REC, si, nullptr);
        else mlstm_chain<false>(p, shm, T0, Mc, T0 + si * UNIT, UNIT, combo & 3, (combo >> 2) & 1, combo >> 3, 0, 32, nullptr, 0, nullptr); }
    if (n_na) { __syncthreads();
        if (gridDim.x == 256) na_band(p, shm, T0, Mc);
        else for (int idx = blockIdx.x; idx < n_na; idx += gridDim.x) { __syncthreads(); na_item(p, shm, T0, idx >> 4, idx & 15); } }
    __syncthreads();
}

#define XB_TMO      128
#define XB_XCNT(j)  (256  + 64 * (j))
#define XB_XSUB(j)  (1280 + 64 * (j))
#define XB_XGEN(j)  (2304 + 64 * (j))
#define XB_TOP      3328
#define XB_TOPGEN   3392
#define XCD_BAR_WORDS 3456
#define XB_SPIN_CAP (1u << 18)
#define XB_TOP      3328
#define XB_TOPGEN   3392
#define XCD_BAR_WORDS 3456
#define XB_SPIN_CAP (1u << 18)

__device__ __forceinline__ unsigned xb_ld(unsigned* p)              { return __hip_atomic_load(p, __ATOMIC_RELAXED, __HIP_MEMORY_SCOPE_AGENT); }
__device__ __forceinline__ unsigned xb_add(unsigned* p, unsigned v) { return __hip_atomic_fetch_add(p, v, __ATOMIC_RELAXED, __HIP_MEMORY_SCOPE_AGENT); }
__device__ __forceinline__ unsigned xb_xcc_id() { return (unsigned)__builtin_amdgcn_s_getreg((3 << 11) | 20) & 0xFu; }
#define XB_SPIN(cond, bar) do { unsigned _sp = 0; while (cond) { __builtin_amdgcn_s_sleep(1); \
    if ((++_sp & 255u) == 0u) { if (xb_ld(&(bar)[XB_TMO])) break; if (_sp > XB_SPIN_CAP) { atomicAdd(&(bar)[XB_TMO], 1u); break; } } } } while (0)

struct XcdBarrier {
    unsigned* bar; unsigned x;
    volatile LAS unsigned* st;
};

__device__ __forceinline__ XcdBarrier xcd_barrier_post(unsigned* bar, volatile LAS unsigned* st) {
    XcdBarrier b; b.bar = bar; b.x = xb_xcc_id(); b.st = st;
    if (threadIdx.x == 0) (void)xb_add(&bar[XB_XCNT(b.x)], 1u);
    return b;
}
__device__ __forceinline__ void xcd_barrier_complete(unsigned* bar, unsigned x, unsigned& nloc, unsigned& nx) {
    const unsigned G = gridDim.x * gridDim.y * gridDim.z;
    unsigned sum, cnt, mine, sp = 0u;
    for (;;) {
        sum = 0u; cnt = 0u; mine = 0u;
#pragma unroll
        for (unsigned j = 0; j < 16; ++j) { const unsigned c = xb_ld(&bar[XB_XCNT(j)]); sum += c; cnt += (c > 0u) ? 1u : 0u; mine = (j == x) ? c : mine; }
        if (sum == G) break;
        __builtin_amdgcn_s_sleep(1);
        if ((++sp & 255u) == 0u) { if (xb_ld(&bar[XB_TMO])) break; if (sp > XB_SPIN_CAP) { atomicAdd(&bar[XB_TMO], 1u); break; } }
    }
    nloc = mine > 0u ? mine : 1u; nx = cnt > 0u ? cnt : 1u;
}

__device__ __forceinline__ void xcd_barrier(const XcdBarrier& b) {
    asm volatile("s_waitcnt vmcnt(0)" ::: "memory");
    __syncthreads();
    if (threadIdx.x == 0) {
        unsigned* bar = b.bar;
        __builtin_amdgcn_s_waitcnt(0);
        unsigned nloc = b.st[0], nx = b.st[1];
        if (nloc == 0u) { xcd_barrier_complete(bar, b.x, nloc, nx); b.st[0] = nloc; b.st[1] = nx; }
        const unsigned old = xb_add(&bar[XB_XSUB(b.x)], 1u);
        const unsigned gen = old / nloc;
        if (old + 1u == (gen + 1u) * nloc) {
            __builtin_amdgcn_fence(__ATOMIC_RELEASE, "agent");
            asm volatile("s_waitcnt vmcnt(0)" ::: "memory");
            const unsigned og = xb_add(&bar[XB_TOP], 1u);
            const unsigned tg = og / nx;
            if (og + 1u == (tg + 1u) * nx) xb_add(&bar[XB_TOPGEN], 1u);
            else XB_SPIN(xb_ld(&bar[XB_TOPGEN]) == tg, bar);
            __builtin_amdgcn_fence(__ATOMIC_ACQUIRE, "agent");
            xb_add(&bar[XB_XGEN(b.x)], 1u);
            asm volatile("s_waitcnt vmcnt(0)" ::: "memory");
        } else {
            XB_SPIN(xb_ld(&bar[XB_XGEN(b.x)]) == gen, bar);
            __builtin_amdgcn_fence(__ATOMIC_ACQUIRE, "agent");
            asm volatile("s_waitcnt vmcnt(0)" ::: "memory");
        }
    }
    __syncthreads();
}

#ifndef PHM
#define PHM 0xFFF
#endif
#define IN(k) (lo <= (k) && (k) < hi)
#define INB(b, k) (((PHM >> (b)) & 1) && IN(k))
#define SEAM(k) do { if (IN(k) && IN((k) + 1)) xcd_barrier(bar); } while (0)
__device__ __forceinline__ void round_body(const Params& p, unsigned char* shm, const XcdBarrier& bar, const int round, const int lo, const int hi) {
    const int T0 = round * p.Mr, pb = 1 + 8 * round;
    const int Mc = (TOK_ALL - T0) < p.Mr ? (TOK_ALL - T0) : p.Mr;
    if (INB(1, pb)) { EpiIn E; E.act = actp(p, 0); E.split_stride = (size_t)p.Mr * 1024; E.gates = (float*)(p.ws + p.o_gates); E.b_gate = p.b_gate;
        run_gemm(shm, (const us*)(p.ws + p.o_xn), (const us*)(p.ws + p.o_winT), Mc, 11264, 1024, E); }
    SEAM(pb);
    if (INB(2, pb + 1)) { phase_gates(p, Mc); phase_conv(p, T0, Mc); }
    SEAM(pb + 1);
    if (round == 0) {
        if (INB(3, pb + 2)) phase_mix(p, shm, T0, Mc, 0, 1 | 4);
        SEAM(pb + 2);
        if (INB(4, pb + 3)) phase_mix(p, shm, T0, Mc, 1, 2);
    } else {
        if (INB(4, pb + 3)) phase_mix(p, shm, T0, Mc, 1 + round, 2 | 4);
    }
    SEAM(pb + 3);
    if (INB(5, pb + 4)) phase_ya(p, Mc);
    SEAM(pb + 4);
    if (INB(6, pb + 5)) {
        EpiPair E; E.ga = actp(p, 9); E.gb = actp(p, 10); E.merged = actp(p, 1);
        run_gemm_pair(shm, actp(p, 0), (const us*)(p.ws + p.o_wdaT), (const us*)(p.ws + p.o_xn), (const us*)(p.ws + p.o_wdbT), Mc, 1024, 1024, E);
    }
    SEAM(pb + 5);
    if (INB(7, pb + 6)) { EpiOut E; E.out = p.out + (size_t)T0 * 1024; E.xp = p.xp; E.xs = p.xs; E.T0 = T0; run_gemm(shm, actp(p, 1), (const us*)(p.ws + p.o_woutT), Mc, 1024, 1024, E); }
    SEAM(pb + 6);
    if (INB(8, pb + 7)) { phase_fnorm(p, T0, Mc); if (T0 + Mc < TOK_ALL) phase_xnorm(p, T0 + Mc, (TOK_ALL - T0 - Mc) < p.Mr ? (TOK_ALL - T0 - Mc) : p.Mr); }
    if (T0 + Mc < TOK_ALL) SEAM(pb + 7);
}
__global__ __launch_bounds__(512, 2) void mega(Params p) {
    extern __shared__ __attribute__((aligned(16))) unsigned char shm[];
    cg::grid_group grid = cg::this_grid();
    const int lo = p.ph_lo, hi = p.ph_hi;
    volatile LAS unsigned* bst = (volatile LAS unsigned*)((LAS unsigned char*)shm + (LDS_BYTES - 32));
    if (threadIdx.x == 0) { bst[0] = 0u; bst[1] = 0u; }
    __syncthreads();
    const XcdBarrier bar = xcd_barrier_post((unsigned*)(p.ws + p.o_bar), bst);
    if (INB(0, 0)) { phase_weights(p, shm); phase_xnorm(p, 0, p.Mr); }
    if (IN(0) && IN(1)) grid.sync();
    round_body(p, shm, bar, 0, lo, hi);
    round_body(p, shm, bar, 1, lo, hi);
    round_body(p, shm, bar, 2, lo, hi);
#undef IN
#undef SEAM
}

#ifndef N_LAUNCH_MODE
#define N_LAUNCH_MODE 1
#endif
extern "C" void kernel_launch(void* const* d_in, const int* in_sizes, int n_in, void* d_out, int out_size, void* d_ws, size_t ws_size, hipStream_t stream) {
    static int grid = 0;
    if (grid == 0) {
        int dev = 0, cus = 0, per_cu = 0;
        hipGetDevice(&dev); hipDeviceGetAttribute(&cus, hipDeviceAttributeMultiprocessorCount, dev);
        if (hipFuncSetAttribute((const void*)mega, hipFuncAttributeMaxDynamicSharedMemorySize, LDS_BYTES) != hipSuccess) fprintf(stderr, "kernel_launch: hipFuncSetAttribute failed\n");
        if (hipOccupancyMaxActiveBlocksPerMultiprocessor(&per_cu, (const void*)mega, 512, LDS_BYTES) != hipSuccess || per_cu < 1) { fprintf(stderr, "kernel_launch: occupancy query says %d\n", per_cu); per_cu = 1; }
        (void)hipGetLastError();
        grid = cus * 1;
        if (grid <= 0) grid = 256;
    }
    Params p{};
    p.xp = (const float*)d_in[0]; p.xs = (const float*)d_in[1]; p.norm_w = (const float*)d_in[2]; p.w_in = (const float*)d_in[3]; p.b_gate = (const float*)d_in[4];
    p.conv_w = (const float*)d_in[5]; p.conv_b = (const float*)d_in[6]; p.mh_w = (const float*)d_in[7]; p.rpb = (const float*)d_in[8];
    p.wda = (const float*)d_in[9]; p.wdb = (const float*)d_in[10]; p.wout = (const float*)d_in[11]; p.fnw = (const float*)d_in[12];
    p.out = (float*)d_out; p.ws = (unsigned char*)d_ws;
    size_t off = 0;
    p.o_winT = off; off += (size_t)NPAD * 1024 * 2;
    p.o_wdaT = off; off += (size_t)1024 * 1024 * 2; p.o_wdbT = off; off += (size_t)1024 * 1024 * 2; p.o_woutT = off; off += (size_t)1024 * 1024 * 2;
    p.o_ctr = off; off += 256;
    p.o_bar = off; off += (size_t)XCD_BAR_WORDS * 4;
    p.o_state = off; off += (size_t)256 * ST_REC * 4;
    const int Mr = 32768;
    p.Mr = Mr; p.nrounds = 3;
    p.o_gates = off; off += (size_t)Mr * 64;
    p.o_xn = off; off += (size_t)Mr * 2048;
    p.o_act = off; off += (size_t)Mr * 11 * 2048;
    if (off > ws_size) { fprintf(stderr, "kernel_launch: workspace too small (%zu > %zu)\n", off, ws_size); return; }
    hipMemsetAsync((char*)d_ws + p.o_ctr, 0, 256 + (size_t)XCD_BAR_WORDS * 4, stream);
    const int nph = 1 + 8 * p.nrounds;
#if N_LAUNCH_MODE == 1
    p.ph_lo = 0; p.ph_hi = nph;
    void* args[] = {&p};
    hipError_t e = hipLaunchCooperativeKernel((const void*)mega, dim3(grid), dim3(512), args, LDS_BYTES, stream);
    if (e != hipSuccess) fprintf(stderr, "kernel_launch: cooperative launch failed: %s (grid %d)\n", hipGetErrorString(e), grid);
#else
    for (int ph = 0; ph < nph; ++ph) { p.ph_lo = ph; p.ph_hi = ph + 1; hipLaunchKernelGGL(mega, dim3(grid), dim3(512), LDS_BYTES, stream, p); }
#endif
}
```

```cpp
#include <hip/hip_runtime.h>
#include <hip/hip_cooperative_groups.h>
#include <cstdio>
namespace cg = cooperative_groups;
namespace pg8 {
#define PG8_LAS __attribute__((address_space(3)))
typedef unsigned short bf16_t;
typedef short bf16x8 __attribute__((ext_vector_type(8)));
typedef float f32x4 __attribute__((ext_vector_type(4)));
typedef unsigned u32x4 __attribute__((ext_vector_type(4)));
constexpr int BM = 256, BK = 64, HALF = 128, HTB = HALF * BK * 2  , STAGE_BYTES = 8 * HTB, NXCD = 8, WGM = 8;

__host__ __device__ __forceinline__ int lds_byte(int r, int c) { const int st = (r >> 4) * 2 + (c >> 5), rr = r & 15, cc = c & 31, ob = rr * 64 + cc * 2; return st * 1024 + (ob ^ (((ob >> 9) & 1) << 5)); }
__host__ __device__ __forceinline__ void stage_rc(int b, int& R, int& C) { const int st = b / 1024, sb = b % 1024, swz = sb ^ (((sb >> 9) & 1) << 5); R = (st >> 1) * 16 + swz / 64; C = (st & 1) * 32 + (swz % 64) / 2; }
__host__ __device__ __forceinline__ int perm32(int rho) { const int n = rho >> 4, i = rho & 15; return 8 * (i >> 2) + 4 * n + (i & 3); }

struct Unit { int pm, pn, w; };
struct Gemm { const bf16_t* A; const bf16_t* Bt; int M, N, K; const bf16_t* A2; const bf16_t* Bt2; };

struct StaticOrder {
    int nM, nN, nwg, G, c;
    __host__ __device__ void init(int M, int N, int G_, int c_) { nM = M / BM; nN = N / BM; nwg = nM * nN; G = G_; c = c_; }
    __host__ __device__ bool next(int i, Unit& u) const {
        const long L = (long)i * G + c; if (L >= nwg) return false;
        int wgid = (int)L; { const int q = nwg / NXCD, r = nwg % NXCD, xcd = wgid % NXCD, off = wgid / NXCD; wgid = (xcd < r ? xcd * (q + 1) : r * (q + 1) + (xcd - r) * q) + off; }
        const int nig = WGM * nN, gid = wgid / nig, fm = gid * WGM, gsz = (nM - fm) < WGM ? (nM - fm) : WGM;
        u.pm = fm + ((wgid % nig) % gsz); u.pn = (wgid % nig) / gsz; u.w = 0; return true;
    }
    __device__ __forceinline__ void a_ready(const Unit&) const {}
    __device__ __forceinline__ void done(const Unit&) const {}
};
__device__ __forceinline__ unsigned cvt_pk_bf16(float lo, float hi) { unsigned r; asm volatile("v_cvt_pk_bf16_f32 %0, %1, %2" : "=v"(r) : "v"(lo), "v"(hi)); return r; }
template <class Epi, class Sched, bool STAMP = false>
__device__ __forceinline__ void gemm_phase(PG8_LAS unsigned char* lds, const Gemm g, const Sched& S, const Epi& E, unsigned long long* stamps) {
    const int tid = threadIdx.x, wid = __builtin_amdgcn_readfirstlane(tid >> 6), lane = tid & 63, wr = wid >> 2, wc = wid & 3, fr = lane & 15, fq = lane >> 4;
    const int K = g.K, nt = K / BK;
    int ts_lo = 0, ts_hi = 0, nts = 0; const unsigned long long rt_entry = STAMP ? (unsigned long long)wall_clock64() : 0ull;
#define PG8_STAMP() do { if (STAMP && wid == 0 && nts < 64) { const unsigned long long _c = (unsigned long long)clock64(); \
        ts_lo = (lane == nts) ? (int)(unsigned)_c : ts_lo; ts_hi = (lane == nts) ? (int)(unsigned)(_c >> 32) : ts_hi; ++nts; } } while (0)
    PG8_STAMP();
    unsigned voffA[2], voffB[2];
#pragma unroll
    for (int i = 0; i < 2; ++i) { int R, C; stage_rc(tid * 16 + i * 8192, R, C); const int Rb = Epi::PERM ? ((R & ~31) + perm32(R & 31)) : R;
        voffA[i] = (unsigned)(R * K + C) * 2u; voffB[i] = (unsigned)(Rb * K + C) * 2u; }
    const size_t kstep = (size_t)(BK * 2);
    const size_t hstep = (size_t)HALF * K * 2;
    const size_t tstep = 2 * hstep;
    const unsigned ldsw = (unsigned)wid * 1024u;
    const int aoff = lds_byte(wr * 64 + fr, fq * 8), boff = lds_byte(wc * 32 + fr, fq * 8);
#define PG8_SA(b, h) (((b) * 2 + (h)) * HTB)
#define PG8_SB(b, h) ((4 + (b) * 2 + (h)) * HTB)
#define PG8_STAGE(bufoff, gbase, voff) do { _Pragma("unroll") for (int _i = 0; _i < 2; ++_i) \
        __builtin_amdgcn_global_load_lds((const unsigned*)((const char*)(gbase) + (voff)[_i]), (PG8_LAS unsigned*)(lds + (bufoff) + ldsw + _i * 8192), 16, 0, 0); } while (0)
#define PG8_LDA(dst, b, h) do { _Pragma("unroll") for (int m = 0; m < 4; ++m) _Pragma("unroll") for (int k = 0; k < 2; ++k) dst[m][k] = *(const PG8_LAS bf16x8*)(lds + PG8_SA(b, h) + aoff + m * 2048 + k * 1024); } while (0)
#define PG8_LDB(dst, b, h) do { _Pragma("unroll") for (int n = 0; n < 2; ++n) _Pragma("unroll") for (int k = 0; k < 2; ++k) dst[n][k] = *(const PG8_LAS bf16x8*)(lds + PG8_SB(b, h) + boff + n * 2048 + k * 1024); } while (0)
#define PG8_MMA(ai, bj, At, Bt) do { __builtin_amdgcn_s_setprio(1); _Pragma("unroll") for (int m = 0; m < 4; ++m) _Pragma("unroll") for (int n = 0; n < 2; ++n) _Pragma("unroll") for (int k = 0; k < 2; ++k) \
        acc[ai][bj][m][n] = __builtin_amdgcn_mfma_f32_16x16x32_bf16(Bt[n][k], At[m][k], acc[ai][bj][m][n], 0, 0, 0); __builtin_amdgcn_s_setprio(0); } while (0)
#define PG8_WAIT_V(n) asm volatile("s_waitcnt vmcnt(" #n ")" ::: "memory")
#define PG8_WAIT_L(n) asm volatile("s_waitcnt lgkmcnt(" #n ")" ::: "memory")
#define PG8_BAR __builtin_amdgcn_s_barrier()
#define PG8_SCHED __builtin_amdgcn_sched_barrier(0)
    Unit cur, nxt; int ui = 0;
    if (!S.next(0, cur)) return;
    f32x4 acc[2][2][4][2];
#pragma unroll
    for (int a = 0; a < 2; ++a)
#pragma unroll
        for (int b = 0; b < 2; ++b)
#pragma unroll
            for (int m = 0; m < 4; ++m)
#pragma unroll
                for (int n = 0; n < 2; ++n) acc[a][b][m][n] = (f32x4){0.f, 0.f, 0.f, 0.f};
    bf16x8 At[4][2], B0[2][2], B1[2][2];
    const char* cA = (const char*)(cur.w ? g.A2 : g.A) + (size_t)cur.pm * tstep; const char* cB = (const char*)(cur.w ? g.Bt2 : g.Bt) + (size_t)cur.pn * tstep;
    S.a_ready(cur);
    PG8_STAGE(PG8_SB(0, 0), cB, voffB); PG8_STAGE(PG8_SB(0, 1), cB + hstep, voffB); PG8_STAGE(PG8_SA(0, 0), cA, voffA); PG8_STAGE(PG8_SA(0, 1), cA + hstep, voffA);
    if (wr == 1) PG8_BAR;
    PG8_WAIT_V(2); PG8_BAR;
    PG8_STAGE(PG8_SB(1, 0), cB + kstep, voffB); PG8_STAGE(PG8_SA(1, 0), cA + kstep, voffA); PG8_STAGE(PG8_SB(1, 1), cB + hstep + kstep, voffB);
    PG8_WAIT_V(6); PG8_BAR;
    PG8_STAMP();
    for (;;) {
        const bool has_next = S.next(ui + 1, nxt);
        const char* nA = has_next ? (const char*)(nxt.w ? g.A2 : g.A) + (size_t)nxt.pm * tstep : cA; const char* nB = has_next ? (const char*)(nxt.w ? g.Bt2 : g.Bt) + (size_t)nxt.pn * tstep : cB;
        for (int t = 0; t < nt; t += 2) {
            const bool last = (t == nt - 2);
            const char* a1 = cA + (size_t)(t + 1) * kstep;
            const char* a2 = last ? nA : cA + (size_t)(t + 2) * kstep; const char* b2 = last ? nB : cB + (size_t)(t + 2) * kstep;
            const char* a3 = a2 + kstep; const char* b3 = b2 + kstep;
            if (last && has_next) S.a_ready(nxt);
            PG8_LDB(B0, 0, 0); PG8_LDB(B1, 0, 1); PG8_SCHED; PG8_LDA(At, 0, 0); PG8_STAGE(PG8_SA(1, 1), a1 + hstep, voffA);
            PG8_WAIT_V(8); PG8_WAIT_L(0); PG8_BAR; PG8_MMA(0, 0, At, B0); PG8_MMA(0, 1, At, B1); PG8_BAR; PG8_SCHED;
            PG8_LDA(At, 0, 1); PG8_STAGE(PG8_SB(0, 0), b2, voffB); PG8_STAGE(PG8_SB(0, 1), b2 + hstep, voffB); PG8_STAGE(PG8_SA(0, 0), a2, voffA);
            PG8_WAIT_V(8); PG8_WAIT_L(0); PG8_BAR; PG8_MMA(1, 0, At, B0); PG8_MMA(1, 1, At, B1); PG8_BAR; PG8_SCHED;
            PG8_LDB(B0, 1, 0); PG8_LDB(B1, 1, 1); PG8_SCHED; PG8_LDA(At, 1, 0); PG8_STAGE(PG8_SA(0, 1), a2 + hstep, voffA);
            PG8_WAIT_V(8); PG8_WAIT_L(0); PG8_BAR; PG8_MMA(0, 0, At, B0); PG8_MMA(0, 1, At, B1); PG8_BAR; PG8_SCHED;
            PG8_LDA(At, 1, 1); PG8_STAGE(PG8_SB(1, 0), b3, voffB); PG8_STAGE(PG8_SB(1, 1), b3 + hstep, voffB); PG8_STAGE(PG8_SA(1, 0), a3, voffA);
            PG8_WAIT_V(8); PG8_WAIT_L(0); PG8_BAR; PG8_MMA(1, 0, At, B0); PG8_MMA(1, 1, At, B1); PG8_BAR; PG8_SCHED;
        }
        PG8_STAMP();
        if (wr == 0) PG8_BAR;
        if constexpr (!Epi::AFTER_DRAIN) { E(acc, cur, wr, wc, fr, fq); S.done(cur); }
        PG8_STAMP();
        if (!has_next) break;
        if (!(Epi::PAIR && cur.w == 0)) {
#pragma unroll
        for (int a = 0; a < 2; ++a)
#pragma unroll
            for (int b = 0; b < 2; ++b)
#pragma unroll
                for (int m = 0; m < 4; ++m)
#pragma unroll
                    for (int n = 0; n < 2; ++n) acc[a][b][m][n] = (f32x4){0.f, 0.f, 0.f, 0.f};
        }
        cur = nxt; cA = nA; cB = nB; ++ui;
        if (wr == 1) PG8_BAR;
    }
    PG8_WAIT_V(0);
    PG8_BAR;
    if constexpr (Epi::AFTER_DRAIN) { E.fused(acc, cur, wr, wc, fr, fq, lds, wid, lane); S.done(cur); }
    PG8_STAMP();
    if (STAMP && wid == 0) { stamps[lane] = lane < nts ? (((unsigned long long)(unsigned)ts_hi << 32) | (unsigned)ts_lo) : 0ull;
        if (lane == 62) stamps[62] = rt_entry; if (lane == 63) stamps[63] = (unsigned long long)wall_clock64(); }
#undef PG8_STAMP
#undef PG8_SA
#undef PG8_SB
#undef PG8_STAGE
#undef PG8_LDA
#undef PG8_LDB
#undef PG8_MMA
#undef PG8_WAIT_V
#undef PG8_WAIT_L
#undef PG8_BAR
#undef PG8_SCHED
}
}

#define LAS __attribute__((address_space(3)))
typedef unsigned short us;
typedef short bf16x8 __attribute__((ext_vector_type(8)));
typedef short s16x4 __attribute__((ext_vector_type(4)));
typedef float f32x4 __attribute__((ext_vector_type(4)));
typedef unsigned u32x4 __attribute__((ext_vector_type(4)));
typedef unsigned u32x2 __attribute__((ext_vector_type(2)));

constexpr int TOK_P = 16384, TOK_ALL = 81920, UNIT = 2048;
constexpr int DIN = 11280, NPAD = 11520;
constexpr int LDS_BYTES = 163840;
constexpr int L_ITEM = LDS_BYTES - 16;
constexpr int QS = 528, VS = 144;
constexpr int VSW = 176;
constexpr int L_Q = 0, L_K = 33792, L_ST = 67584, L_V = 101376, L_VW = 110592, L_P = 121856, L_SM = 131072;
constexpr int SM_W = 256, SM_QN = 320, SM_RS = 384  , SM_N = 640  ;
constexpr int L_NP = 132864  , L_GU = 134912, L_GC = 143104, L_GB = 151296, L_GM = 159488;
constexpr int NA_VH = 73728, L_RPB = 147456;

struct Params {
    const float *xp, *xs, *norm_w, *w_in, *b_gate, *conv_w, *conv_b, *mh_w, *rpb, *wda, *wdb, *wout, *fnw;
    float* out;
    unsigned char* ws;
    unsigned long long o_winT, o_wdaT, o_wdbT, o_woutT, o_ctr, o_bar, o_state, o_gates, o_xn, o_act;
    int Mr, nrounds, ph_lo, ph_hi;
};

__device__ __forceinline__ us f2bf(float f) { unsigned u = __float_as_uint(f); u += 0x7FFFu + ((u >> 16) & 1u); return (us)(u >> 16); }
__device__ __forceinline__ float bf2f(unsigned b) { return __uint_as_float(b << 16); }
typedef float f32x2_ __attribute__((ext_vector_type(2)));
typedef __bf16 bf16x2_ __attribute__((ext_vector_type(2)));
__device__ __forceinline__ unsigned pk2(float lo, float hi) { f32x2_ v = {lo, hi}; bf16x2_ b = __builtin_convertvector(v, bf16x2_); return __builtin_bit_cast(unsigned, b); }
__device__ __forceinline__ float bflo(unsigned w) { return __uint_as_float(w << 16); }
__device__ __forceinline__ float bfhi(unsigned w) { return __uint_as_float(w & 0xFFFF0000u); }
__device__ __forceinline__ float sigmoidf_(float x) { return __builtin_amdgcn_rcpf(1.0f + __expf(-x)); }
__device__ __forceinline__ float siluf_(float x) { return x * __builtin_amdgcn_rcpf(1.0f + __expf(-x)); }
__device__ __forceinline__ const float* xrow(const Params& p, int t) { return t < TOK_P ? p.xp + (size_t)t * 1024 : p.xs + (size_t)(t - TOK_P) * 1024; }
__device__ __forceinline__ void seq_of(int t, int& s0, int& len) { if (t < TOK_P) { s0 = 0; len = TOK_P; } else { s0 = TOK_P + ((t - TOK_P) / UNIT) * UNIT; len = UNIT; } }
__device__ __forceinline__ us* actp(const Params& p, int i) { return (us*)(p.ws + p.o_act) + (size_t)i * p.Mr * 1024; }
__device__ __forceinline__ f32x4 mfma16(bf16x8 a, bf16x8 b, f32x4 c) { return __builtin_amdgcn_mfma_f32_16x16x32_bf16(a, b, c, 0, 0, 0); }
__device__ __forceinline__ bf16x8 tr8(LAS unsigned char* base, int off0, int off1) {
    s16x4 lo = __builtin_amdgcn_ds_read_tr16_b64_v4i16((LAS s16x4*)(base + off0));
    s16x4 hi = __builtin_amdgcn_ds_read_tr16_b64_v4i16((LAS s16x4*)(base + off1));
    return __builtin_shufflevector(lo, hi, 0, 1, 2, 3, 4, 5, 6, 7);
}

struct EpiIn {
    static constexpr bool PERM = true, AFTER_DRAIN = false, PAIR = false;
    us* act; size_t split_stride; float* gates; const float* b_gate;
    __device__ __forceinline__ void operator()(const pg8::f32x4 (&acc)[2][2][4][2], const pg8::Unit& u, int wr, int wc, int fr, int fq) const {
        const int row0 = u.pm * 256 + wr * 64 + fr;
        if (u.pn < 44) {
            const int t = u.pn >> 2;
            us* base = act + (size_t)t * split_stride;
            const int col0 = (u.pn & 3) * 256 + wc * 32 + 8 * fq;
            if (t >= 5 && t <= 7) {
                const size_t hstride = split_stride >> 4;
#pragma unroll
                for (int ai = 0; ai < 2; ++ai)
#pragma unroll
                    for (int m = 0; m < 4; ++m) { const size_t ro = (size_t)(row0 + ai * 128 + m * 16) * 64;
#pragma unroll
                        for (int bj = 0; bj < 2; ++bj) { const pg8::f32x4 v0 = acc[ai][bj][m][0], v1 = acc[ai][bj][m][1]; const int col = col0 + bj * 128;
                            u32x4 w; w.x = pk2(v0[0], v0[1]); w.y = pk2(v0[2], v0[3]); w.z = pk2(v1[0], v1[1]); w.w = pk2(v1[2], v1[3]);
                            __builtin_nontemporal_store(w, (u32x4*)(base + (size_t)(col >> 6) * hstride + ro + (col & 63))); } }
            } else
#pragma unroll
            for (int ai = 0; ai < 2; ++ai)
#pragma unroll
                for (int m = 0; m < 4; ++m) { us* rowp = base + (size_t)(row0 + ai * 128 + m * 16) * 1024 + col0;
#pragma unroll
                    for (int bj = 0; bj < 2; ++bj) { const pg8::f32x4 v0 = acc[ai][bj][m][0], v1 = acc[ai][bj][m][1];
                        u32x4 w; w.x = pk2(v0[0], v0[1]); w.y = pk2(v0[2], v0[3]); w.z = pk2(v1[0], v1[1]); w.w = pk2(v1[2], v1[3]);
                        __builtin_nontemporal_store(w, (u32x4*)(rowp + bj * 128)); } }
        } else {
            if (wc == 0 && fq < 2) {
#pragma unroll
                for (int n = 0; n < 2; ++n) { const int c = 8 * fq + 4 * n; const f32x4 bv = *(const f32x4*)(b_gate + c);
#pragma unroll
                    for (int ai = 0; ai < 2; ++ai)
#pragma unroll
                        for (int m = 0; m < 4; ++m) { const int row = row0 + ai * 128 + m * 16; *(f32x4*)(gates + (size_t)row * 16 + c) = acc[ai][0][m][n] + bv; } }
            }
        }
    }
};
struct PairOrder : pg8::StaticOrder {
    __device__ bool next(int i, pg8::Unit& u) const { const bool ok = pg8::StaticOrder::next(i >> 1, u); u.w = i & 1; return ok; }
};
struct EpiPair {
    static constexpr bool PERM = true, AFTER_DRAIN = false, PAIR = true;
    const us* ga; const us* gb; us* merged;
    __device__ __forceinline__ void operator()(pg8::f32x4 (&acc)[2][2][4][2], const pg8::Unit& u, int wr, int wc, int fr, int fq) const {
        const int row0 = u.pm * 256 + wr * 64 + fr, col0 = u.pn * 256 + wc * 32 + 8 * fq;
        if (u.w == 0) {
#pragma unroll
            for (int ai = 0; ai < 2; ++ai) {
                u32x4 a[4][2], b[4][2];
#pragma unroll
                for (int m = 0; m < 4; ++m)
#pragma unroll
                    for (int bj = 0; bj < 2; ++bj) { const size_t o = (size_t)(row0 + ai * 128 + m * 16) * 1024 + col0 + bj * 128; a[m][bj] = *(const u32x4*)(ga + o); b[m][bj] = *(const u32x4*)(gb + o); }
#pragma unroll
                for (int m = 0; m < 4; ++m)
#pragma unroll
                    for (int bj = 0; bj < 2; ++bj)
#pragma unroll
                        for (int q = 0; q < 4; ++q) { const unsigned aw = a[m][bj][q], bw = b[m][bj][q];
                            const float r0 = (1.0f + __expf(-bflo(bw))) * __builtin_amdgcn_rcpf(1.0f + __expf(-bflo(aw))), r1 = (1.0f + __expf(-bfhi(bw))) * __builtin_amdgcn_rcpf(1.0f + __expf(-bfhi(aw)));
                            acc[ai][bj][m][q >> 1][(q & 1) * 2] *= r0; acc[ai][bj][m][q >> 1][(q & 1) * 2 + 1] *= r1; }
                asm volatile("" ::: "memory");
            }
        } else {
#pragma unroll
            for (int ai = 0; ai < 2; ++ai) {
                u32x4 b[4][2];
#pragma unroll
                for (int m = 0; m < 4; ++m)
#pragma unroll
                    for (int bj = 0; bj < 2; ++bj) { const size_t o = (size_t)(row0 + ai * 128 + m * 16) * 1024 + col0 + bj * 128; b[m][bj] = *(const u32x4*)(gb + o); }
#pragma unroll
                for (int m = 0; m < 4; ++m)
#pragma unroll
                    for (int bj = 0; bj < 2; ++bj) { const size_t o = (size_t)(row0 + ai * 128 + m * 16) * 1024 + col0 + bj * 128; u32x4 w;
#pragma unroll
                        for (int q = 0; q < 4; ++q) { const unsigned bw = b[m][bj][q];
                            w[q] = pk2(acc[ai][bj][m][q >> 1][(q & 1) * 2] * sigmoidf_(bflo(bw)), acc[ai][bj][m][q >> 1][(q & 1) * 2 + 1] * sigmoidf_(bfhi(bw))); }
                        *(u32x4*)(merged + o) = w; }
                asm volatile("" ::: "memory");
            }
        }
    }
};
struct EpiOut {
    static constexpr bool PERM = false, AFTER_DRAIN = false, PAIR = false;
    float* out; const float* xp; const float* xs; int T0;
    __device__ __forceinline__ void operator()(const pg8::f32x4 (&acc)[2][2][4][2], const pg8::Unit& u, int wr, int wc, int fr, int fq) const {
        const int row0 = u.pm * 256 + wr * 64 + fr, col0 = u.pn * 256 + wc * 32 + 4 * fq;
#pragma unroll
        for (int ai = 0; ai < 2; ++ai)
#pragma unroll
            for (int m = 0; m < 4; ++m) { const int row = row0 + ai * 128 + m * 16; const int t = T0 + row;
                const float* xr = (t < TOK_P ? xp + (size_t)t * 1024 : xs + (size_t)(t - TOK_P) * 1024) + col0; float* orow = out + (size_t)row * 1024 + col0;
#pragma unroll
                for (int bj = 0; bj < 2; ++bj)
#pragma unroll
                    for (int n = 0; n < 2; ++n) { const int o = bj * 128 + n * 16; *(f32x4*)(orow + o) = *(const f32x4*)(xr + o) + acc[ai][bj][m][n]; } }
    }
};

template <class Epi> __device__ __forceinline__ void run_gemm(unsigned char* shm, const us* A, const us* Bt, int M, int N, int K, const Epi& E) {
    pg8::Gemm g; g.A = A; g.Bt = Bt; g.M = M; g.N = N; g.K = K; g.A2 = A; g.Bt2 = Bt;
    pg8::StaticOrder S; S.init(M, N, (int)gridDim.x, (int)blockIdx.x);
    pg8::gemm_phase<Epi, pg8::StaticOrder, false>((LAS unsigned char*)shm, g, S, E, nullptr);
}

__device__ __forceinline__ void run_gemm_pair(unsigned char* shm, const us* A, const us* Bt, const us* A2, const us* Bt2, int M, int N, int K, const EpiPair& E) {
    pg8::Gemm g; g.A = A; g.Bt = Bt; g.M = M; g.N = N; g.K = K; g.A2 = A2; g.Bt2 = Bt2;
    PairOrder S; S.init(M, N, (int)gridDim.x, (int)blockIdx.x);
    pg8::gemm_phase<EpiPair, PairOrder, false>((LAS unsigned char*)shm, g, S, E, nullptr);
}

__device__ __forceinline__ void phase_weights(const Params& p, unsigned char* shm) {
    float* tile = (float*)shm;
    const int tid = threadIdx.x;
    for (int job = blockIdx.x; job < 2880 + 768; job += gridDim.x) {
        const float* src; int ld, col0, nvalid, kt; us* dst;
        if (job < 2880) { const int nt = job >> 4; kt = job & 15; src = p.w_in; ld = DIN; const int n0 = nt * 64;
            if (n0 < 5120) { col0 = n0; nvalid = 64; } else if (n0 < 11264) { col0 = n0 + 16; nvalid = 64; } else if (n0 == 11264) { col0 = 5120; nvalid = 16; } else { col0 = 0; nvalid = 0; }
            dst = (us*)(p.ws + p.o_winT) + (size_t)n0 * 1024;
        } else { const int j2 = job - 2880, which = j2 >> 8, t = j2 & 255, nt = t >> 4; kt = t & 15; ld = 1024; col0 = nt * 64; nvalid = 64;
            src = which == 0 ? p.wda : (which == 1 ? p.wdb : p.wout);
            dst = (us*)(p.ws + (which == 0 ? p.o_wdaT : (which == 1 ? p.o_wdbT : p.o_woutT))) + (size_t)nt * 64 * 1024; }
        __syncthreads();
        { const int j = tid & 63, i0 = tid >> 6;
#pragma unroll
          for (int ii = 0; ii < 8; ++ii) { const int i = i0 + 8 * ii; tile[i * 65 + j] = (j < nvalid) ? src[(size_t)(kt * 64 + i) * ld + col0 + j] : 0.f; } }
        __syncthreads();
        { const int i = tid & 63, j0 = tid >> 6;
#pragma unroll
          for (int jj = 0; jj < 8; ++jj) { const int j = j0 + 8 * jj; dst[(size_t)j * 1024 + kt * 64 + i] = f2bf(tile[i * 65 + j]); } }
    }
    __syncthreads();
}

__device__ __forceinline__ void phase_xnorm(const Params& p, int T0, int Mc) {
    const int wave = threadIdx.x >> 6, lane = threadIdx.x & 63;
    us* xn = (us*)(p.ws + p.o_xn);
    f32x4 nw[4];
#pragma unroll
    for (int j = 0; j < 4; ++j) nw[j] = *(const f32x4*)(p.norm_w + lane * 4 + 256 * j);
    for (int r = blockIdx.x * 8 + wave; r < Mc; r += gridDim.x * 8) {
        const float* xr = xrow(p, T0 + r);
        f32x4 v[4]; float ss = 0.f;
#pragma unroll
        for (int j = 0; j < 4; ++j) { v[j] = *(const f32x4*)(xr + lane * 4 + 256 * j); ss += v[j][0] * v[j][0] + v[j][1] * v[j][1] + v[j][2] * v[j][2] + v[j][3] * v[j][3]; }
#pragma unroll
        for (int o = 32; o >= 1; o >>= 1) ss += __shfl_xor(ss, o);
        const float rs = rsqrtf(ss * (1.0f / 1024.0f) + 1e-6f);
#pragma unroll
        for (int j = 0; j < 4; ++j) { u32x2 w; w.x = pk2(v[j][0] * rs * nw[j][0], v[j][1] * rs * nw[j][1]); w.y = pk2(v[j][2] * rs * nw[j][2], v[j][3] * rs * nw[j][3]);
            *(u32x2*)(xn + (size_t)r * 1024 + lane * 4 + 256 * j) = w; }
    }
}

__device__ __forceinline__ void phase_fnorm(const Params& p, int T0, int Mc) {
    const int wave = threadIdx.x >> 6, lane = threadIdx.x & 63;
    f32x4 nw[4];
#pragma unroll
    for (int j = 0; j < 4; ++j) nw[j] = *(const f32x4*)(p.fnw + lane * 4 + 256 * j);
    for (int r = blockIdx.x * 8 + wave; r < Mc; r += gridDim.x * 8) {
        float* xr = p.out + (size_t)(T0 + r) * 1024;
        f32x4 v[4]; float ss = 0.f;
#pragma unroll
        for (int j = 0; j < 4; ++j) { v[j] = *(const f32x4*)(xr + lane * 4 + 256 * j); ss += v[j][0] * v[j][0] + v[j][1] * v[j][1] + v[j][2] * v[j][2] + v[j][3] * v[j][3]; }
#pragma unroll
        for (int o = 32; o >= 1; o >>= 1) ss += __shfl_xor(ss, o);
        const float rs = rsqrtf(ss * (1.0f / 1024.0f) + 1e-6f);
#pragma unroll
        for (int j = 0; j < 4; ++j) { f32x4 w; w[0] = v[j][0] * rs * nw[j][0]; w[1] = v[j][1] * rs * nw[j][1]; w[2] = v[j][2] * rs * nw[j][2]; w[3] = v[j][3] * rs * nw[j][3];
            *(f32x4*)(xr + lane * 4 + 256 * j) = w; }
    }
}

__device__ __forceinline__ void phase_gates(const Params& p, int Mc) {
    const int wave = threadIdx.x >> 6, lane = threadIdx.x & 63, fr = lane & 15, fq = lane >> 4;
    const us* xn = (const us*)(p.ws + p.o_xn);
    const us* wg = (const us*)(p.ws + p.o_winT) + (size_t)(11264 + fr) * 1024 + fq * 8;
    float* gates = (float*)(p.ws + p.o_gates);
    const float bias = p.b_gate[fr];
    for (int task = blockIdx.x * 8 + wave; task < Mc / 16; task += gridDim.x * 8) {
        const us* ar = xn + (size_t)(task * 16 + fr) * 1024 + fq * 8;
        f32x4 acc0 = (f32x4){0.f, 0.f, 0.f, 0.f}, acc1 = acc0;
#pragma unroll 8
        for (int kk = 0; kk < 32; kk += 2) {
            const bf16x8 a0 = *(const bf16x8*)(ar + kk * 32), a1 = *(const bf16x8*)(ar + kk * 32 + 32);
            const bf16x8 b0 = *(const bf16x8*)(wg + kk * 32), b1 = *(const bf16x8*)(wg + kk * 32 + 32);
            acc0 = mfma16(a0, b0, acc0); acc1 = mfma16(a1, b1, acc1);
        }
#pragma unroll
        for (int i = 0; i < 4; ++i) gates[(size_t)(task * 16 + 4 * fq + i) * 16 + fr] = acc0[i] + acc1[i] + bias;
    }
}

__device__ __forceinline__ void phase_conv(const Params& p, int T0, int Mc) {
    const int tid = threadIdx.x, ct = tid & 255, tensor = ct >> 7, cgp = ct & 127, sub = tid >> 8;
    const us* src = actp(p, tensor);
    us* dst = (us*)(p.out + (size_t)T0 * 1024) + (size_t)tensor * Mc * 1024;
    const int ch0 = tensor * 1024 + cgp * 8;
    float w[5][8], b[8];
#pragma unroll
    for (int e = 0; e < 8; ++e) { b[e] = p.conv_b[ch0 + e];
#pragma unroll
        for (int i = 0; i < 5; ++i) w[i][e] = p.conv_w[i * 2048 + ch0 + e]; }
    const float oscale = tensor ? 0.0625f : 1.0f;
    for (int item = blockIdx.x; item < Mc / 32; item += gridDim.x) {
        const int r0 = (item * 2 + sub) * 16;
        int s0, len; seq_of(T0 + r0, s0, len);
        const int lo = s0 - T0, hi = lo + len;
        u32x4 rows[20];
#pragma unroll
        for (int i = 0; i < 20; ++i) { const int r = r0 - 2 + i; rows[i] = (r >= lo && r < hi) ? *(const u32x4*)(src + (size_t)r * 1024 + cgp * 8) : (u32x4){0u, 0u, 0u, 0u}; }
#pragma unroll
        for (int o = 0; o < 16; ++o) {
            float a[8];
#pragma unroll
            for (int e = 0; e < 8; ++e) a[e] = b[e];
#pragma unroll
            for (int i = 0; i < 5; ++i) { const u32x4 rw = rows[o + i];
                a[0] += w[i][0] * bflo(rw.x); a[1] += w[i][1] * bfhi(rw.x); a[2] += w[i][2] * bflo(rw.y); a[3] += w[i][3] * bfhi(rw.y);
                a[4] += w[i][4] * bflo(rw.z); a[5] += w[i][5] * bfhi(rw.z); a[6] += w[i][6] * bflo(rw.w); a[7] += w[i][7] * bfhi(rw.w); }
#pragma unroll
            for (int e = 0; e < 8; ++e) a[e] = siluf_(a[e]) * oscale;
            u32x4 wv; wv.x = pk2(a[0], a[1]); wv.y = pk2(a[2], a[3]); wv.z = pk2(a[4], a[5]); wv.w = pk2(a[6], a[7]);
            *(u32x4*)(dst + (size_t)(r0 + o) * 1024 + cgp * 8) = wv;
        }
    }
}

__device__ __forceinline__ void phase_ya(const Params& p, int Mc) {
    const int wave = threadIdx.x >> 6, lane = threadIdx.x & 63;
    const us* hf = actp(p, 0); const us* hb = actp(p, 1); const us* mo = actp(p, 3); const us* mz = actp(p, 4);
    us* ya = actp(p, 0);
    float mw[16];
#pragma unroll
    for (int i = 0; i < 16; ++i) mw[i] = p.mh_w[lane * 16 + i];
    for (int r = blockIdx.x * 8 + wave; r < Mc; r += gridDim.x * 8) {
        const size_t o = (size_t)r * 1024 + lane * 16;
        float h[16]; float ss = 0.f;
        unsigned zz[8];
#pragma unroll
        for (int c = 0; c < 2; ++c) {
            const u32x4 a = *(const u32x4*)(hf + o + c * 8), b = *(const u32x4*)(hb + o + c * 8), g = *(const u32x4*)(mo + o + c * 8), z = *(const u32x4*)(mz + o + c * 8);
#pragma unroll
            for (int q = 0; q < 4; ++q) { const unsigned aw = a[q], bw = b[q], gw = g[q];
                h[c * 8 + 2 * q] = (bflo(aw) + bflo(bw)) * sigmoidf_(bflo(gw)); h[c * 8 + 2 * q + 1] = (bfhi(aw) + bfhi(bw)) * sigmoidf_(bfhi(gw)); zz[c * 4 + q] = z[q]; }
        }
#pragma unroll
        for (int i = 0; i < 16; ++i) ss += h[i] * h[i];
        ss += __shfl_xor(ss, 1); ss += __shfl_xor(ss, 2); ss += __shfl_xor(ss, 4); ss += __shfl_xor(ss, 8);
        const float rn = rsqrtf(ss * (1.0f / 256.0f) + 1e-6f);
        unsigned w[8];
#pragma unroll
        for (int q = 0; q < 8; ++q) w[q] = pk2(h[2 * q] * rn * mw[2 * q] * siluf_(bflo(zz[q])), h[2 * q + 1] * rn * mw[2 * q + 1] * siluf_(bfhi(zz[q])));
        *(u32x4*)(ya + o) = (u32x4){w[0], w[1], w[2], w[3]}; *(u32x4*)(ya + o + 8) = (u32x4){w[4], w[5], w[6], w[7]};
    }
}

constexpr int ST_REC = 16896;
template <bool STATE_ONLY>
__device__ __forceinline__ void mlstm_chain(const Params& p, unsigned char* shm, int T0, int Mc, int s0, int len, int head, int dir, int split, int c0, int c1,
                                            const float* st_in, int n_prev, float* st_out) {
    LAS unsigned char* lds = (LAS unsigned char*)shm;
    LAS float* sm = (LAS float*)(lds + L_SM);
    const int tid = threadIdx.x, w = tid >> 6, lane = tid & 63, fr = lane & 15, fq = lane >> 4;
    const us* qc = (const us*)(p.out + (size_t)T0 * 1024); const us* kc = qc + (size_t)Mc * 1024;
    const us* mv = actp(p, 2); const float* gates = (const float*)(p.ws + p.o_gates);
    us* hout = actp(p, dir);
    const int base = dir ? (s0 + len - 1 - T0) : (s0 - T0); const int sgn = dir ? -1 : 1;
    const size_t hoff = (size_t)head * 256;
    u32x4 rq[4], rk[4], rv;
    LAS float* GU = (LAS float*)(lds + L_GU); LAS float* GC = (LAS float*)(lds + L_GC); LAS float* GB = (LAS float*)(lds + L_GB); LAS float* GM = (LAS float*)(lds + L_GM); LAS unsigned char* NBF = lds + L_NP;
    f32x4 Sacc[2][5];
#pragma unroll
    for (int a = 0; a < 2; ++a)
#pragma unroll
        for (int b = 0; b < 5; ++b) Sacc[a][b] = (f32x4){0.f, 0.f, 0.f, 0.f};
    float mstate = 0.f;
    if constexpr (!STATE_ONLY) {
        float nval = 0.f;
        for (int g = 0; g < n_prev; ++g) { const float* rec = st_in + (size_t)g * ST_REC; const float m_loc = rec[16640], B = rec[16641];
            const float m_new = fmaxf(B + mstate, m_loc), a1 = __expf(B + mstate - m_new), a2 = __expf(m_loc - m_new);
#pragma unroll
            for (int dd = 0; dd < 2; ++dd)
#pragma unroll
                for (int e4 = 0; e4 < 4; ++e4) { const f32x4 sl = *(const f32x4*)(rec + (size_t)((((w * 2 + dd) * 4 + e4) * 64 + lane) * 4)); Sacc[dd][e4] = a1 * Sacc[dd][e4] + a2 * sl; }
            if (tid < 256) nval = a1 * nval + a2 * rec[16384 + tid];
            mstate = m_new; }
        if (tid < 256) sm[SM_N + tid] = nval;
        __syncthreads();
#pragma unroll
        for (int dd = 0; dd < 2; ++dd)
#pragma unroll
            for (int i = 0; i < 4; ++i) Sacc[dd][4][i] = (fr == 0) ? sm[SM_N + (w * 2 + dd) * 16 + 4 * fq + i] : 0.f;
        if (fr == 0) {
#pragma unroll
            for (int dd = 0; dd < 2; ++dd) { u32x2 nb; nb.x = pk2(Sacc[dd][4][0], Sacc[dd][4][1]); nb.y = pk2(Sacc[dd][4][2], Sacc[dd][4][3]); *(LAS u32x2*)(NBF + ((w * 2 + dd) * 16 + 4 * fq) * 2) = nb; }
        }
#pragma unroll
        for (int dd = 0; dd < 2; ++dd)
#pragma unroll
            for (int e4 = 0; e4 < 4; ++e4) { const f32x4 sv = Sacc[dd][e4]; u32x2 wv; wv.x = pk2(sv[0], sv[1]); wv.y = pk2(sv[2], sv[3]);
                *(LAS u32x2*)(lds + L_ST + (e4 * 16 + fr) * QS + ((w * 2 + dd) * 16 + 4 * fq) * 2) = wv; }
    } else {
        if (tid < 256) sm[SM_N + tid] = 0.f;
    }
#define CH_LOAD(c) do { \
        _Pragma("unroll") for (int i = 0; i < 4; ++i) { const int id = tid + 512 * i, row = id >> 5, ch = id & 31; const size_t lr = (size_t)(base + sgn * ((c) * 64 + row)); \
            if (!STATE_ONLY) rq[i] = *(const u32x4*)(qc + lr * 1024 + hoff + ch * 8); rk[i] = *(const u32x4*)(kc + lr * 1024 + hoff + ch * 8); } \
        { const int row = tid >> 3, ch = tid & 7; const size_t lr = (size_t)(base + sgn * ((c) * 64 + row)); rv = *(const u32x4*)(mv + lr * 1024 + hoff + split * 64 + ch * 8); } \
 } while (0)
#define CH_STORE() do { \
        _Pragma("unroll") for (int i = 0; i < 4; ++i) { const int id = tid + 512 * i, row = id >> 5, ch = id & 31; \
            if (!STATE_ONLY) *(LAS u32x4*)(lds + L_Q + row * QS + ch * 16) = rq[i]; *(LAS u32x4*)(lds + L_K + row * QS + ch * 16) = rk[i]; } \
        { const int row = tid >> 3, ch = tid & 7; *(LAS u32x4*)(lds + L_V + row * VS + ch * 16) = rv; } } while (0)
    CH_LOAD(c0);
    for (int cc = w; cc < c1 - c0; cc += 8) {
        const size_t lr = (size_t)(base + sgn * ((c0 + cc) * 64 + lane));
        const float li = gates[lr * 16 + dir * 8 + head], gfv = gates[lr * 16 + dir * 8 + 4 + head];
        const float lf = fminf(gfv, 0.f) - log1pf(__expf(-fabsf(gfv)));
        float b = lf;
#pragma unroll
        for (int o = 1; o < 64; o <<= 1) { const float t = __shfl_up(b, o); if (lane >= o) b += t; }
        const float u = li - b; float cm = u;
#pragma unroll
        for (int o = 1; o < 64; o <<= 1) { const float t = __shfl_up(cm, o); if (lane >= o) cm = fmaxf(cm, t); }
        GU[cc * 64 + lane] = u; GC[cc * 64 + lane] = cm; GB[cc * 64 + lane] = b;
    }
    CH_STORE();
    __syncthreads();
    if (tid == 0) { float m = mstate, bt = 0.f;
        for (int cc = 0; cc < c1 - c0; ++cc) { GM[cc] = m; const float M63 = fmaxf(m, GC[cc * 64 + 63]), b63 = GB[cc * 64 + 63]; m = b63 + M63; bt += b63; }
        GM[32] = m; GM[33] = bt; }
    __syncthreads();
    const int tA = w & 3, jt0 = (w >> 2) * 2;
    for (int c = c0; c < c1; ++c) {
        if (c + 1 < c1) CH_LOAD(c + 1);
        const int cg_ = (c - c0) * 64; const float m_c = GM[c - c0]; const float M63 = fmaxf(m_c, GC[cg_ + 63]);
        f32x4 h0 = (f32x4){0.f, 0.f, 0.f, 0.f}, h1 = h0, qn0 = h0, qn1 = h0;
        if constexpr (!STATE_ONLY) {
            f32x4 sc0 = (f32x4){0.f, 0.f, 0.f, 0.f}, sc1 = sc0;
#pragma unroll 4
            for (int kk = 0; kk < 8; ++kk) {
                const bf16x8 a = *(LAS bf16x8*)(lds + L_K + (tA * 16 + fr) * QS + kk * 64 + fq * 16);
                const bf16x8 a2 = *(LAS bf16x8*)(lds + L_ST + (tA * 16 + fr) * QS + kk * 64 + fq * 16);
                const bf16x8 b0 = *(LAS bf16x8*)(lds + L_Q + (jt0 * 16 + fr) * QS + kk * 64 + fq * 16);
                const bf16x8 b1 = *(LAS bf16x8*)(lds + L_Q + ((jt0 + 1) * 16 + fr) * QS + kk * 64 + fq * 16);
                sc0 = mfma16(a, b0, sc0); sc1 = mfma16(a, b1, sc1);
                h0 = mfma16(a2, b0, h0); h1 = mfma16(a2, b1, h1);
                const bf16x8 nf = *(LAS bf16x8*)(NBF + kk * 64 + fq * 16);
                qn0 = mfma16(nf, b0, qn0); qn1 = mfma16(nf, b1, qn1);
            }
            const int sb = tA * 16 + 4 * fq;
            const f32x4 uv = *(LAS f32x4*)(GU + cg_ + sb);
#pragma unroll
            for (int jt = 0; jt < 2; ++jt) { const int j = (jt0 + jt) * 16 + fr; const float Mj = fmaxf(m_c, GC[cg_ + j]); const f32x4 sc = jt ? sc1 : sc0;
                float v[4];
#pragma unroll
                for (int i = 0; i < 4; ++i) v[i] = (sb + i <= j) ? sc[i] * __expf(uv[i] - Mj) : 0.f;
                u32x2 wv; wv.x = pk2(v[0], v[1]); wv.y = pk2(v[2], v[3]);
                *(LAS u32x2*)(lds + L_P + j * VS + sb * 2) = wv;
                }
        }
        {
            const int s = tid >> 3, ch = tid & 7; const float ws_ = __expf(GU[cg_ + s] - M63); const u32x4 vv = *(LAS u32x4*)(lds + L_V + s * VS + ch * 16);
            u32x4 o; o.x = pk2(bflo(vv.x) * ws_, bfhi(vv.x) * ws_); o.y = pk2(bflo(vv.y) * ws_, bfhi(vv.y) * ws_); o.z = pk2(bflo(vv.z) * ws_, bfhi(vv.z) * ws_); o.w = pk2(bflo(vv.w) * ws_, bfhi(vv.w) * ws_);
            *(LAS u32x4*)(lds + L_VW + s * VSW + ch * 16) = o;
            if (ch == 0) { *(LAS u32x4*)(lds + L_VW + s * VSW + 128) = (u32x4){pk2(ws_, 0.f), 0u, 0u, 0u}; *(LAS u32x4*)(lds + L_VW + s * VSW + 144) = (u32x4){0u, 0u, 0u, 0u}; }
        }
        bf16x8 pkf[2][2], pvf[2];
#pragma unroll
        for (int ks = 0; ks < 2; ++ks) { const int rbase = ks * 32 + 8 * fq + (fr >> 2);
#pragma unroll
            for (int dd = 0; dd < 2; ++dd) { const int o0 = rbase * QS + ((w * 2 + dd) * 16 + 4 * (fr & 3)) * 2; pkf[ks][dd] = tr8(lds + L_K, o0, o0 + 4 * QS); }
            if constexpr (!STATE_ONLY) { const int o0 = rbase * VS + (tA * 16 + 4 * (fr & 3)) * 2; pvf[ks] = tr8(lds + L_V, o0, o0 + 4 * VS); } }
        __syncthreads();
        if (c + 1 < c1) { CH_STORE(); }
        if constexpr (!STATE_ONLY) {
            const int j0 = jt0 * 16 + fr, j1 = j0 + 16;
            const float Mj0 = fmaxf(m_c, GC[cg_ + j0]), Mj1 = fmaxf(m_c, GC[cg_ + j1]);
            const float wi0 = __expf(m_c - Mj0), wi1 = __expf(m_c - Mj1);
            h0 *= wi0; h1 *= wi1;
            f32x4 rs0 = (f32x4){0.f, 0.f, 0.f, 0.f}, rs1 = rs0;
            const bf16x8 ones = (bf16x8){(short)0x3F80, (short)0x3F80, (short)0x3F80, (short)0x3F80, (short)0x3F80, (short)0x3F80, (short)0x3F80, (short)0x3F80};
#pragma unroll
            for (int ks = 0; ks < 2; ++ks) {
                const bf16x8 a = pvf[ks];
                const bf16x8 b0 = *(LAS bf16x8*)(lds + L_P + j0 * VS + ks * 64 + fq * 16);
                const bf16x8 b1 = *(LAS bf16x8*)(lds + L_P + j1 * VS + ks * 64 + fq * 16);
                h0 = mfma16(a, b0, h0); h1 = mfma16(a, b1, h1);
                rs0 = mfma16(ones, b0, rs0); rs1 = mfma16(ones, b1, rs1);
            }
            const float den0 = wi0 * qn0[0] + rs0[0], den1 = wi1 * qn1[0] + rs1[0];
            const float sc0 = __builtin_amdgcn_rcpf(fmaxf(fabsf(den0), __expf(-GB[cg_ + j0] - Mj0))), sc1 = __builtin_amdgcn_rcpf(fmaxf(fabsf(den1), __expf(-GB[cg_ + j1] - Mj1)));
            h0 *= sc0; h1 *= sc1;
            const size_t lr0 = (size_t)(base + sgn * (c * 64 + j0)), lr1 = (size_t)(base + sgn * (c * 64 + j1));
            const int eo = split * 64 + tA * 16 + 4 * fq;
            u32x2 w0, w1; w0.x = pk2(h0[0], h0[1]); w0.y = pk2(h0[2], h0[3]); w1.x = pk2(h1[0], h1[1]); w1.y = pk2(h1[2], h1[3]);
            *(u32x2*)(hout + lr0 * 1024 + hoff + eo) = w0; *(u32x2*)(hout + lr1 * 1024 + hoff + eo) = w1;
        }
        {
            const float a_ = __expf(m_c - M63);
#pragma unroll
            for (int dd = 0; dd < 2; ++dd)
#pragma unroll
                for (int e4 = 0; e4 < 5; ++e4) Sacc[dd][e4] *= a_;
#pragma unroll
            for (int ks = 0; ks < 2; ++ks) {
                const int rbase = ks * 32 + 8 * fq + (fr >> 2);
                bf16x8 A[2], B[5];
#pragma unroll
                for (int dd = 0; dd < 2; ++dd) A[dd] = pkf[ks][dd];
#pragma unroll
                for (int e4 = 0; e4 < 5; ++e4) { const int o0 = rbase * VSW + (e4 * 16 + 4 * (fr & 3)) * 2; B[e4] = tr8(lds + L_VW, o0, o0 + 4 * VSW); }
#pragma unroll
                for (int dd = 0; dd < 2; ++dd)
#pragma unroll
                    for (int e4 = 0; e4 < 5; ++e4) Sacc[dd][e4] = mfma16(A[dd], B[e4], Sacc[dd][e4]);
            }
            if constexpr (!STATE_ONLY) {
#pragma unroll
                for (int dd = 0; dd < 2; ++dd)
#pragma unroll
                    for (int e4 = 0; e4 < 4; ++e4) { const f32x4 sv = Sacc[dd][e4]; u32x2 wv; wv.x = pk2(sv[0], sv[1]); wv.y = pk2(sv[2], sv[3]);
                        *(LAS u32x2*)(lds + L_ST + (e4 * 16 + fr) * QS + ((w * 2 + dd) * 16 + 4 * fq) * 2) = wv; }
            }
            if (fr == 0) {
#pragma unroll
                for (int dd = 0; dd < 2; ++dd) { *(LAS f32x4*)(sm + SM_N + (w * 2 + dd) * 16 + 4 * fq) = Sacc[dd][4];
                    if (!STATE_ONLY) { u32x2 nb; nb.x = pk2(Sacc[dd][4][0], Sacc[dd][4][1]); nb.y = pk2(Sacc[dd][4][2], Sacc[dd][4][3]); *(LAS u32x2*)(NBF + ((w * 2 + dd) * 16 + 4 * fq) * 2) = nb; } }
            }
        }
        __syncthreads();
    }
#undef CH_LOAD
#undef CH_STORE
    if constexpr (STATE_ONLY) {
#pragma unroll
        for (int dd = 0; dd < 2; ++dd)
#pragma unroll
            for (int e4 = 0; e4 < 4; ++e4) *(f32x4*)(st_out + (size_t)((((w * 2 + dd) * 4 + e4) * 64 + lane) * 4)) = Sacc[dd][e4];
        if (tid < 256) st_out[16384 + tid] = sm[SM_N + tid];
        if (tid == 0) { st_out[16640] = GM[32]; st_out[16641] = GM[33]; }
    }
}

__device__ __forceinline__ void na_item(const Params& p, unsigned char* shm, int T0, int gpair, int head) {
    LAS unsigned char* lds = (LAS unsigned char*)shm;
    LAS float* rpbs = (LAS float*)(lds + L_RPB);
    constexpr int VOFF = 73728;
    const int tid = threadIdx.x, w = tid >> 6, lane = tid & 63, fr = lane & 15, fq = lane >> 4;
    const int n = w & 3, rr = w >> 2;
    const us* nq = actp(p, 5); const us* nk = actp(p, 6); const us* nv = actp(p, 7); const us* nz = actp(p, 8);
    us* yb = (us*)(p.ws + p.o_xn);
    const size_t hstr = (size_t)p.Mr * 64;
    const int tokA = T0 + gpair * 128; int s0, len; seq_of(tokA, s0, len);
    const int rows = len / 64, r0 = (tokA - s0) / 64, r = r0 + rr;
    const int rsb = min(max(r0 - 4, 0), rows - 8), rs1 = min(max(r0 - 3, 0), rows - 8);
    const int rs = rr ? rs1 : rsb;
    const int nkeys = (rs1 + 8 - rsb) * 64;
    const int wl0 = s0 + rsb * 64 - T0;
    const int kb = min(max(16 * n - 8, 0), 32);
    const size_t lrq = (size_t)(tokA - T0 + rr * 64 + 16 * n + fr);
    u32x4 kreg[9], vreg[9];
#pragma unroll
    for (int i = 0; i < 9; ++i) { const int id = tid + 512 * i, key = id >> 3, ch = id & 7;
        if (key < nkeys) { kreg[i] = *(const u32x4*)(nk + (size_t)head * hstr + (size_t)(wl0 + key) * 64 + ch * 8); vreg[i] = *(const u32x4*)(nv + (size_t)head * hstr + (size_t)(wl0 + key) * 64 + ch * 8); } }
    bf16x8 qf[2];
#pragma unroll
    for (int ks = 0; ks < 2; ++ks) qf[ks] = *(const bf16x8*)(nq + head * hstr + lrq * 64 + ks * 32 + fq * 8);
    float rp0 = 0.f;
    if (tid < 465) rp0 = p.rpb[head * 465 + tid] * 1.44269504f;
#pragma unroll
    for (int i = 0; i < 9; ++i) { const int id = tid + 512 * i, key = id >> 3, ch = id & 7;
        if (key < nkeys) { const int o = key * 128 + ((ch ^ (key & 7)) * 16); *(LAS u32x4*)(lds + o) = kreg[i]; *(LAS u32x4*)(lds + VOFF + o) = vreg[i]; } }
    if (tid < 465) rpbs[tid] = rp0;
    __syncthreads();
    u32x2 zreg[4];
#pragma unroll
    for (int dt = 0; dt < 4; ++dt) zreg[dt] = *(const u32x2*)(nz + lrq * 1024 + head * 64 + dt * 16 + 4 * fq);
    f32x4 s[16];
    const int krow0 = (rs - rsb) * 64 + kb + fr;
#pragma unroll
    for (int t = 0; t < 16; ++t) { s[t] = (f32x4){0.f, 0.f, 0.f, 0.f};
        const int key = krow0 + (t >> 1) * 64 + 16 * (t & 1);
#pragma unroll
        for (int ks = 0; ks < 2; ++ks) { const bf16x8 kf = *(LAS bf16x8*)(lds + key * 128 + (((ks * 4 + fq) ^ (key & 7)) * 16)); s[t] = mfma16(kf, qf[ks], s[t]); } }
    const int c = 16 * n + fr, cs = min(max(c - 8, 0), 48);
    bool vf[2][4];
#pragma unroll
    for (int hf2 = 0; hf2 < 2; ++hf2)
#pragma unroll
        for (int i = 0; i < 4; ++i) vf[hf2][i] = (unsigned)(kb + 16 * hf2 + 4 * fq + i - cs) < 16u;
    LAS float* bp = rpbs + ((rs - r + 7) * 31 + (kb - 16 * n + 4 * fq - fr + 15));
    float mx = -1e30f;
#pragma unroll
    for (int t = 0; t < 16; ++t)
#pragma unroll
        for (int i = 0; i < 4; ++i) { const float v = vf[t & 1][i] ? s[t][i] * 0.18033688f + bp[(t >> 1) * 31 + 16 * (t & 1) + i] : -1e30f; s[t][i] = v; mx = fmaxf(mx, v); }
    mx = fmaxf(mx, __shfl_xor(mx, 16)); mx = fmaxf(mx, __shfl_xor(mx, 32));
    float sum = 0.f;
#pragma unroll
    for (int t = 0; t < 16; ++t)
#pragma unroll
        for (int i = 0; i < 4; ++i) { const float e = __builtin_amdgcn_exp2f(s[t][i] - mx); s[t][i] = e; sum += e; }
    sum += __shfl_xor(sum, 16); sum += __shfl_xor(sum, 32);
    f32x4 o[4];
#pragma unroll
    for (int dt = 0; dt < 4; ++dt) o[dt] = (f32x4){0.f, 0.f, 0.f, 0.f};
    const int vrow0 = (rs - rsb) * 64 + kb + 4 * fq + (fr >> 2), pch = (fr & 3) >> 1, phalf = (fr & 3) & 1;
#pragma unroll
    for (int kk = 0; kk < 8; ++kk) {
        u32x4 pw; pw.x = pk2(s[2 * kk][0], s[2 * kk][1]); pw.y = pk2(s[2 * kk][2], s[2 * kk][3]); pw.z = pk2(s[2 * kk + 1][0], s[2 * kk + 1][1]); pw.w = pk2(s[2 * kk + 1][2], s[2 * kk + 1][3]);
        const bf16x8 pf = __builtin_bit_cast(bf16x8, pw);
        const int k0 = vrow0 + kk * 64, k1 = k0 + 16;
#pragma unroll
        for (int dt = 0; dt < 4; ++dt) { const int chunk = 2 * dt + pch;
            const bf16x8 a = tr8(lds + VOFF, k0 * 128 + ((chunk ^ (k0 & 7)) * 16) + phalf * 8, k1 * 128 + ((chunk ^ (k1 & 7)) * 16) + phalf * 8); o[dt] = mfma16(a, pf, o[dt]); }
    }
    const float inv = __builtin_amdgcn_rcpf(sum);
#pragma unroll
    for (int dt = 0; dt < 4; ++dt) { const size_t off = lrq * 1024 + head * 64 + dt * 16 + 4 * fq; const u32x2 z = zreg[dt];
        u32x2 wv; wv.x = pk2(o[dt][0] * inv * siluf_(bflo(z.x)), o[dt][1] * inv * siluf_(bfhi(z.x))); wv.y = pk2(o[dt][2] * inv * siluf_(bflo(z.y)), o[dt][3] * inv * siluf_(bfhi(z.y)));
        *(u32x2*)(yb + off) = wv; }
}

struct NaGeom { int s0, rows, r0, rsb, rs1; };
__device__ __forceinline__ NaGeom na_geom(int T0, int gpair) {
    NaGeom g; const int tokA = T0 + gpair * 128; int len; seq_of(tokA, g.s0, len);
    g.rows = len / 64; g.r0 = (tokA - g.s0) / 64;
    g.rsb = min(max(g.r0 - 4, 0), g.rows - 8); g.rs1 = min(max(g.r0 - 3, 0), g.rows - 8); return g;
}
__device__ __forceinline__ void na_band(const Params& p, unsigned char* shm, int T0, int Mc) {
    LAS unsigned char* lds = (LAS unsigned char*)shm;
    LAS float* rpbs = (LAS float*)(lds + L_RPB);
    constexpr int VOFF = 73728;
    const int tid = threadIdx.x, w = tid >> 6, lane = tid & 63, fr = lane & 15, fq = lane >> 4;
    const int n = w & 3, rr = w >> 2;
    const int head = blockIdx.x & 15, band = blockIdx.x >> 4, ppb = (Mc / 128) / 16;
    const us* nq = actp(p, 5) + (size_t)head * p.Mr * 64; const us* nk = actp(p, 6) + (size_t)head * p.Mr * 64; const us* nv = actp(p, 7) + (size_t)head * p.Mr * 64;
    const us* nz = actp(p, 8); us* yb = (us*)(p.ws + p.o_xn);
    const int kb = min(max(16 * n - 8, 0), 32);
    const int c = 16 * n + fr, cs = min(max(c - 8, 0), 48);
    const int ccol = tid >> 3, cch = tid & 7;
    const int cswz = (ccol * 128) + ((cch ^ (ccol & 7)) * 16);
    if (tid < 465) rpbs[tid] = p.rpb[head * 465 + tid] * 1.44269504f;
    bool vf[2][4];
#pragma unroll
    for (int hf2 = 0; hf2 < 2; ++hf2)
#pragma unroll
        for (int i = 0; i < 4; ++i) vf[hf2][i] = (unsigned)(kb + 16 * hf2 + 4 * fq + i - cs) < 16u;
    u32x4 kpf[2], vpf[2]; bf16x8 qfn[2];
    int prev_hi = 0, prev_s0 = -1;
    {
        const int gp0 = band * ppb; const size_t lq = (size_t)(gp0 * 128 + rr * 64 + 16 * n + fr);
#pragma unroll
        for (int ks = 0; ks < 2; ++ks) qfn[ks] = *(const bf16x8*)(nq + lq * 64 + ks * 32 + fq * 8);
    }
    for (int k = 0; k < ppb; ++k) {
        const int gpair = band * ppb + k; const NaGeom g = na_geom(T0, gpair);
        const int hi = g.rs1 + 8; const bool fresh = (g.s0 != prev_s0);
        const int r = g.r0 + rr, rs = rr ? g.rs1 : g.rsb;
        const size_t lrq = (size_t)(gpair * 128 + rr * 64 + 16 * n + fr);
        const size_t rowbase = (size_t)(g.s0 - T0) * 64 + (size_t)ccol * 64 + cch * 8;
        __syncthreads();
        if (fresh) {
            u32x4 kreg[9], vreg[9];
#pragma unroll
            for (int i = 0; i < 9; ++i) { const int R = g.rsb + i; if (R < hi) { kreg[i] = *(const u32x4*)(nk + rowbase + (size_t)R * 4096); vreg[i] = *(const u32x4*)(nv + rowbase + (size_t)R * 4096); } }
#pragma unroll
            for (int i = 0; i < 9; ++i) { const int R = g.rsb + i; if (R < hi) { const int o = (R % 9) * 8192 + cswz; *(LAS u32x4*)(lds + o) = kreg[i]; *(LAS u32x4*)(lds + VOFF + o) = vreg[i]; } }
        } else {
#pragma unroll
            for (int i = 0; i < 2; ++i) { const int R = prev_hi + i; if (R < hi) { const int o = (R % 9) * 8192 + cswz; *(LAS u32x4*)(lds + o) = kpf[i]; *(LAS u32x4*)(lds + VOFF + o) = vpf[i]; } }
        }
        const bf16x8 qf0 = qfn[0], qf1 = qfn[1];
        __syncthreads();
        u32x2 zreg[4];
#pragma unroll
        for (int dt = 0; dt < 4; ++dt) zreg[dt] = *(const u32x2*)(nz + lrq * 1024 + head * 64 + dt * 16 + 4 * fq);
        if (k + 1 < ppb) {
            const NaGeom g2 = na_geom(T0, gpair + 1); const int hi2 = g2.rs1 + 8;
            if (g2.s0 == g.s0) {
#pragma unroll
                for (int i = 0; i < 2; ++i) { const int R = hi + i; if (R < hi2) { kpf[i] = *(const u32x4*)(nk + rowbase + (size_t)R * 4096); vpf[i] = *(const u32x4*)(nv + rowbase + (size_t)R * 4096); } }
            }
            const size_t lq = (size_t)((gpair + 1) * 128 + rr * 64 + 16 * n + fr);
#pragma unroll
            for (int ks = 0; ks < 2; ++ks) qfn[ks] = *(const bf16x8*)(nq + lq * 64 + ks * 32 + fq * 8);
        }
        prev_hi = hi; prev_s0 = g.s0;
        int slot[8];
#pragma unroll
        for (int i = 0; i < 8; ++i) slot[i] = (rs + i) % 9;
        f32x4 s[16];
#pragma unroll
        for (int t = 0; t < 16; ++t) { s[t] = (f32x4){0.f, 0.f, 0.f, 0.f};
            const int key = slot[t >> 1] * 64 + kb + 16 * (t & 1) + fr;
            const bf16x8 kf0 = *(LAS bf16x8*)(lds + key * 128 + (((0 + fq) ^ (key & 7)) * 16)), kf1 = *(LAS bf16x8*)(lds + key * 128 + (((4 + fq) ^ (key & 7)) * 16));
            s[t] = mfma16(kf0, qf0, s[t]); s[t] = mfma16(kf1, qf1, s[t]); }
        LAS float* bp = rpbs + ((rs - r + 7) * 31 + (kb - 16 * n + 4 * fq - fr + 15));
        float mx = -1e30f;
#pragma unroll
        for (int t = 0; t < 16; ++t)
#pragma unroll
            for (int i = 0; i < 4; ++i) { const float v = vf[t & 1][i] ? s[t][i] * 0.18033688f + bp[(t >> 1) * 31 + 16 * (t & 1) + i] : -1e30f; s[t][i] = v; mx = fmaxf(mx, v); }
        mx = fmaxf(mx, __shfl_xor(mx, 16)); mx = fmaxf(mx, __shfl_xor(mx, 32));
        float sum = 0.f;
#pragma unroll
        for (int t = 0; t < 16; ++t)
#pragma unroll
            for (int i = 0; i < 4; ++i) { const float e = __builtin_amdgcn_exp2f(s[t][i] - mx); s[t][i] = e; sum += e; }
        sum += __shfl_xor(sum, 16); sum += __shfl_xor(sum, 32);
        f32x4 o[4];
#pragma unroll
        for (int dt = 0; dt < 4; ++dt) o[dt] = (f32x4){0.f, 0.f, 0.f, 0.f};
        const int vcol0 = kb + 4 * fq + (fr >> 2), pch = (fr & 3) >> 1, phalf = (fr & 3) & 1;
#pragma unroll
        for (int kk = 0; kk < 8; ++kk) {
            u32x4 pw; pw.x = pk2(s[2 * kk][0], s[2 * kk][1]); pw.y = pk2(s[2 * kk][2], s[2 * kk][3]); pw.z = pk2(s[2 * kk + 1][0], s[2 * kk + 1][1]); pw.w = pk2(s[2 * kk + 1][2], s[2 * kk + 1][3]);
            const bf16x8 pf = __builtin_bit_cast(bf16x8, pw);
            const int k0 = slot[kk] * 64 + vcol0, k1 = k0 + 16;
#pragma unroll
            for (int dt = 0; dt < 4; ++dt) { const int chunk = 2 * dt + pch;
                const bf16x8 a = tr8(lds + VOFF, k0 * 128 + ((chunk ^ (k0 & 7)) * 16) + phalf * 8, k1 * 128 + ((chunk ^ (k1 & 7)) * 16) + phalf * 8); o[dt] = mfma16(a, pf, o[dt]); }
        }
        const float inv = __builtin_amdgcn_rcpf(sum);
#pragma unroll
        for (int dt = 0; dt < 4; ++dt) { const size_t off = lrq * 1024 + head * 64 + dt * 16 + 4 * fq; const u32x2 z = zreg[dt];
            u32x2 wv; wv.x = pk2(o[dt][0] * inv * siluf_(bflo(z.x)), o[dt][1] * inv * siluf_(bfhi(z.x))); wv.y = pk2(o[dt][2] * inv * siluf_(bflo(z.y)), o[dt][3] * inv * siluf_(bfhi(z.y)));
            *(u32x2*)(yb + off) = wv; }
    }
}

__device__ __forceinline__ void phase_mix(const Params& p, unsigned char* shm, int T0, int Mc, int cidx, int flags) {
    float* state = (float*)(p.ws + p.o_state);
    const int n_pre = (flags & 1) ? 7 * 32 : 0;
    const int n_chain = (flags & 2) ? (Mc / UNIT) * 32 : 0;
    const int n_na = (flags & 4) ? (Mc / 128) * 16 : 0;
    for (int item = blockIdx.x; item < n_pre; item += gridDim.x) { __syncthreads();
        const int g = item >> 5, combo = item & 31;
        mlstm_chain<true>(p, shm, T0, Mc, 0, TOK_P, combo & 3, (combo >> 2) & 1, combo >> 3, 32 * g, 32 * g + 32, nullptr, 0, state + (size_t)(combo * 8 + g) * ST_REC); }
    for (int item = blockIdx.x; item < n_chain; item += gridDim.x) { __syncthreads();
        const int si = item >> 5, combo = item & 31;
        if (T0 == 0 && si < 8) mlstm_chain<false>(p, shm, T0, Mc, 0, TOK_P, combo & 3, (combo >> 2) & 1, combo >> 3, 32 * si, 32 * si + 32, state + (size_t)(combo * 8) * ST_REC, si, nullptr);
        else mlstm_chain<false>(p, shm, T0, Mc, T0 + si * UNIT, UNIT, combo & 3, (combo >> 2) & 1, combo >> 3, 0, 32, nullptr, 0, nullptr); }
    if (n_na) { __syncthreads();
        if (gridDim.x == 256) na_band(p, shm, T0, Mc);
        else for (int idx = blockIdx.x; idx < n_na; idx += gridDim.x) { __syncthreads(); na_item(p, shm, T0, idx >> 4, idx & 15); } }
    __syncthreads();
}

#define XB_TMO      128
#define XB_XCNT(j)  (256  + 64 * (j))
#define XB_XSUB(j)  (1280 + 64 * (j))
#define XB_XGEN(j)  (2304 + 64 * (j))
#define XB_TOP      3328
#define XB_TOPGEN   3392
#define XCD_BAR_WORDS 3456
#define XB_SPIN_CAP (1u << 18)
#define XB_TOP      3328
#define XB_TOPGEN   3392
#define XCD_BAR_WORDS 3456
#define XB_SPIN_CAP (1u << 18)

__device__ __forceinline__ unsigned xb_ld(unsigned* p)              { return __hip_atomic_load(p, __ATOMIC_RELAXED, __HIP_MEMORY_SCOPE_AGENT); }
__device__ __forceinline__ unsigned xb_add(unsigned* p, unsigned v) { return __hip_atomic_fetch_add(p, v, __ATOMIC_RELAXED, __HIP_MEMORY_SCOPE_AGENT); }
__device__ __forceinline__ unsigned xb_xcc_id() { return (unsigned)__builtin_amdgcn_s_getreg((3 << 11) | 20) & 0xFu; }
#define XB_SPIN(cond, bar) do { unsigned _sp = 0; while (cond) { __builtin_amdgcn_s_sleep(1); \
    if ((++_sp & 255u) == 0u) { if (xb_ld(&(bar)[XB_TMO])) break; if (_sp > XB_SPIN_CAP) { atomicAdd(&(bar)[XB_TMO], 1u); break; } } } } while (0)

struct XcdBarrier {
    unsigned* bar; unsigned x;
    volatile LAS unsigned* st;
};

__device__ __forceinline__ XcdBarrier xcd_barrier_post(unsigned* bar, volatile LAS unsigned* st) {
    XcdBarrier b; b.bar = bar; b.x = xb_xcc_id(); b.st = st;
    if (threadIdx.x == 0) (void)xb_add(&bar[XB_XCNT(b.x)], 1u);
    return b;
}
__device__ __forceinline__ void xcd_barrier_complete(unsigned* bar, unsigned x, unsigned& nloc, unsigned& nx) {
    const unsigned G = gridDim.x * gridDim.y * gridDim.z;
    unsigned sum, cnt, mine, sp = 0u;
    for (;;) {
        sum = 0u; cnt = 0u; mine = 0u;
#pragma unroll
        for (unsigned j = 0; j < 16; ++j) { const unsigned c = xb_ld(&bar[XB_XCNT(j)]); sum += c; cnt += (c > 0u) ? 1u : 0u; mine = (j == x) ? c : mine; }
        if (sum == G) break;
        __builtin_amdgcn_s_sleep(1);
        if ((++sp & 255u) == 0u) { if (xb_ld(&bar[XB_TMO])) break; if (sp > XB_SPIN_CAP) { atomicAdd(&bar[XB_TMO], 1u); break; } }
    }
    nloc = mine > 0u ? mine : 1u; nx = cnt > 0u ? cnt : 1u;
}

__device__ __forceinline__ void xcd_barrier(const XcdBarrier& b) {
    asm volatile("s_waitcnt vmcnt(0)" ::: "memory");
    __syncthreads();
    if (threadIdx.x == 0) {
        unsigned* bar = b.bar;
        __builtin_amdgcn_s_waitcnt(0);
        unsigned nloc = b.st[0], nx = b.st[1];
        if (nloc == 0u) { xcd_barrier_complete(bar, b.x, nloc, nx); b.st[0] = nloc; b.st[1] = nx; }
        const unsigned old = xb_add(&bar[XB_XSUB(b.x)], 1u);
        const unsigned gen = old / nloc;
        if (old + 1u == (gen + 1u) * nloc) {
            __builtin_amdgcn_fence(__ATOMIC_RELEASE, "agent");
            asm volatile("s_waitcnt vmcnt(0)" ::: "memory");
            const unsigned og = xb_add(&bar[XB_TOP], 1u);
            const unsigned tg = og / nx;
            if (og + 1u == (tg + 1u) * nx) xb_add(&bar[XB_TOPGEN], 1u);
            else XB_SPIN(xb_ld(&bar[XB_TOPGEN]) == tg, bar);
            __builtin_amdgcn_fence(__ATOMIC_ACQUIRE, "agent");
            xb_add(&bar[XB_XGEN(b.x)], 1u);
            asm volatile("s_waitcnt vmcnt(0)" ::: "memory");
        } else {
            XB_SPIN(xb_ld(&bar[XB_XGEN(b.x)]) == gen, bar);
            __builtin_amdgcn_fence(__ATOMIC_ACQUIRE, "agent");
            asm volatile("s_waitcnt vmcnt(0)" ::: "memory");
        }
    }
    __syncthreads();
}

#ifndef PHM
#define PHM 0xFFF
#endif
#define IN(k) (lo <= (k) && (k) < hi)
#define INB(b, k) (((PHM >> (b)) & 1) && IN(k))
#define SEAM(k) do { if (IN(k) && IN((k) + 1)) xcd_barrier(bar); } while (0)
__device__ __forceinline__ void round_body(const Params& p, unsigned char* shm, const XcdBarrier& bar, const int round, const int lo, const int hi) {
    const int T0 = round * p.Mr, pb = 1 + 8 * round;
    const int Mc = (TOK_ALL - T0) < p.Mr ? (TOK_ALL - T0) : p.Mr;
    if (INB(1, pb)) { EpiIn E; E.act = actp(p, 0); E.split_stride = (size_t)p.Mr * 1024; E.gates = (float*)(p.ws + p.o_gates); E.b_gate = p.b_gate;
        run_gemm(shm, (const us*)(p.ws + p.o_xn), (const us*)(p.ws + p.o_winT), Mc, 11264, 1024, E); }
    SEAM(pb);
    if (INB(2, pb + 1)) { phase_gates(p, Mc); phase_conv(p, T0, Mc); }
    SEAM(pb + 1);
    if (round == 0) {
        if (INB(3, pb + 2)) phase_mix(p, shm, T0, Mc, 0, 1 | 4);
        SEAM(pb + 2);
        if (INB(4, pb + 3)) phase_mix(p, shm, T0, Mc, 1, 2);
    } else {
        if (INB(4, pb + 3)) phase_mix(p, shm, T0, Mc, 1 + round, 2 | 4);
    }
    SEAM(pb + 3);
    if (INB(5, pb + 4)) phase_ya(p, Mc);
    SEAM(pb + 4);
    if (INB(6, pb + 5)) {
        EpiPair E; E.ga = actp(p, 9); E.gb = actp(p, 10); E.merged = actp(p, 1);
        run_gemm_pair(shm, actp(p, 0), (const us*)(p.ws + p.o_wdaT), (const us*)(p.ws + p.o_xn), (const us*)(p.ws + p.o_wdbT), Mc, 1024, 1024, E);
    }
    SEAM(pb + 5);
    if (INB(7, pb + 6)) { EpiOut E; E.out = p.out + (size_t)T0 * 1024; E.xp = p.xp; E.xs = p.xs; E.T0 = T0; run_gemm(shm, actp(p, 1), (const us*)(p.ws + p.o_woutT), Mc, 1024, 1024, E); }
    SEAM(pb + 6);
    if (INB(8, pb + 7)) { phase_fnorm(p, T0, Mc); if (T0 + Mc < TOK_ALL) phase_xnorm(p, T0 + Mc, (TOK_ALL - T0 - Mc) < p.Mr ? (TOK_ALL - T0 - Mc) : p.Mr); }
    if (T0 + Mc < TOK_ALL) SEAM(pb + 7);
}
__global__ __launch_bounds__(512, 2) void mega(Params p) {
    extern __shared__ __attribute__((aligned(16))) unsigned char shm[];
    cg::grid_group grid = cg::this_grid();
    const int lo = p.ph_lo, hi = p.ph_hi;
    volatile LAS unsigned* bst = (volatile LAS unsigned*)((LAS unsigned char*)shm + (LDS_BYTES - 32));
    if (threadIdx.x == 0) { bst[0] = 0u; bst[1] = 0u; }
    __syncthreads();
    const XcdBarrier bar = xcd_barrier_post((unsigned*)(p.ws + p.o_bar), bst);
    if (INB(0, 0)) { phase_weights(p, shm); phase_xnorm(p, 0, p.Mr); }
    if (IN(0) && IN(1)) grid.sync();
    round_body(p, shm, bar, 0, lo, hi);
    round_body(p, shm, bar, 1, lo, hi);
    round_body(p, shm, bar, 2, lo, hi);
#undef IN
#undef SEAM
}

#ifndef N_LAUNCH_MODE
#define N_LAUNCH_MODE 1
#endif
extern "C" void kernel_launch(void* const* d_in, const int* in_sizes, int n_in, void* d_out, int out_size, void* d_ws, size_t ws_size, hipStream_t stream) {
    static int grid = 0;
    if (grid == 0) {
        int dev = 0, cus = 0, per_cu = 0;
        hipGetDevice(&dev); hipDeviceGetAttribute(&cus, hipDeviceAttributeMultiprocessorCount, dev);
        if (hipFuncSetAttribute((const void*)mega, hipFuncAttributeMaxDynamicSharedMemorySize, LDS_BYTES) != hipSuccess) fprintf(stderr, "kernel_launch: hipFuncSetAttribute failed\n");
        if (hipOccupancyMaxActiveBlocksPerMultiprocessor(&per_cu, (const void*)mega, 512, LDS_BYTES) != hipSuccess || per_cu < 1) { fprintf(stderr, "kernel_launch: occupancy query says %d\n", per_cu); per_cu = 1; }
        (void)hipGetLastError();
        grid = cus * 1;
        if (grid <= 0) grid = 256;
    }
    Params p{};
    p.xp = (const float*)d_in[0]; p.xs = (const float*)d_in[1]; p.norm_w = (const float*)d_in[2]; p.w_in = (const float*)d_in[3]; p.b_gate = (const float*)d_in[4];
    p.conv_w = (const float*)d_in[5]; p.conv_b = (const float*)d_in[6]; p.mh_w = (const float*)d_in[7]; p.rpb = (const float*)d_in[8];
    p.wda = (const float*)d_in[9]; p.wdb = (const float*)d_in[10]; p.wout = (const float*)d_in[11]; p.fnw = (const float*)d_in[12];
    p.out = (float*)d_out; p.ws = (unsigned char*)d_ws;
    size_t off = 0;
    p.o_winT = off; off += (size_t)NPAD * 1024 * 2;
    p.o_wdaT = off; off += (size_t)1024 * 1024 * 2; p.o_wdbT = off; off += (size_t)1024 * 1024 * 2; p.o_woutT = off; off += (size_t)1024 * 1024 * 2;
    p.o_ctr = off; off += 256;
    p.o_bar = off; off += (size_t)XCD_BAR_WORDS * 4;
    p.o_state = off; off += (size_t)256 * ST_REC * 4;
    const int Mr = 32768;
    p.Mr = Mr; p.nrounds = 3;
    p.o_gates = off; off += (size_t)Mr * 64;
    p.o_xn = off; off += (size_t)Mr * 2048;
    p.o_act = off; off += (size_t)Mr * 11 * 2048;
    if (off > ws_size) { fprintf(stderr, "kernel_launch: workspace too small (%zu > %zu)\n", off, ws_size); return; }
    hipMemsetAsync((char*)d_ws + p.o_ctr, 0, 256 + (size_t)XCD_BAR_WORDS * 4, stream);
    const int nph = 1 + 8 * p.nrounds;
#if N_LAUNCH_MODE == 1
    p.ph_lo = 0; p.ph_hi = nph;
    void* args[] = {&p};
    hipError_t e = hipLaunchCooperativeKernel((const void*)mega, dim3(grid), dim3(512), args, LDS_BYTES, stream);
    if (e != hipSuccess) fprintf(stderr, "kernel_launch: cooperative launch failed: %s (grid %d)\n", hipGetErrorString(e), grid);
#else
    for (int ph = 0; ph < nph; ++ph) { p.ph_lo = ph; p.ph_hi = ph + 1; hipLaunchKernelGGL(mega, dim3(grid), dim3(512), LDS_BYTES, stream, p); }
#endif
}
```

```cpp
#include <hip/hip_runtime.h>
#include <hip/hip_cooperative_groups.h>
#include <cstdio>
namespace cg = cooperative_groups;
namespace pg8 {
#define PG8_LAS __attribute__((address_space(3)))
typedef unsigned short bf16_t;
typedef short bf16x8 __attribute__((ext_vector_type(8)));
typedef float f32x4 __attribute__((ext_vector_type(4)));
typedef unsigned u32x4 __attribute__((ext_vector_type(4)));
constexpr int BM = 256, BK = 64, HALF = 128, HTB = HALF * BK * 2  , STAGE_BYTES = 8 * HTB, NXCD = 8, WGM = 8;

__host__ __device__ __forceinline__ int lds_byte(int r, int c) { const int st = (r >> 4) * 2 + (c >> 5), rr = r & 15, cc = c & 31, ob = rr * 64 + cc * 2; return st * 1024 + (ob ^ (((ob >> 9) & 1) << 5)); }
__host__ __device__ __forceinline__ void stage_rc(int b, int& R, int& C) { const int st = b / 1024, sb = b % 1024, swz = sb ^ (((sb >> 9) & 1) << 5); R = (st >> 1) * 16 + swz / 64; C = (st & 1) * 32 + (swz % 64) / 2; }
__host__ __device__ __forceinline__ int perm32(int rho) { const int n = rho >> 4, i = rho & 15; return 8 * (i >> 2) + 4 * n + (i & 3); }

struct Unit { int pm, pn, w; };
struct Gemm { const bf16_t* A; const bf16_t* Bt; int M, N, K; const bf16_t* A2; const bf16_t* Bt2; };

struct StaticOrder {
    int nM, nN, nwg, G, c;
    __host__ __device__ void init(int M, int N, int G_, int c_) { nM = M / BM; nN = N / BM; nwg = nM * nN; G = G_; c = c_; }
    __host__ __device__ bool next(int i, Unit& u) const {
        const long L = (long)i * G + c; if (L >= nwg) return false;
        int wgid = (int)L; { const int q = nwg / NXCD, r = nwg % NXCD, xcd = wgid % NXCD, off = wgid / NXCD; wgid = (xcd < r ? xcd * (q + 1) : r * (q + 1) + (xcd - r) * q) + off; }
        const int nig = WGM * nN, gid = wgid / nig, fm = gid * WGM, gsz = (nM - fm) < WGM ? (nM - fm) : WGM;
        u.pm = fm + ((wgid % nig) % gsz); u.pn = (wgid % nig) / gsz; u.w = 0; return true;
    }
    __device__ __forceinline__ void a_ready(const Unit&) const {}
    __device__ __forceinline__ void done(const Unit&) const {}
};
__device__ __forceinline__ unsigned cvt_pk_bf16(float lo, float hi) { unsigned r; asm volatile("v_cvt_pk_bf16_f32 %0, %1, %2" : "=v"(r) : "v"(lo), "v"(hi)); return r; }
template <class Epi, class Sched, bool STAMP = false>
__device__ __forceinline__ void gemm_phase(PG8_LAS unsigned char* lds, const Gemm g, const Sched& S, const Epi& E, unsigned long long* stamps) {
    const int tid = threadIdx.x, wid = __builtin_amdgcn_readfirstlane(tid >> 6), lane = tid & 63, wr = wid >> 2, wc = wid & 3, fr = lane & 15, fq = lane >> 4;
    const int K = g.K, nt = K / BK;
    int ts_lo = 0, ts_hi = 0, nts = 0; const unsigned long long rt_entry = STAMP ? (unsigned long long)wall_clock64() : 0ull;
#define PG8_STAMP() do { if (STAMP && wid == 0 && nts < 64) { const unsigned long long _c = (unsigned long long)clock64(); \
        ts_lo = (lane == nts) ? (int)(unsigned)_c : ts_lo; ts_hi = (lane == nts) ? (int)(unsigned)(_c >> 32) : ts_hi; ++nts; } } while (0)
    PG8_STAMP();
    unsigned voffA[2], voffB[2];
#pragma unroll
    for (int i = 0; i < 2; ++i) { int R, C; stage_rc(tid * 16 + i * 8192, R, C); const int Rb = Epi::PERM ? ((R & ~31) + perm32(R & 31)) : R;
        voffA[i] = (unsigned)(R * K + C) * 2u; voffB[i] = (unsigned)(Rb * K + C) * 2u; }
    const size_t kstep = (size_t)(BK * 2);
    const size_t hstep = (size_t)HALF * K * 2;
    const size_t tstep = 2 * hstep;
    const unsigned ldsw = (unsigned)wid * 1024u;
    const int aoff = lds_byte(wr * 64 + fr, fq * 8), boff = lds_byte(wc * 32 + fr, fq * 8);
#define PG8_SA(b, h) (((b) * 2 + (h)) * HTB)
#define PG8_SB(b, h) ((4 + (b) * 2 + (h)) * HTB)
#define PG8_STAGE(bufoff, gbase, voff) do { _Pragma("unroll") for (int _i = 0; _i < 2; ++_i) \
        __builtin_amdgcn_global_load_lds((const unsigned*)((const char*)(gbase) + (voff)[_i]), (PG8_LAS unsigned*)(lds + (bufoff) + ldsw + _i * 8192), 16, 0, 0); } while (0)
#define PG8_LDA(dst, b, h) do { _Pragma("unroll") for (int m = 0; m < 4; ++m) _Pragma("unroll") for (int k = 0; k < 2; ++k) dst[m][k] = *(const PG8_LAS bf16x8*)(lds + PG8_SA(b, h) + aoff + m * 2048 + k * 1024); } while (0)
#define PG8_LDB(dst, b, h) do { _Pragma("unroll") for (int n = 0; n < 2; ++n) _Pragma("unroll") for (int k = 0; k < 2; ++k) dst[n][k] = *(const PG8_LAS bf16x8*)(lds + PG8_SB(b, h) + boff + n * 2048 + k * 1024); } while (0)
#define PG8_MMA(ai, bj, At, Bt) do { __builtin_amdgcn_s_setprio(1); _Pragma("unroll") for (int m = 0; m < 4; ++m) _Pragma("unroll") for (int n = 0; n < 2; ++n) _Pragma("unroll") for (int k = 0; k < 2; ++k) \
        acc[ai][bj][m][n] = __builtin_amdgcn_mfma_f32_16x16x32_bf16(Bt[n][k], At[m][k], acc[ai][bj][m][n], 0, 0, 0); __builtin_amdgcn_s_setprio(0); } while (0)
#define PG8_WAIT_V(n) asm volatile("s_waitcnt vmcnt(" #n ")" ::: "memory")
#define PG8_WAIT_L(n) asm volatile("s_waitcnt lgkmcnt(" #n ")" ::: "memory")
#define PG8_BAR __builtin_amdgcn_s_barrier()
#define PG8_SCHED __builtin_amdgcn_sched_barrier(0)
    Unit cur, nxt; int ui = 0;
    if (!S.next(0, cur)) return;
    f32x4 acc[2][2][4][2];
#pragma unroll
    for (int a = 0; a < 2; ++a)
#pragma unroll
        for (int b = 0; b < 2; ++b)
#pragma unroll
            for (int m = 0; m < 4; ++m)
#pragma unroll
                for (int n = 0; n < 2; ++n) acc[a][b][m][n] = (f32x4){0.f, 0.f, 0.f, 0.f};
    bf16x8 At[4][2], B0[2][2], B1[2][2];
    const char* cA = (const char*)(cur.w ? g.A2 : g.A) + (size_t)cur.pm * tstep; const char* cB = (const char*)(cur.w ? g.Bt2 : g.Bt) + (size_t)cur.pn * tstep;
    S.a_ready(cur);
    PG8_STAGE(PG8_SB(0, 0), cB, voffB); PG8_STAGE(PG8_SB(0, 1), cB + hstep, voffB); PG8_STAGE(PG8_SA(0, 0), cA, voffA); PG8_STAGE(PG8_SA(0, 1), cA + hstep, voffA);
    if (wr == 1) PG8_BAR;
    PG8_WAIT_V(2); PG8_BAR;
    PG8_STAGE(PG8_SB(1, 0), cB + kstep, voffB); PG8_STAGE(PG8_SA(1, 0), cA + kstep, voffA); PG8_STAGE(PG8_SB(1, 1), cB + hstep + kstep, voffB);
    PG8_WAIT_V(6); PG8_BAR;
    PG8_STAMP();
    for (;;) {
        const bool has_next = S.next(ui + 1, nxt);
        const char* nA = has_next ? (const char*)(nxt.w ? g.A2 : g.A) + (size_t)nxt.pm * tstep : cA; const char* nB = has_next ? (const char*)(nxt.w ? g.Bt2 : g.Bt) + (size_t)nxt.pn * tstep : cB;
        for (int t = 0; t < nt; t += 2) {
            const bool last = (t == nt - 2);
            const char* a1 = cA + (size_t)(t + 1) * kstep;
            const char* a2 = last ? nA : cA + (size_t)(t + 2) * kstep; const char* b2 = last ? nB : cB + (size_t)(t + 2) * kstep;
            const char* a3 = a2 + kstep; const char* b3 = b2 + kstep;
            if (last && has_next) S.a_ready(nxt);
            PG8_LDB(B0, 0, 0); PG8_LDB(B1, 0, 1); PG8_SCHED; PG8_LDA(At, 0, 0); PG8_STAGE(PG8_SA(1, 1), a1 + hstep, voffA);
            PG8_WAIT_V(8); PG8_WAIT_L(0); PG8_BAR; PG8_MMA(0, 0, At, B0); PG8_MMA(0, 1, At, B1); PG8_BAR; PG8_SCHED;
            PG8_LDA(At, 0, 1); PG8_STAGE(PG8_SB(0, 0), b2, voffB); PG8_STAGE(PG8_SB(0, 1), b2 + hstep, voffB); PG8_STAGE(PG8_SA(0, 0), a2, voffA);
            PG8_WAIT_V(8); PG8_WAIT_L(0); PG8_BAR; PG8_MMA(1, 0, At, B0); PG8_MMA(1, 1, At, B1); PG8_BAR; PG8_SCHED;
            PG8_LDB(B0, 1, 0); PG8_LDB(B1, 1, 1); PG8_SCHED; PG8_LDA(At, 1, 0); PG8_STAGE(PG8_SA(0, 1), a2 + hstep, voffA);
            PG8_WAIT_V(8); PG8_WAIT_L(0); PG8_BAR; PG8_MMA(0, 0, At, B0); PG8_MMA(0, 1, At, B1); PG8_BAR; PG8_SCHED;
            PG8_LDA(At, 1, 1); PG8_STAGE(PG8_SB(1, 0), b3, voffB); PG8_STAGE(PG8_SB(1, 1), b3 + hstep, voffB); PG8_STAGE(PG8_SA(1, 0), a3, voffA);
            PG8_WAIT_V(8); PG8_WAIT_L(0); PG8_BAR; PG8_MMA(1, 0, At, B0); PG8_MMA(1, 1, At, B1); PG8_BAR; PG8_SCHED;
        }
        PG8_STAMP();
        if (wr == 0) PG8_BAR;
        if constexpr (!Epi::AFTER_DRAIN) { E(acc, cur, wr, wc, fr, fq); S.done(cur); }
        PG8_STAMP();
        if (!has_next) break;
        if (!(Epi::PAIR && cur.w == 0)) {
#pragma unroll
        for (int a = 0; a < 2; ++a)
#pragma unroll
            for (int b = 0; b < 2; ++b)
#pragma unroll
                for (int m = 0; m < 4; ++m)
#pragma unroll
                    for (int n = 0; n < 2; ++n) acc[a][b][m][n] = (f32x4){0.f, 0.f, 0.f, 0.f};
        }
        cur = nxt; cA = nA; cB = nB; ++ui;
        if (wr == 1) PG8_BAR;
    }
    PG8_WAIT_V(0);
    PG8_BAR;
    if constexpr (Epi::AFTER_DRAIN) { E.fused(acc, cur, wr, wc, fr, fq, lds, wid, lane); S.done(cur); }
    PG8_STAMP();
    if (STAMP && wid == 0) { stamps[lane] = lane < nts ? (((unsigned long long)(unsigned)ts_hi << 32) | (unsigned)ts_lo) : 0ull;
        if (lane == 62) stamps[62] = rt_entry; if (lane == 63) stamps[63] = (unsigned long long)wall_clock64(); }
#undef PG8_STAMP
#undef PG8_SA
#undef PG8_SB
#undef PG8_STAGE
#undef PG8_LDA
#undef PG8_LDB
#undef PG8_MMA
#undef PG8_WAIT_V
#undef PG8_WAIT_L
#undef PG8_BAR
#undef PG8_SCHED
}
}

#define LAS __attribute__((address_space(3)))
typedef unsigned short us;
typedef short bf16x8 __attribute__((ext_vector_type(8)));
typedef short s16x4 __attribute__((ext_vector_type(4)));
typedef float f32x4 __attribute__((ext_vector_type(4)));
typedef unsigned u32x4 __attribute__((ext_vector_type(4)));
typedef unsigned u32x2 __attribute__((ext_vector_type(2)));

constexpr int TOK_P = 16384, TOK_ALL = 81920, UNIT = 2048;
constexpr int DIN = 11280, NPAD = 11520;
constexpr int LDS_BYTES = 163840;
constexpr int L_ITEM = LDS_BYTES - 16;
constexpr int QS = 528, VS = 144;
constexpr int VSW = 176;
constexpr int L_Q = 0, L_K = 33792, L_ST = 67584, L_V = 101376, L_VW = 110592, L_P = 121856, L_SM = 131072;
constexpr int SM_W = 256, SM_QN = 320, SM_RS = 384  , SM_N = 640  ;
constexpr int L_NP = 132864  , L_GU = 134912, L_GC = 143104, L_GB = 151296, L_GM = 159488;
constexpr int NA_VH = 73728, L_RPB = 147456;

struct Params {
    const float *xp, *xs, *norm_w, *w_in, *b_gate, *conv_w, *conv_b, *mh_w, *rpb, *wda, *wdb, *wout, *fnw;
    float* out;
    unsigned char* ws;
    unsigned long long o_winT, o_wdaT, o_wdbT, o_woutT, o_ctr, o_bar, o_state, o_gates, o_xn, o_act;
    int Mr, nrounds, ph_lo, ph_hi;
};

__device__ __forceinline__ us f2bf(float f) { unsigned u = __float_as_uint(f); u += 0x7FFFu + ((u >> 16) & 1u); return (us)(u >> 16); }
__device__ __forceinline__ float bf2f(unsigned b) { return __uint_as_float(b << 16); }
typedef float f32x2_ __attribute__((ext_vector_type(2)));
typedef __bf16 bf16x2_ __attribute__((ext_vector_type(2)));
__device__ __forceinline__ unsigned pk2(float lo, float hi) { f32x2_ v = {lo, hi}; bf16x2_ b = __builtin_convertvector(v, bf16x2_); return __builtin_bit_cast(unsigned, b); }
__device__ __forceinline__ float bflo(unsigned w) { return __uint_as_float(w << 16); }
__device__ __forceinline__ float bfhi(unsigned w) { return __uint_as_float(w & 0xFFFF0000u); }
__device__ __forceinline__ float sigmoidf_(float x) { return __builtin_amdgcn_rcpf(1.0f + __expf(-x)); }
__device__ __forceinline__ float siluf_(float x) { return x * __builtin_amdgcn_rcpf(1.0f + __expf(-x)); }
__device__ __forceinline__ const float* xrow(const Params& p, int t) { return t < TOK_P ? p.xp + (size_t)t * 1024 : p.xs + (size_t)(t - TOK_P) * 1024; }
__device__ __forceinline__ void seq_of(int t, int& s0, int& len) { if (t < TOK_P) { s0 = 0; len = TOK_P; } else { s0 = TOK_P + ((t - TOK_P) / UNIT) * UNIT; len = UNIT; } }
__device__ __forceinline__ us* actp(const Params& p, int i) { return (us*)(p.ws + p.o_act) + (size_t)i * p.Mr * 1024; }
__device__ __forceinline__ f32x4 mfma16(bf16x8 a, bf16x8 b, f32x4 c) { return __builtin_amdgcn_mfma_f32_16x16x32_bf16(a, b, c, 0, 0, 0); }
__device__ __forceinline__ bf16x8 tr8(LAS unsigned char* base, int off0, int off1) {
    s16x4 lo = __builtin_amdgcn_ds_read_tr16_b64_v4i16((LAS s16x4*)(base + off0));
    s16x4 hi = __builtin_amdgcn_ds_read_tr16_b64_v4i16((LAS s16x4*)(base + off1));
    return __builtin_shufflevector(lo, hi, 0, 1, 2, 3, 4, 5, 6, 7);
}

struct EpiIn {
    static constexpr bool PERM = true, AFTER_DRAIN = false, PAIR = false;
    us* act; size_t split_stride; float* gates; const float* b_gate;
    __device__ __forceinline__ void operator()(const pg8::f32x4 (&acc)[2][2][4][2], const pg8::Unit& u, int wr, int wc, int fr, int fq) const {
        const int row0 = u.pm * 256 + wr * 64 + fr;
        if (u.pn < 44) {
            const int t = u.pn >> 2;
            us* base = act + (size_t)t * split_stride;
            const int col0 = (u.pn & 3) * 256 + wc * 32 + 8 * fq;
            if (t >= 5 && t <= 7) {
                const size_t hstride = split_stride >> 4;
#pragma unroll
                for (int ai = 0; ai < 2; ++ai)
#pragma unroll
                    for (int m = 0; m < 4; ++m) { const size_t ro = (size_t)(row0 + ai * 128 + m * 16) * 64;
#pragma unroll
                        for (int bj = 0; bj < 2; ++bj) { const pg8::f32x4 v0 = acc[ai][bj][m][0], v1 = acc[ai][bj][m][1]; const int col = col0 + bj * 128;
                            u32x4 w; w.x = pk2(v0[0], v0[1]); w.y = pk2(v0[2], v0[3]); w.z = pk2(v1[0], v1[1]); w.w = pk2(v1[2], v1[3]);
                            __builtin_nontemporal_store(w, (u32x4*)(base + (size_t)(col >> 6) * hstride + ro + (col & 63))); } }
            } else
#pragma unroll
            for (int ai = 0; ai < 2; ++ai)
#pragma unroll
                for (int m = 0; m < 4; ++m) { us* rowp = base + (size_t)(row0 + ai * 128 + m * 16) * 1024 + col0;
#pragma unroll
                    for (int bj = 0; bj < 2; ++bj) { const pg8::f32x4 v0 = acc[ai][bj][m][0], v1 = acc[ai][bj][m][1];
                        u32x4 w; w.x = pk2(v0[0], v0[1]); w.y = pk2(v0[2], v0[3]); w.z = pk2(v1[0], v1[1]); w.w = pk2(v1[2], v1[3]);
                        __builtin_nontemporal_store(w, (u32x4*)(rowp + bj * 128)); } }
        } else {
            if (wc == 0 && fq < 2) {
#pragma unroll
                for (int n = 0; n < 2; ++n) { const int c = 8 * fq + 4 * n; const f32x4 bv = *(const f32x4*)(b_gate + c);
#pragma unroll
                    for (int ai = 0; ai < 2; ++ai)
#pragma unroll
                        for (int m = 0; m < 4; ++m) { const int row = row0 + ai * 128 + m * 16; *(f32x4*)(gates + (size_t)row * 16 + c) = acc[ai][0][m][n] + bv; } }
            }
        }
    }
};
struct PairOrder : pg8::StaticOrder {
    __device__ bool next(int i, pg8::Unit& u) const { const bool ok = pg8::StaticOrder::next(i >> 1, u); u.w = i & 1; return ok; }
};
struct EpiPair {
    static constexpr bool PERM = true, AFTER_DRAIN = false, PAIR = true;
    const us* ga; const us* gb; us* merged;
    __device__ __forceinline__ void operator()(pg8::f32x4 (&acc)[2][2][4][2], const pg8::Unit& u, int wr, int wc, int fr, int fq) const {
        const int row0 = u.pm * 256 + wr * 64 + fr, col0 = u.pn * 256 + wc * 32 + 8 * fq;
        if (u.w == 0) {
#pragma unroll
            for (int ai = 0; ai < 2; ++ai) {
                u32x4 a[4][2], b[4][2];
#pragma unroll
                for (int m = 0; m < 4; ++m)
#pragma unroll
                    for (int bj = 0; bj < 2; ++bj) { const size_t o = (size_t)(row0 + ai * 128 + m * 16) * 1024 + col0 + bj * 128; a[m][bj] = *(const u32x4*)(ga + o); b[m][bj] = *(const u32x4*)(gb + o); }
#pragma unroll
                for (int m = 0; m < 4; ++m)
#pragma unroll
                    for (int bj = 0; bj < 2; ++bj)
#pragma unroll
                        for (int q = 0; q < 4; ++q) { const unsigned aw = a[m][bj][q], bw = b[m][bj][q];
                            const float r0 = (1.0f + __expf(-bflo(bw))) * __builtin_amdgcn_rcpf(1.0f + __expf(-bflo(aw))), r1 = (1.0f + __expf(-bfhi(bw))) * __builtin_amdgcn_rcpf(1.0f + __expf(-bfhi(aw)));
                            acc[ai][bj][m][q >> 1][(q & 1) * 2] *= r0; acc[ai][bj][m][q >> 1][(q & 1) * 2 + 1] *= r1; }
                asm volatile("" ::: "memory");
            }
        } else {
#pragma unroll
            for (int ai = 0; ai < 2; ++ai) {
                u32x4 b[4][2];
#pragma unroll
                for (int m = 0; m < 4; ++m)
#pragma unroll
                    for (int bj = 0; bj < 2; ++bj) { const size_t o = (size_t)(row0 + ai * 128 + m * 16) * 1024 + col0 + bj * 128; b[m][bj] = *(const u32x4*)(gb + o); }
#pragma unroll
                for (int m = 0; m < 4; ++m)
#pragma unroll
                    for (int bj = 0; bj < 2; ++bj) { const size_t o = (size_t)(row0 + ai * 128 + m * 16) * 1024 + col0 + bj * 128; u32x4 w;
#pragma unroll
                        for (int q = 0; q < 4; ++q) { const unsigned bw = b[m][bj][q];
                            w[q] = pk2(acc[ai][bj][m][q >> 1][(q & 1) * 2] * sigmoidf_(bflo(bw)), acc[ai][bj][m][q >> 1][(q & 1) * 2 + 1] * sigmoidf_(bfhi(bw))); }
                        *(u32x4*)(merged + o) = w; }
                asm volatile("" ::: "memory");
            }
        }
    }
};
struct EpiOut {
    static constexpr bool PERM = false, AFTER_DRAIN = false, PAIR = false;
    float* out; const float* xp; const float* xs; int T0;
    __device__ __forceinline__ void operator()(const pg8::f32x4 (&acc)[2][2][4][2], const pg8::Unit& u, int wr, int wc, int fr, int fq) const {
        const int row0 = u.pm * 256 + wr * 64 + fr, col0 = u.pn * 256 + wc * 32 + 4 * fq;
#pragma unroll
        for (int ai = 0; ai < 2; ++ai)
#pragma unroll
            for (int m = 0; m < 4; ++m) { const int row = row0 + ai * 128 + m * 16; const int t = T0 + row;
                const float* xr = (t < TOK_P ? xp + (size_t)t * 1024 : xs + (size_t)(t - TOK_P) * 1024) + col0; float* orow = out + (size_t)row * 1024 + col0;
#pragma unroll
                for (int bj = 0; bj < 2; ++bj)
#pragma unroll
                    for (int n = 0; n < 2; ++n) { const int o = bj * 128 + n * 16; *(f32x4*)(orow + o) = *(const f32x4*)(xr + o) + acc[ai][bj][m][n]; } }
    }
};

template <class Epi> __device__ __forceinline__ void run_gemm(unsigned char* shm, const us* A, const us* Bt, int M, int N, int K, const Epi& E) {
    pg8::Gemm g; g.A = A; g.Bt = Bt; g.M = M; g.N = N; g.K = K; g.A2 = A; g.Bt2 = Bt;
    pg8::StaticOrder S; S.init(M, N, (int)gridDim.x, (int)blockIdx.x);
    pg8::gemm_phase<Epi, pg8::StaticOrder, false>((LAS unsigned char*)shm, g, S, E, nullptr);
}

__device__ __forceinline__ void run_gemm_pair(unsigned char* shm, const us* A, const us* Bt, const us* A2, const us* Bt2, int M, int N, int K, const EpiPair& E) {
    pg8::Gemm g; g.A = A; g.Bt = Bt; g.M = M; g.N = N; g.K = K; g.A2 = A2; g.Bt2 = Bt2;
    PairOrder S; S.init(M, N, (int)gridDim.x, (int)blockIdx.x);
    pg8::gemm_phase<EpiPair, PairOrder, false>((LAS unsigned char*)shm, g, S, E, nullptr);
}

__device__ __forceinline__ void phase_weights(const Params& p, unsigned char* shm) {
    float* tile = (float*)shm;
    const int tid = threadIdx.x;
    for (int job = blockIdx.x; job < 2880 + 768; job += gridDim.x) {
        const float* src; int ld, col0, nvalid, kt; us* dst;
        if (job < 2880) { const int nt = job >> 4; kt = job & 15; src = p.w_in; ld = DIN; const int n0 = nt * 64;
            if (n0 < 5120) { col0 = n0; nvalid = 64; } else if (n0 < 11264) { col0 = n0 + 16; nvalid = 64; } else if (n0 == 11264) { col0 = 5120; nvalid = 16; } else { col0 = 0; nvalid = 0; }
            dst = (us*)(p.ws + p.o_winT) + (size_t)n0 * 1024;
        } else { const int j2 = job - 2880, which = j2 >> 8, t = j2 & 255, nt = t >> 4; kt = t & 15; ld = 1024; col0 = nt * 64; nvalid = 64;
            src = which == 0 ? p.wda : (which == 1 ? p.wdb : p.wout);
            dst = (us*)(p.ws + (which == 0 ? p.o_wdaT : (which == 1 ? p.o_wdbT : p.o_woutT))) + (size_t)nt * 64 * 1024; }
        __syncthreads();
        { const int j = tid & 63, i0 = tid >> 6;
#pragma unroll
          for (int ii = 0; ii < 8; ++ii) { const int i = i0 + 8 * ii; tile[i * 65 + j] = (j < nvalid) ? src[(size_t)(kt * 64 + i) * ld + col0 + j] : 0.f; } }
        __syncthreads();
        { const int j = tid & 63, kg = tid >> 6;
          u32x4 wv; wv.x = pk2(tile[(kg * 8 + 0) * 65 + j], tile[(kg * 8 + 1) * 65 + j]); wv.y = pk2(tile[(kg * 8 + 2) * 65 + j], tile[(kg * 8 + 3) * 65 + j]);
          wv.z = pk2(tile[(kg * 8 + 4) * 65 + j], tile[(kg * 8 + 5) * 65 + j]); wv.w = pk2(tile[(kg * 8 + 6) * 65 + j], tile[(kg * 8 + 7) * 65 + j]);
          *(u32x4*)(dst + (size_t)j * 1024 + kt * 64 + kg * 8) = wv; }
    }
    __syncthreads();
}

__device__ __forceinline__ void phase_xnorm(const Params& p, int T0, int Mc) {
    const int wave = threadIdx.x >> 6, lane = threadIdx.x & 63;
    us* xn = (us*)(p.ws + p.o_xn);
    f32x4 nw[4];
#pragma unroll
    for (int j = 0; j < 4; ++j) nw[j] = *(const f32x4*)(p.norm_w + lane * 4 + 256 * j);
    for (int r = blockIdx.x * 8 + wave; r < Mc; r += gridDim.x * 8) {
        const float* xr = xrow(p, T0 + r);
        f32x4 v[4]; float ss = 0.f;
#pragma unroll
        for (int j = 0; j < 4; ++j) { v[j] = *(const f32x4*)(xr + lane * 4 + 256 * j); ss += v[j][0] * v[j][0] + v[j][1] * v[j][1] + v[j][2] * v[j][2] + v[j][3] * v[j][3]; }
#pragma unroll
        for (int o = 32; o >= 1; o >>= 1) ss += __shfl_xor(ss, o);
        const float rs = rsqrtf(ss * (1.0f / 1024.0f) + 1e-6f);
#pragma unroll
        for (int j = 0; j < 4; ++j) { u32x2 w; w.x = pk2(v[j][0] * rs * nw[j][0], v[j][1] * rs * nw[j][1]); w.y = pk2(v[j][2] * rs * nw[j][2], v[j][3] * rs * nw[j][3]);
            *(u32x2*)(xn + (size_t)r * 1024 + lane * 4 + 256 * j) = w; }
    }
}

__device__ __forceinline__ void phase_fnorm(const Params& p, int T0, int Mc) {
    const int wave = threadIdx.x >> 6, lane = threadIdx.x & 63;
    f32x4 nw[4];
#pragma unroll
    for (int j = 0; j < 4; ++j) nw[j] = *(const f32x4*)(p.fnw + lane * 4 + 256 * j);
    for (int r = blockIdx.x * 8 + wave; r < Mc; r += gridDim.x * 8) {
        float* xr = p.out + (size_t)(T0 + r) * 1024;
        f32x4 v[4]; float ss = 0.f;
#pragma unroll
        for (int j = 0; j < 4; ++j) { v[j] = *(const f32x4*)(xr + lane * 4 + 256 * j); ss += v[j][0] * v[j][0] + v[j][1] * v[j][1] + v[j][2] * v[j][2] + v[j][3] * v[j][3]; }
#pragma unroll
        for (int o = 32; o >= 1; o >>= 1) ss += __shfl_xor(ss, o);
        const float rs = rsqrtf(ss * (1.0f / 1024.0f) + 1e-6f);
#pragma unroll
        for (int j = 0; j < 4; ++j) { f32x4 w; w[0] = v[j][0] * rs * nw[j][0]; w[1] = v[j][1] * rs * nw[j][1]; w[2] = v[j][2] * rs * nw[j][2]; w[3] = v[j][3] * rs * nw[j][3];
            *(f32x4*)(xr + lane * 4 + 256 * j) = w; }
    }
}

__device__ __forceinline__ void phase_gates(const Params& p, int Mc) {
    const int wave = threadIdx.x >> 6, lane = threadIdx.x & 63, fr = lane & 15, fq = lane >> 4;
    const us* xn = (const us*)(p.ws + p.o_xn);
    const us* wg = (const us*)(p.ws + p.o_winT) + (size_t)(11264 + fr) * 1024 + fq * 8;
    float* gates = (float*)(p.ws + p.o_gates);
    const float bias = p.b_gate[fr];
    for (int task = blockIdx.x * 8 + wave; task < Mc / 16; task += gridDim.x * 8) {
        const us* ar = xn + (size_t)(task * 16 + fr) * 1024 + fq * 8;
        f32x4 acc0 = (f32x4){0.f, 0.f, 0.f, 0.f}, acc1 = acc0;
#pragma unroll 8
        for (int kk = 0; kk < 32; kk += 2) {
            const bf16x8 a0 = *(const bf16x8*)(ar + kk * 32), a1 = *(const bf16x8*)(ar + kk * 32 + 32);
            const bf16x8 b0 = *(const bf16x8*)(wg + kk * 32), b1 = *(const bf16x8*)(wg + kk * 32 + 32);
            acc0 = mfma16(a0, b0, acc0); acc1 = mfma16(a1, b1, acc1);
        }
#pragma unroll
        for (int i = 0; i < 4; ++i) gates[(size_t)(task * 16 + 4 * fq + i) * 16 + fr] = acc0[i] + acc1[i] + bias;
    }
}

__device__ __forceinline__ void phase_conv(const Params& p, int T0, int Mc) {
    const int tid = threadIdx.x, ct = tid & 255, tensor = ct >> 7, cgp = ct & 127, sub = tid >> 8;
    const us* src = actp(p, tensor);
    us* dst = (us*)(p.out + (size_t)T0 * 1024) + (size_t)tensor * Mc * 1024;
    const int ch0 = tensor * 1024 + cgp * 8;
    float w[5][8], b[8];
#pragma unroll
    for (int e = 0; e < 8; ++e) { b[e] = p.conv_b[ch0 + e];
#pragma unroll
        for (int i = 0; i < 5; ++i) w[i][e] = p.conv_w[i * 2048 + ch0 + e]; }
    const float oscale = tensor ? 0.0625f : 1.0f;
    for (int item = blockIdx.x; item < Mc / 32; item += gridDim.x) {
        const int r0 = (item * 2 + sub) * 16;
        int s0, len; seq_of(T0 + r0, s0, len);
        const int lo = s0 - T0, hi = lo + len;
        u32x4 rows[20];
#pragma unroll
        for (int i = 0; i < 20; ++i) { const int r = r0 - 2 + i; rows[i] = (r >= lo && r < hi) ? *(const u32x4*)(src + (size_t)r * 1024 + cgp * 8) : (u32x4){0u, 0u, 0u, 0u}; }
#pragma unroll
        for (int o = 0; o < 16; ++o) {
            float a[8];
#pragma unroll
            for (int e = 0; e < 8; ++e) a[e] = b[e];
#pragma unroll
            for (int i = 0; i < 5; ++i) { const u32x4 rw = rows[o + i];
                a[0] += w[i][0] * bflo(rw.x); a[1] += w[i][1] * bfhi(rw.x); a[2] += w[i][2] * bflo(rw.y); a[3] += w[i][3] * bfhi(rw.y);
                a[4] += w[i][4] * bflo(rw.z); a[5] += w[i][5] * bfhi(rw.z); a[6] += w[i][6] * bflo(rw.w); a[7] += w[i][7] * bfhi(rw.w); }
#pragma unroll
            for (int e = 0; e < 8; ++e) a[e] = siluf_(a[e]) * oscale;
            u32x4 wv; wv.x = pk2(a[0], a[1]); wv.y = pk2(a[2], a[3]); wv.z = pk2(a[4], a[5]); wv.w = pk2(a[6], a[7]);
            *(u32x4*)(dst + (size_t)(r0 + o) * 1024 + cgp * 8) = wv;
        }
    }
}

__device__ __forceinline__ void phase_ya(const Params& p, int Mc) {
    const int wave = threadIdx.x >> 6, lane = threadIdx.x & 63;
    const us* hf = actp(p, 0); const us* hb = actp(p, 1); const us* mo = actp(p, 3); const us* mz = actp(p, 4);
    us* ya = actp(p, 0);
    float mw[16];
#pragma unroll
    for (int i = 0; i < 16; ++i) mw[i] = p.mh_w[lane * 16 + i];
    for (int r = blockIdx.x * 8 + wave; r < Mc; r += gridDim.x * 8) {
        const size_t o = (size_t)r * 1024 + lane * 16;
        float h[16]; float ss = 0.f;
        unsigned zz[8];
#pragma unroll
        for (int c = 0; c < 2; ++c) {
            const u32x4 a = *(const u32x4*)(hf + o + c * 8), b = *(const u32x4*)(hb + o + c * 8), g = *(const u32x4*)(mo + o + c * 8), z = *(const u32x4*)(mz + o + c * 8);
#pragma unroll
            for (int q = 0; q < 4; ++q) { const unsigned aw = a[q], bw = b[q], gw = g[q];
                h[c * 8 + 2 * q] = (bflo(aw) + bflo(bw)) * sigmoidf_(bflo(gw)); h[c * 8 + 2 * q + 1] = (bfhi(aw) + bfhi(bw)) * sigmoidf_(bfhi(gw)); zz[c * 4 + q] = z[q]; }
        }
#pragma unroll
        for (int i = 0; i < 16; ++i) ss += h[i] * h[i];
        ss += __shfl_xor(ss, 1); ss += __shfl_xor(ss, 2); ss += __shfl_xor(ss, 4); ss += __shfl_xor(ss, 8);
        const float rn = rsqrtf(ss * (1.0f / 256.0f) + 1e-6f);
        unsigned w[8];
#pragma unroll
        for (int q = 0; q < 8; ++q) w[q] = pk2(h[2 * q] * rn * mw[2 * q] * siluf_(bflo(zz[q])), h[2 * q + 1] * rn * mw[2 * q + 1] * siluf_(bfhi(zz[q])));
        *(u32x4*)(ya + o) = (u32x4){w[0], w[1], w[2], w[3]}; *(u32x4*)(ya + o + 8) = (u32x4){w[4], w[5], w[6], w[7]};
    }
}

constexpr int ST_REC = 16896;
template <bool STATE_ONLY>
__device__ __forceinline__ void mlstm_chain(const Params& p, unsigned char* shm, int T0, int Mc, int s0, int len, int head, int dir, int split, int c0, int c1,
                                            const float* st_in, int n_prev, float* st_out) {
    LAS unsigned char* lds = (LAS unsigned char*)shm;
    LAS float* sm = (LAS float*)(lds + L_SM);
    const int tid = threadIdx.x, w = tid >> 6, lane = tid & 63, fr = lane & 15, fq = lane >> 4;
    const us* qc = (const us*)(p.out + (size_t)T0 * 1024); const us* kc = qc + (size_t)Mc * 1024;
    const us* mv = actp(p, 2); const float* gates = (const float*)(p.ws + p.o_gates);
    us* hout = actp(p, dir);
    const int base = dir ? (s0 + len - 1 - T0) : (s0 - T0); const int sgn = dir ? -1 : 1;
    const size_t hoff = (size_t)head * 256;
    u32x4 rq[4], rk[4], rv;
    LAS float* GU = (LAS float*)(lds + L_GU); LAS float* GC = (LAS float*)(lds + L_GC); LAS float* GB = (LAS float*)(lds + L_GB); LAS float* GM = (LAS float*)(lds + L_GM); LAS unsigned char* NBF = lds + L_NP;
    f32x4 Sacc[2][5];
#pragma unroll
    for (int a = 0; a < 2; ++a)
#pragma unroll
        for (int b = 0; b < 5; ++b) Sacc[a][b] = (f32x4){0.f, 0.f, 0.f, 0.f};
    float mstate = 0.f;
    if constexpr (!STATE_ONLY) {
        float nval = 0.f;
        for (int g = 0; g < n_prev; ++g) { const float* rec = st_in + (size_t)g * ST_REC; const float m_loc = rec[16640], B = rec[16641];
            const float m_new = fmaxf(B + mstate, m_loc), a1 = __expf(B + mstate - m_new), a2 = __expf(m_loc - m_new);
#pragma unroll
            for (int dd = 0; dd < 2; ++dd)
#pragma unroll
                for (int e4 = 0; e4 < 4; ++e4) { const f32x4 sl = *(const f32x4*)(rec + (size_t)((((w * 2 + dd) * 4 + e4) * 64 + lane) * 4)); Sacc[dd][e4] = a1 * Sacc[dd][e4] + a2 * sl; }
            if (tid < 256) nval = a1 * nval + a2 * rec[16384 + tid];
            mstate = m_new; }
        if (tid < 256) sm[SM_N + tid] = nval;
        __syncthreads();
#pragma unroll
        for (int dd = 0; dd < 2; ++dd)
#pragma unroll
            for (int i = 0; i < 4; ++i) Sacc[dd][4][i] = (fr == 0) ? sm[SM_N + (w * 2 + dd) * 16 + 4 * fq + i] : 0.f;
        if (fr == 0) {
#pragma unroll
            for (int dd = 0; dd < 2; ++dd) { u32x2 nb; nb.x = pk2(Sacc[dd][4][0], Sacc[dd][4][1]); nb.y = pk2(Sacc[dd][4][2], Sacc[dd][4][3]); *(LAS u32x2*)(NBF + ((w * 2 + dd) * 16 + 4 * fq) * 2) = nb; }
        }
#pragma unroll
        for (int dd = 0; dd < 2; ++dd)
#pragma unroll
            for (int e4 = 0; e4 < 4; ++e4) { const f32x4 sv = Sacc[dd][e4]; u32x2 wv; wv.x = pk2(sv[0], sv[1]); wv.y = pk2(sv[2], sv[3]);
                *(LAS u32x2*)(lds + L_ST + (e4 * 16 + fr) * QS + ((w * 2 + dd) * 16 + 4 * fq) * 2) = wv; }
    } else {
        if (tid < 256) sm[SM_N + tid] = 0.f;
    }
#define CH_LOAD(c) do { \
        _Pragma("unroll") for (int i = 0; i < 4; ++i) { const int id = tid + 512 * i, row = id >> 5, ch = id & 31; const size_t lr = (size_t)(base + sgn * ((c) * 64 + row)); \
            if (!STATE_ONLY) rq[i] = *(const u32x4*)(qc + lr * 1024 + hoff + ch * 8); rk[i] = *(const u32x4*)(kc + lr * 1024 + hoff + ch * 8); } \
        { const int row = tid >> 3, ch = tid & 7; const size_t lr = (size_t)(base + sgn * ((c) * 64 + row)); rv = *(const u32x4*)(mv + lr * 1024 + hoff + split * 64 + ch * 8); } \
 } while (0)
#define CH_STORE() do { \
        _Pragma("unroll") for (int i = 0; i < 4; ++i) { const int id = tid + 512 * i, row = id >> 5, ch = id & 31; \
            if (!STATE_ONLY) *(LAS u32x4*)(lds + L_Q + row * QS + ch * 16) = rq[i]; *(LAS u32x4*)(lds + L_K + row * QS + ch * 16) = rk[i]; } \
        { const int row = tid >> 3, ch = tid & 7; *(LAS u32x4*)(lds + L_V + row * VS + ch * 16) = rv; } } while (0)
    CH_LOAD(c0);
    for (int cc = w; cc < c1 - c0; cc += 8) {
        const size_t lr = (size_t)(base + sgn * ((c0 + cc) * 64 + lane));
        const float li = gates[lr * 16 + dir * 8 + head], gfv = gates[lr * 16 + dir * 8 + 4 + head];
        const float lf = fminf(gfv, 0.f) - log1pf(__expf(-fabsf(gfv)));
        float b = lf;
#pragma unroll
        for (int o = 1; o < 64; o <<= 1) { const float t = __shfl_up(b, o); if (lane >= o) b += t; }
        const float u = li - b; float cm = u;
#pragma unroll
        for (int o = 1; o < 64; o <<= 1) { const float t = __shfl_up(cm, o); if (lane >= o) cm = fmaxf(cm, t); }
        GU[cc * 64 + lane] = u; GC[cc * 64 + lane] = cm; GB[cc * 64 + lane] = b;
    }
    CH_STORE();
    __syncthreads();
    if (tid == 0) { float m = mstate, bt = 0.f;
        for (int cc = 0; cc < c1 - c0; ++cc) { GM[cc] = m; const float M63 = fmaxf(m, GC[cc * 64 + 63]), b63 = GB[cc * 64 + 63]; m = b63 + M63; bt += b63; }
        GM[32] = m; GM[33] = bt; }
    __syncthreads();
    const int tA = w & 3, jt0 = (w >> 2) * 2;
    for (int c = c0; c < c1; ++c) {
        if (c + 1 < c1) CH_LOAD(c + 1);
        const int cg_ = (c - c0) * 64; const float m_c = GM[c - c0]; const float M63 = fmaxf(m_c, GC[cg_ + 63]);
        f32x4 h0 = (f32x4){0.f, 0.f, 0.f, 0.f}, h1 = h0, qn0 = h0, qn1 = h0;
        if constexpr (!STATE_ONLY) {
            f32x4 sc0 = (f32x4){0.f, 0.f, 0.f, 0.f}, sc1 = sc0;
#pragma unroll 4
            for (int kk = 0; kk < 8; ++kk) {
                const bf16x8 a = *(LAS bf16x8*)(lds + L_K + (tA * 16 + fr) * QS + kk * 64 + fq * 16);
                const bf16x8 a2 = *(LAS bf16x8*)(lds + L_ST + (tA * 16 + fr) * QS + kk * 64 + fq * 16);
                const bf16x8 b0 = *(LAS bf16x8*)(lds + L_Q + (jt0 * 16 + fr) * QS + kk * 64 + fq * 16);
                const bf16x8 b1 = *(LAS bf16x8*)(lds + L_Q + ((jt0 + 1) * 16 + fr) * QS + kk * 64 + fq * 16);
                sc0 = mfma16(a, b0, sc0); sc1 = mfma16(a, b1, sc1);
                h0 = mfma16(a2, b0, h0); h1 = mfma16(a2, b1, h1);
                const bf16x8 nf = *(LAS bf16x8*)(NBF + kk * 64 + fq * 16);
                qn0 = mfma16(nf, b0, qn0); qn1 = mfma16(nf, b1, qn1);
            }
            const int sb = tA * 16 + 4 * fq;
            const f32x4 uv = *(LAS f32x4*)(GU + cg_ + sb);
#pragma unroll
            for (int jt = 0; jt < 2; ++jt) { const int j = (jt0 + jt) * 16 + fr; const float Mj = fmaxf(m_c, GC[cg_ + j]); const f32x4 sc = jt ? sc1 : sc0;
                float v[4];
#pragma unroll
                for (int i = 0; i < 4; ++i) v[i] = (sb + i <= j) ? sc[i] * __expf(uv[i] - Mj) : 0.f;
                u32x2 wv; wv.x = pk2(v[0], v[1]); wv.y = pk2(v[2], v[3]);
                *(LAS u32x2*)(lds + L_P + j * VS + sb * 2) = wv;
                }
        }
        {
            const int s = tid >> 3, ch = tid & 7; const float ws_ = __expf(GU[cg_ + s] - M63); const u32x4 vv = *(LAS u32x4*)(lds + L_V + s * VS + ch * 16);
            u32x4 o; o.x = pk2(bflo(vv.x) * ws_, bfhi(vv.x) * ws_); o.y = pk2(bflo(vv.y) * ws_, bfhi(vv.y) * ws_); o.z = pk2(bflo(vv.z) * ws_, bfhi(vv.z) * ws_); o.w = pk2(bflo(vv.w) * ws_, bfhi(vv.w) * ws_);
            *(LAS u32x4*)(lds + L_VW + s * VSW + ch * 16) = o;
            if (ch == 0) { *(LAS u32x4*)(lds + L_VW + s * VSW + 128) = (u32x4){pk2(ws_, 0.f), 0u, 0u, 0u}; *(LAS u32x4*)(lds + L_VW + s * VSW + 144) = (u32x4){0u, 0u, 0u, 0u}; }
        }
        bf16x8 pkf[2][2], pvf[2];
#pragma unroll
        for (int ks = 0; ks < 2; ++ks) { const int rbase = ks * 32 + 8 * fq + (fr >> 2);
#pragma unroll
            for (int dd = 0; dd < 2; ++dd) { const int o0 = rbase * QS + ((w * 2 + dd) * 16 + 4 * (fr & 3)) * 2; pkf[ks][dd] = tr8(lds + L_K, o0, o0 + 4 * QS); }
            if constexpr (!STATE_ONLY) { const int o0 = rbase * VS + (tA * 16 + 4 * (fr & 3)) * 2; pvf[ks] = tr8(lds + L_V, o0, o0 + 4 * VS); } }
        __syncthreads();
        if (c + 1 < c1) { CH_STORE(); }
        if constexpr (!STATE_ONLY) {
            const int j0 = jt0 * 16 + fr, j1 = j0 + 16;
            const float Mj0 = fmaxf(m_c, GC[cg_ + j0]), Mj1 = fmaxf(m_c, GC[cg_ + j1]);
            const float wi0 = __expf(m_c - Mj0), wi1 = __expf(m_c - Mj1);
            h0 *= wi0; h1 *= wi1;
            f32x4 rs0 = (f32x4){0.f, 0.f, 0.f, 0.f}, rs1 = rs0;
            const bf16x8 ones = (bf16x8){(short)0x3F80, (short)0x3F80, (short)0x3F80, (short)0x3F80, (short)0x3F80, (short)0x3F80, (short)0x3F80, (short)0x3F80};
#pragma unroll
            for (int ks = 0; ks < 2; ++ks) {
                const bf16x8 a = pvf[ks];
                const bf16x8 b0 = *(LAS bf16x8*)(lds + L_P + j0 * VS + ks * 64 + fq * 16);
                const bf16x8 b1 = *(LAS bf16x8*)(lds + L_P + j1 * VS + ks * 64 + fq * 16);
                h0 = mfma16(a, b0, h0); h1 = mfma16(a, b1, h1);
                rs0 = mfma16(ones, b0, rs0); rs1 = mfma16(ones, b1, rs1);
            }
            const float den0 = wi0 * qn0[0] + rs0[0], den1 = wi1 * qn1[0] + rs1[0];
            const float sc0 = __builtin_amdgcn_rcpf(fmaxf(fabsf(den0), __expf(-GB[cg_ + j0] - Mj0))), sc1 = __builtin_amdgcn_rcpf(fmaxf(fabsf(den1), __expf(-GB[cg_ + j1] - Mj1)));
            h0 *= sc0; h1 *= sc1;
            const size_t lr0 = (size_t)(base + sgn * (c * 64 + j0)), lr1 = (size_t)(base + sgn * (c * 64 + j1));
            const int eo = split * 64 + tA * 16 + 4 * fq;
            u32x2 w0, w1; w0.x = pk2(h0[0], h0[1]); w0.y = pk2(h0[2], h0[3]); w1.x = pk2(h1[0], h1[1]); w1.y = pk2(h1[2], h1[3]);
            *(u32x2*)(hout + lr0 * 1024 + hoff + eo) = w0; *(u32x2*)(hout + lr1 * 1024 + hoff + eo) = w1;
        }
        {
            const float a_ = __expf(m_c - M63);
#pragma unroll
            for (int dd = 0; dd < 2; ++dd)
#pragma unroll
                for (int e4 = 0; e4 < 5; ++e4) Sacc[dd][e4] *= a_;
#pragma unroll
            for (int ks = 0; ks < 2; ++ks) {
                const int rbase = ks * 32 + 8 * fq + (fr >> 2);
                bf16x8 A[2], B[5];
#pragma unroll
                for (int dd = 0; dd < 2; ++dd) A[dd] = pkf[ks][dd];
#pragma unroll
                for (int e4 = 0; e4 < 5; ++e4) { const int o0 = rbase * VSW + (e4 * 16 + 4 * (fr & 3)) * 2; B[e4] = tr8(lds + L_VW, o0, o0 + 4 * VSW); }
#pragma unroll
                for (int dd = 0; dd < 2; ++dd)
#pragma unroll
                    for (int e4 = 0; e4 < 5; ++e4) Sacc[dd][e4] = mfma16(A[dd], B[e4], Sacc[dd][e4]);
            }
            if constexpr (!STATE_ONLY) {
#pragma unroll
                for (int dd = 0; dd < 2; ++dd)
#pragma unroll
                    for (int e4 = 0; e4 < 4; ++e4) { const f32x4 sv = Sacc[dd][e4]; u32x2 wv; wv.x = pk2(sv[0], sv[1]); wv.y = pk2(sv[2], sv[3]);
                        *(LAS u32x2*)(lds + L_ST + (e4 * 16 + fr) * QS + ((w * 2 + dd) * 16 + 4 * fq) * 2) = wv; }
            }
            if (fr == 0) {
#pragma unroll
                for (int dd = 0; dd < 2; ++dd) { *(LAS f32x4*)(sm + SM_N + (w * 2 + dd) * 16 + 4 * fq) = Sacc[dd][4];
                    if (!STATE_ONLY) { u32x2 nb; nb.x = pk2(Sacc[dd][4][0], Sacc[dd][4][1]); nb.y = pk2(Sacc[dd][4][2], Sacc[dd][4][3]); *(LAS u32x2*)(NBF + ((w * 2 + dd) * 16 + 4 * fq) * 2) = nb; } }
            }
        }
        __syncthreads();
    }
#undef CH_LOAD
#undef CH_STORE
    if constexpr (STATE_ONLY) {
#pragma unroll
        for (int dd = 0; dd < 2; ++dd)
#pragma unroll
            for (int e4 = 0; e4 < 4; ++e4) *(f32x4*)(st_out + (size_t)((((w * 2 + dd) * 4 + e4) * 64 + lane) * 4)) = Sacc[dd][e4];
        if (tid < 256) st_out[16384 + tid] = sm[SM_N + tid];
        if (tid == 0) { st_out[16640] = GM[32]; st_out[16641] = GM[33]; }
    }
}

__device__ __forceinline__ void na_item(const Params& p, unsigned char* shm, int T0, int gpair, int head) {
    LAS unsigned char* lds = (LAS unsigned char*)shm;
    LAS float* rpbs = (LAS float*)(lds + L_RPB);
    constexpr int VOFF = 73728;
    const int tid = threadIdx.x, w = tid >> 6, lane = tid & 63, fr = lane & 15, fq = lane >> 4;
    const int n = w & 3, rr = w >> 2;
    const us* nq = actp(p, 5); const us* nk = actp(p, 6); const us* nv = actp(p, 7); const us* nz = actp(p, 8);
    us* yb = (us*)(p.ws + p.o_xn);
    const size_t hstr = (size_t)p.Mr * 64;
    const int tokA = T0 + gpair * 128; int s0, len; seq_of(tokA, s0, len);
    const int rows = len / 64, r0 = (tokA - s0) / 64, r = r0 + rr;
    const int rsb = min(max(r0 - 4, 0), rows - 8), rs1 = min(max(r0 - 3, 0), rows - 8);
    const int rs = rr ? rs1 : rsb;
    const int nkeys = (rs1 + 8 - rsb) * 64;
    const int wl0 = s0 + rsb * 64 - T0;
    const int kb = min(max(16 * n - 8, 0), 32);
    const size_t lrq = (size_t)(tokA - T0 + rr * 64 + 16 * n + fr);
    u32x4 kreg[9], vreg[9];
#pragma unroll
    for (int i = 0; i < 9; ++i) { const int id = tid + 512 * i, key = id >> 3, ch = id & 7;
        if (key < nkeys) { kreg[i] = *(const u32x4*)(nk + (size_t)head * hstr + (size_t)(wl0 + key) * 64 + ch * 8); vreg[i] = *(const u32x4*)(nv + (size_t)head * hstr + (size_t)(wl0 + key) * 64 + ch * 8); } }
    bf16x8 qf[2];
#pragma unroll
    for (int ks = 0; ks < 2; ++ks) qf[ks] = *(const bf16x8*)(nq + head * hstr + lrq * 64 + ks * 32 + fq * 8);
    float rp0 = 0.f;
    if (tid < 465) rp0 = p.rpb[head * 465 + tid] * 1.44269504f;
#pragma unroll
    for (int i = 0; i < 9; ++i) { const int id = tid + 512 * i, key = id >> 3, ch = id & 7;
        if (key < nkeys) { const int o = key * 128 + ((ch ^ (key & 7)) * 16); *(LAS u32x4*)(lds + o) = kreg[i]; *(LAS u32x4*)(lds + VOFF + o) = vreg[i]; } }
    if (tid < 465) rpbs[tid] = rp0;
    __syncthreads();
    u32x2 zreg[4];
#pragma unroll
    for (int dt = 0; dt < 4; ++dt) zreg[dt] = *(const u32x2*)(nz + lrq * 1024 + head * 64 + dt * 16 + 4 * fq);
    f32x4 s[16];
    const int krow0 = (rs - rsb) * 64 + kb + fr;
#pragma unroll
    for (int t = 0; t < 16; ++t) { s[t] = (f32x4){0.f, 0.f, 0.f, 0.f};
        const int key = krow0 + (t >> 1) * 64 + 16 * (t & 1);
#pragma unroll
        for (int ks = 0; ks < 2; ++ks) { const bf16x8 kf = *(LAS bf16x8*)(lds + key * 128 + (((ks * 4 + fq) ^ (key & 7)) * 16)); s[t] = mfma16(kf, qf[ks], s[t]); } }
    const int c = 16 * n + fr, cs = min(max(c - 8, 0), 48);
    bool vf[2][4];
#pragma unroll
    for (int hf2 = 0; hf2 < 2; ++hf2)
#pragma unroll
        for (int i = 0; i < 4; ++i) vf[hf2][i] = (unsigned)(kb + 16 * hf2 + 4 * fq + i - cs) < 16u;
    LAS float* bp = rpbs + ((rs - r + 7) * 31 + (kb - 16 * n + 4 * fq - fr + 15));
    float mx = -1e30f;
#pragma unroll
    for (int t = 0; t < 16; ++t)
#pragma unroll
        for (int i = 0; i < 4; ++i) { const float v = vf[t & 1][i] ? s[t][i] * 0.18033688f + bp[(t >> 1) * 31 + 16 * (t & 1) + i] : -1e30f; s[t][i] = v; mx = fmaxf(mx, v); }
    mx = fmaxf(mx, __shfl_xor(mx, 16)); mx = fmaxf(mx, __shfl_xor(mx, 32));
    float sum = 0.f;
#pragma unroll
    for (int t = 0; t < 16; ++t)
#pragma unroll
        for (int i = 0; i < 4; ++i) { const float e = __builtin_amdgcn_exp2f(s[t][i] - mx); s[t][i] = e; sum += e; }
    sum += __shfl_xor(sum, 16); sum += __shfl_xor(sum, 32);
    f32x4 o[4];
#pragma unroll
    for (int dt = 0; dt < 4; ++dt) o[dt] = (f32x4){0.f, 0.f, 0.f, 0.f};
    const int vrow0 = (rs - rsb) * 64 + kb + 4 * fq + (fr >> 2), pch = (fr & 3) >> 1, phalf = (fr & 3) & 1;
#pragma unroll
    for (int kk = 0; kk < 8; ++kk) {
        u32x4 pw; pw.x = pk2(s[2 * kk][0], s[2 * kk][1]); pw.y = pk2(s[2 * kk][2], s[2 * kk][3]); pw.z = pk2(s[2 * kk + 1][0], s[2 * kk + 1][1]); pw.w = pk2(s[2 * kk + 1][2], s[2 * kk + 1][3]);
        const bf16x8 pf = __builtin_bit_cast(bf16x8, pw);
        const int k0 = vrow0 + kk * 64, k1 = k0 + 16;
#pragma unroll
        for (int dt = 0; dt < 4; ++dt) { const int chunk = 2 * dt + pch;
            const bf16x8 a = tr8(lds + VOFF, k0 * 128 + ((chunk ^ (k0 & 7)) * 16) + phalf * 8, k1 * 128 + ((chunk ^ (k1 & 7)) * 16) + phalf * 8); o[dt] = mfma16(a, pf, o[dt]); }
    }
    const float inv = __builtin_amdgcn_rcpf(sum);
#pragma unroll
    for (int dt = 0; dt < 4; ++dt) { const size_t off = lrq * 1024 + head * 64 + dt * 16 + 4 * fq; const u32x2 z = zreg[dt];
        u32x2 wv; wv.x = pk2(o[dt][0] * inv * siluf_(bflo(z.x)), o[dt][1] * inv * siluf_(bfhi(z.x))); wv.y = pk2(o[dt][2] * inv * siluf_(bflo(z.y)), o[dt][3] * inv * siluf_(bfhi(z.y)));
        *(u32x2*)(yb + off) = wv; }
}

struct NaGeom { int s0, rows, r0, rsb, rs1; };
__device__ __forceinline__ NaGeom na_geom(int T0, int gpair) {
    NaGeom g; const int tokA = T0 + gpair * 128; int len; seq_of(tokA, g.s0, len);
    g.rows = len / 64; g.r0 = (tokA - g.s0) / 64;
    g.rsb = min(max(g.r0 - 4, 0), g.rows - 8); g.rs1 = min(max(g.r0 - 3, 0), g.rows - 8); return g;
}
__device__ __forceinline__ void na_band(const Params& p, unsigned char* shm, int T0, int Mc) {
    LAS unsigned char* lds = (LAS unsigned char*)shm;
    LAS float* rpbs = (LAS float*)(lds + L_RPB);
    constexpr int VOFF = 73728;
    const int tid = threadIdx.x, w = tid >> 6, lane = tid & 63, fr = lane & 15, fq = lane >> 4;
    const int n = w & 3, rr = w >> 2;
    const int head = blockIdx.x & 15, band = blockIdx.x >> 4, ppb = (Mc / 128) / 16;
    const us* nq = actp(p, 5) + (size_t)head * p.Mr * 64; const us* nk = actp(p, 6) + (size_t)head * p.Mr * 64; const us* nv = actp(p, 7) + (size_t)head * p.Mr * 64;
    const us* nz = actp(p, 8); us* yb = (us*)(p.ws + p.o_xn);
    const int kb = min(max(16 * n - 8, 0), 32);
    const int c = 16 * n + fr, cs = min(max(c - 8, 0), 48);
    const int ccol = tid >> 3, cch = tid & 7;
    const int cswz = (ccol * 128) + ((cch ^ ((ccol >> 1) & 7)) * 16);
    if (tid < 465) rpbs[tid] = p.rpb[head * 465 + tid] * 1.44269504f;
    bool vf[2][4];
#pragma unroll
    for (int hf2 = 0; hf2 < 2; ++hf2)
#pragma unroll
        for (int i = 0; i < 4; ++i) vf[hf2][i] = (unsigned)(kb + 16 * hf2 + 4 * fq + i - cs) < 16u;
    u32x4 kpf[2], vpf[2]; bf16x8 qfn[2];
    int prev_hi = 0, prev_s0 = -1;
    {
        const int gp0 = band * ppb; const size_t lq = (size_t)(gp0 * 128 + rr * 64 + 16 * n + fr);
#pragma unroll
        for (int ks = 0; ks < 2; ++ks) qfn[ks] = *(const bf16x8*)(nq + lq * 64 + ks * 32 + fq * 8);
    }
    for (int k = 0; k < ppb; ++k) {
        const int gpair = band * ppb + k; const NaGeom g = na_geom(T0, gpair);
        const int hi = g.rs1 + 8; const bool fresh = (g.s0 != prev_s0);
        const int r = g.r0 + rr, rs = rr ? g.rs1 : g.rsb;
        const size_t lrq = (size_t)(gpair * 128 + rr * 64 + 16 * n + fr);
        const size_t rowbase = (size_t)(g.s0 - T0) * 64 + (size_t)ccol * 64 + cch * 8;
        __syncthreads();
        if (fresh) {
            u32x4 kreg[9], vreg[9];
#pragma unroll
            for (int i = 0; i < 9; ++i) { const int R = g.rsb + i; if (R < hi) { kreg[i] = *(const u32x4*)(nk + rowbase + (size_t)R * 4096); vreg[i] = *(const u32x4*)(nv + rowbase + (size_t)R * 4096); } }
#pragma unroll
            for (int i = 0; i < 9; ++i) { const int R = g.rsb + i; if (R < hi) { const int o = (R % 9) * 8192 + cswz; *(LAS u32x4*)(lds + o) = kreg[i]; *(LAS u32x4*)(lds + VOFF + o) = vreg[i]; } }
        } else {
#pragma unroll
            for (int i = 0; i < 2; ++i) { const int R = prev_hi + i; if (R < hi) { const int o = (R % 9) * 8192 + cswz; *(LAS u32x4*)(lds + o) = kpf[i]; *(LAS u32x4*)(lds + VOFF + o) = vpf[i]; } }
        }
        const bf16x8 qf0 = qfn[0], qf1 = qfn[1];
        __syncthreads();
        u32x2 zreg[4];
#pragma unroll
        for (int dt = 0; dt < 4; ++dt) zreg[dt] = *(const u32x2*)(nz + lrq * 1024 + head * 64 + dt * 16 + 4 * fq);
        if (k + 1 < ppb) {
            const NaGeom g2 = na_geom(T0, gpair + 1); const int hi2 = g2.rs1 + 8;
            if (g2.s0 == g.s0) {
#pragma unroll
                for (int i = 0; i < 2; ++i) { const int R = hi + i; if (R < hi2) { kpf[i] = *(const u32x4*)(nk + rowbase + (size_t)R * 4096); vpf[i] = *(const u32x4*)(nv + rowbase + (size_t)R * 4096); } }
            }
            const size_t lq = (size_t)((gpair + 1) * 128 + rr * 64 + 16 * n + fr);
#pragma unroll
            for (int ks = 0; ks < 2; ++ks) qfn[ks] = *(const bf16x8*)(nq + lq * 64 + ks * 32 + fq * 8);
        }
        prev_hi = hi; prev_s0 = g.s0;
        int slot[8];
#pragma unroll
        for (int i = 0; i < 8; ++i) slot[i] = (rs + i) % 9;
        f32x4 s[16];
#pragma unroll
        for (int t = 0; t < 16; ++t) { s[t] = (f32x4){0.f, 0.f, 0.f, 0.f};
            const int key = slot[t >> 1] * 64 + kb + 16 * (t & 1) + fr;
            const bf16x8 kf0 = *(LAS bf16x8*)(lds + key * 128 + (((0 + fq) ^ ((key >> 1) & 7)) * 16)), kf1 = *(LAS bf16x8*)(lds + key * 128 + (((4 + fq) ^ ((key >> 1) & 7)) * 16));
            s[t] = mfma16(kf0, qf0, s[t]); s[t] = mfma16(kf1, qf1, s[t]); }
        LAS float* bp = rpbs + ((rs - r + 7) * 31 + (kb - 16 * n + 4 * fq - fr + 15));
        float mx = -1e30f;
#pragma unroll
        for (int t = 0; t < 16; ++t)
#pragma unroll
            for (int i = 0; i < 4; ++i) { const float v = vf[t & 1][i] ? s[t][i] * 0.18033688f + bp[(t >> 1) * 31 + 16 * (t & 1) + i] : -1e30f; s[t][i] = v; mx = fmaxf(mx, v); }
        mx = fmaxf(mx, __shfl_xor(mx, 16)); mx = fmaxf(mx, __shfl_xor(mx, 32));
        float sum = 0.f;
#pragma unroll
        for (int t = 0; t < 16; ++t)
#pragma unroll
            for (int i = 0; i < 4; ++i) { const float e = __builtin_amdgcn_exp2f(s[t][i] - mx); s[t][i] = e; sum += e; }
        sum += __shfl_xor(sum, 16); sum += __shfl_xor(sum, 32);
        f32x4 o[4];
#pragma unroll
        for (int dt = 0; dt < 4; ++dt) o[dt] = (f32x4){0.f, 0.f, 0.f, 0.f};
        const int vcol0 = kb + 4 * fq + (fr >> 2), pch = (fr & 3) >> 1, phalf = (fr & 3) & 1;
#pragma unroll
        for (int kk = 0; kk < 8; ++kk) {
            u32x4 pw; pw.x = pk2(s[2 * kk][0], s[2 * kk][1]); pw.y = pk2(s[2 * kk][2], s[2 * kk][3]); pw.z = pk2(s[2 * kk + 1][0], s[2 * kk + 1][1]); pw.w = pk2(s[2 * kk + 1][2], s[2 * kk + 1][3]);
            const bf16x8 pf = __builtin_bit_cast(bf16x8, pw);
            const int k0 = slot[kk] * 64 + vcol0, k1 = k0 + 16;
#pragma unroll
            for (int dt = 0; dt < 4; ++dt) { const int chunk = 2 * dt + pch;
                const bf16x8 a = tr8(lds + VOFF, k0 * 128 + ((chunk ^ ((k0 >> 1) & 7)) * 16) + phalf * 8, k1 * 128 + ((chunk ^ ((k1 >> 1) & 7)) * 16) + phalf * 8); o[dt] = mfma16(a, pf, o[dt]); }
        }
        const float inv = __builtin_amdgcn_rcpf(sum);
#pragma unroll
        for (int dt = 0; dt < 4; ++dt) { const size_t off = lrq * 1024 + head * 64 + dt * 16 + 4 * fq; const u32x2 z = zreg[dt];
            u32x2 wv; wv.x = pk2(o[dt][0] * inv * siluf_(bflo(z.x)), o[dt][1] * inv * siluf_(bfhi(z.x))); wv.y = pk2(o[dt][2] * inv * siluf_(bflo(z.y)), o[dt][3] * inv * siluf_(bfhi(z.y)));
            *(u32x2*)(yb + off) = wv; }
    }
}

__device__ __forceinline__ void phase_mix(const Params& p, unsigned char* shm, int T0, int Mc, int cidx, int flags) {
    float* state = (float*)(p.ws + p.o_state);
    const int n_pre = (flags & 1) ? 7 * 32 : 0;
    const int n_chain = (flags & 2) ? (Mc / UNIT) * 32 : 0;
    const int n_na = (flags & 4) ? (Mc / 128) * 16 : 0;
    for (int item = blockIdx.x; item < n_pre; item += gridDim.x) { __syncthreads();
        const int g = item >> 5, combo = item & 31;
        mlstm_chain<true>(p, shm, T0, Mc, 0, TOK_P, combo & 3, (combo >> 2) & 1, combo >> 3, 32 * g, 32 * g + 32, nullptr, 0, state + (size_t)(combo * 8 + g) * ST_REC); }
    for (int item = blockIdx.x; item < n_chain; item += gridDim.x) { __syncthreads();
        const int si = item >> 5, combo = item & 31;
        if (T0 == 0 && si < 8) mlstm_chain<false>(p, shm, T0, Mc, 0, TOK_P, combo & 3, (combo >> 2) & 1, combo >> 3, 32 * si, 32 * si + 32, state + (size_t)(combo * 8) * ST_REC, si, nullptr);
        else mlstm_chain<false>(p, shm, T0, Mc, T0 + si * UNIT, UNIT, combo & 3, (combo >> 2) & 1, combo >> 3, 0, 32, nullptr, 0, nullptr); }
    if (n_na) { __syncthreads();
        if (gridDim.x == 256) na_band(p, shm, T0, Mc);
        else for (int idx = blockIdx.x; idx < n_na; idx += gridDim.x) { __syncthreads(); na_item(p, shm, T0, idx >> 4, idx & 15); } }
    __syncthreads();
}

#define XB_TMO      128
#define XB_XCNT(j)  (256  + 64 * (j))
#define XB_XSUB(j)  (1280 + 64 * (j))
#define XB_XGEN(j)  (2304 + 64 * (j))
#define XB_TOP      3328
#define XB_TOPGEN   3392
#define XCD_BAR_WORDS 3456
#define XB_SPIN_CAP (1u << 18)
#define XB_TOP      3328
#define XB_TOPGEN   3392
#define XCD_BAR_WORDS 3456
#define XB_SPIN_CAP (1u << 18)

__device__ __forceinline__ unsigned xb_ld(unsigned* p)              { return __hip_atomic_load(p, __ATOMIC_RELAXED, __HIP_MEMORY_SCOPE_AGENT); }
__device__ __forceinline__ unsigned xb_add(unsigned* p, unsigned v) { return __hip_atomic_fetch_add(p, v, __ATOMIC_RELAXED, __HIP_MEMORY_SCOPE_AGENT); }
__device__ __forceinline__ unsigned xb_xcc_id() { return (unsigned)__builtin_amdgcn_s_getreg((3 << 11) | 20) & 0xFu; }
#define XB_SPIN(cond, bar) do { unsigned _sp = 0; while (cond) { __builtin_amdgcn_s_sleep(1); \
    if ((++_sp & 255u) == 0u) { if (xb_ld(&(bar)[XB_TMO])) break; if (_sp > XB_SPIN_CAP) { atomicAdd(&(bar)[XB_TMO], 1u); break; } } } } while (0)

struct XcdBarrier {
    unsigned* bar; unsigned x;
    volatile LAS unsigned* st;
};

__device__ __forceinline__ XcdBarrier xcd_barrier_post(unsigned* bar, volatile LAS unsigned* st) {
    XcdBarrier b; b.bar = bar; b.x = xb_xcc_id(); b.st = st;
    if (threadIdx.x == 0) (void)xb_add(&bar[XB_XCNT(b.x)], 1u);
    return b;
}
__device__ __forceinline__ void xcd_barrier_complete(unsigned* bar, unsigned x, unsigned& nloc, unsigned& nx) {
    const unsigned G = gridDim.x * gridDim.y * gridDim.z;
    unsigned sum, cnt, mine, sp = 0u;
    for (;;) {
        sum = 0u; cnt = 0u; mine = 0u;
#pragma unroll
        for (unsigned j = 0; j < 16; ++j) { const unsigned c = xb_ld(&bar[XB_XCNT(j)]); sum += c; cnt += (c > 0u) ? 1u : 0u; mine = (j == x) ? c : mine; }
        if (sum == G) break;
        __builtin_amdgcn_s_sleep(1);
        if ((++sp & 255u) == 0u) { if (xb_ld(&bar[XB_TMO])) break; if (sp > XB_SPIN_CAP) { atomicAdd(&bar[XB_TMO], 1u); break; } }
    }
    nloc = mine > 0u ? mine : 1u; nx = cnt > 0u ? cnt : 1u;
}

__device__ __forceinline__ void xcd_barrier(const XcdBarrier& b) {
    asm volatile("s_waitcnt vmcnt(0)" ::: "memory");
    __syncthreads();
    if (threadIdx.x == 0) {
        unsigned* bar = b.bar;
        __builtin_amdgcn_s_waitcnt(0);
        unsigned nloc = b.st[0], nx = b.st[1];
        if (nloc == 0u) { xcd_barrier_complete(bar, b.x, nloc, nx); b.st[0] = nloc; b.st[1] = nx; }
        const unsigned old = xb_add(&bar[XB_XSUB(b.x)], 1u);
        const unsigned gen = old / nloc;
        if (old + 1u == (gen + 1u) * nloc) {
            __builtin_amdgcn_fence(__ATOMIC_RELEASE, "agent");
            asm volatile("s_waitcnt vmcnt(0)" ::: "memory");
            const unsigned og = xb_add(&bar[XB_TOP], 1u);
            const unsigned tg = og / nx;
            if (og + 1u == (tg + 1u) * nx) xb_add(&bar[XB_TOPGEN], 1u);
            else XB_SPIN(xb_ld(&bar[XB_TOPGEN]) == tg, bar);
            __builtin_amdgcn_fence(__ATOMIC_ACQUIRE, "agent");
            xb_add(&bar[XB_XGEN(b.x)], 1u);
            asm volatile("s_waitcnt vmcnt(0)" ::: "memory");
        } else {
            XB_SPIN(xb_ld(&bar[XB_XGEN(b.x)]) == gen, bar);
            __builtin_amdgcn_fence(__ATOMIC_ACQUIRE, "agent");
            asm volatile("s_waitcnt vmcnt(0)" ::: "memory");
        }
    }
    __syncthreads();
}

#ifndef PHM
#define PHM 0xFFF
#endif
#define IN(k) (lo <= (k) && (k) < hi)
#define INB(b, k) (((PHM >> (b)) & 1) && IN(k))
#define SEAM(k) do { if (IN(k) && IN((k) + 1)) xcd_barrier(bar); } while (0)
__device__ __forceinline__ void round_body(const Params& p, unsigned char* shm, const XcdBarrier& bar, const int round, const int lo, const int hi) {
    const int T0 = round * p.Mr, pb = 1 + 8 * round;
    const int Mc = (TOK_ALL - T0) < p.Mr ? (TOK_ALL - T0) : p.Mr;
    if (INB(1, pb)) { EpiIn E; E.act = actp(p, 0); E.split_stride = (size_t)p.Mr * 1024; E.gates = (float*)(p.ws + p.o_gates); E.b_gate = p.b_gate;
        run_gemm(shm, (const us*)(p.ws + p.o_xn), (const us*)(p.ws + p.o_winT), Mc, 11264, 1024, E); }
    SEAM(pb);
    if (INB(2, pb + 1)) { phase_gates(p, Mc); phase_conv(p, T0, Mc); }
    SEAM(pb + 1);
    if (round == 0) {
        if (INB(3, pb + 2)) phase_mix(p, shm, T0, Mc, 0, 1 | 4);
        SEAM(pb + 2);
        if (INB(4, pb + 3)) phase_mix(p, shm, T0, Mc, 1, 2);
    } else {
        if (INB(4, pb + 3)) phase_mix(p, shm, T0, Mc, 1 + round, 2 | 4);
    }
    SEAM(pb + 3);
    if (INB(5, pb + 4)) phase_ya(p, Mc);
    SEAM(pb + 4);
    if (INB(6, pb + 5)) {
        EpiPair E; E.ga = actp(p, 9); E.gb = actp(p, 10); E.merged = actp(p, 1);
        run_gemm_pair(shm, actp(p, 0), (const us*)(p.ws + p.o_wdaT), (const us*)(p.ws + p.o_xn), (const us*)(p.ws + p.o_wdbT), Mc, 1024, 1024, E);
    }
    SEAM(pb + 5);
    if (INB(7, pb + 6)) { EpiOut E; E.out = p.out + (size_t)T0 * 1024; E.xp = p.xp; E.xs = p.xs; E.T0 = T0; run_gemm(shm, actp(p, 1), (const us*)(p.ws + p.o_woutT), Mc, 1024, 1024, E); }
    SEAM(pb + 6);
    if (INB(8, pb + 7)) { phase_fnorm(p, T0, Mc); if (T0 + Mc < TOK_ALL) phase_xnorm(p, T0 + Mc, (TOK_ALL - T0 - Mc) < p.Mr ? (TOK_ALL - T0 - Mc) : p.Mr); }
    if (T0 + Mc < TOK_ALL) SEAM(pb + 7);
}
__global__ __launch_bounds__(512, 2) void mega(Params p) {
    extern __shared__ __attribute__((aligned(16))) unsigned char shm[];
    cg::grid_group grid = cg::this_grid();
    const int lo = p.ph_lo, hi = p.ph_hi;
    volatile LAS unsigned* bst = (volatile LAS unsigned*)((LAS unsigned char*)shm + (LDS_BYTES - 32));
    if (threadIdx.x == 0) { bst[0] = 0u; bst[1] = 0u; }
    __syncthreads();
    const XcdBarrier bar = xcd_barrier_post((unsigned*)(p.ws + p.o_bar), bst);
    if (INB(0, 0)) { phase_weights(p, shm); phase_xnorm(p, 0, p.Mr); }
    if (p.ph_lo < 0) grid.sync();
    SEAM(0);
    round_body(p, shm, bar, 0, lo, hi);
    round_body(p, shm, bar, 1, lo, hi);
    round_body(p, shm, bar, 2, lo, hi);
#undef IN
#undef SEAM
}

#ifndef N_LAUNCH_MODE
#define N_LAUNCH_MODE 1
#endif
extern "C" void kernel_launch(void* const* d_in, const int* in_sizes, int n_in, void* d_out, int out_size, void* d_ws, size_t ws_size, hipStream_t stream) {
    static int grid = 0;
    if (grid == 0) {
        int dev = 0, cus = 0, per_cu = 0;
        hipGetDevice(&dev); hipDeviceGetAttribute(&cus, hipDeviceAttributeMultiprocessorCount, dev);
        if (hipFuncSetAttribute((const void*)mega, hipFuncAttributeMaxDynamicSharedMemorySize, LDS_BYTES) != hipSuccess) fprintf(stderr, "kernel_launch: hipFuncSetAttribute failed\n");
        if (hipOccupancyMaxActiveBlocksPerMultiprocessor(&per_cu, (const void*)mega, 512, LDS_BYTES) != hipSuccess || per_cu < 1) { fprintf(stderr, "kernel_launch: occupancy query says %d\n", per_cu); per_cu = 1; }
        (void)hipGetLastError();
        grid = cus * 1;
        if (grid <= 0) grid = 256;
    }
    Params p{};
    p.xp = (const float*)d_in[0]; p.xs = (const float*)d_in[1]; p.norm_w = (const float*)d_in[2]; p.w_in = (const float*)d_in[3]; p.b_gate = (const float*)d_in[4];
    p.conv_w = (const float*)d_in[5]; p.conv_b = (const float*)d_in[6]; p.mh_w = (const float*)d_in[7]; p.rpb = (const float*)d_in[8];
    p.wda = (const float*)d_in[9]; p.wdb = (const float*)d_in[10]; p.wout = (const float*)d_in[11]; p.fnw = (const float*)d_in[12];
    p.out = (float*)d_out; p.ws = (unsigned char*)d_ws;
    size_t off = 0;
    p.o_winT = off; off += (size_t)NPAD * 1024 * 2;
    p.o_wdaT = off; off += (size_t)1024 * 1024 * 2; p.o_wdbT = off; off += (size_t)1024 * 1024 * 2; p.o_woutT = off; off += (size_t)1024 * 1024 * 2;
    p.o_ctr = off; off += 256;
    p.o_bar = off; off += (size_t)XCD_BAR_WORDS * 4;
    p.o_state = off; off += (size_t)256 * ST_REC * 4;
    const int Mr = 32768;
    p.Mr = Mr; p.nrounds = 3;
    p.o_gates = off; off += (size_t)Mr * 64;
    p.o_xn = off; off += (size_t)Mr * 2048;
    p.o_act = off; off += (size_t)Mr * 11 * 2048;
    if (off > ws_size) { fprintf(stderr, "kernel_launch: workspace too small (%zu > %zu)\n", off, ws_size); return; }
    hipMemsetAsync((char*)d_ws + p.o_ctr, 0, 256 + (size_t)XCD_BAR_WORDS * 4, stream);
    const int nph = 1 + 8 * p.nrounds;
#if N_LAUNCH_MODE == 1
    p.ph_lo = 0; p.ph_hi = nph;
    void* args[] = {&p};
    hipError_t e = hipLaunchCooperativeKernel((const void*)mega, dim3(grid), dim3(512), args, LDS_BYTES, stream);
    if (e != hipSuccess) fprintf(stderr, "kernel_launch: cooperative launch failed: %s (grid %d)\n", hipGetErrorString(e), grid);
#else
    for (int ph = 0; ph < nph; ++ph) { p.ph_lo = ph; p.ph_hi = ph + 1; hipLaunchKernelGGL(mega, dim3(grid), dim3(512), LDS_BYTES, stream, p); }
#endif
}
```
